# Optimizing an MI355X kernel written in HIP

```python
import jax, jax.numpy as jnp
from jax import lax
import numpy as np

D_MODEL = 2048
BATCH = 2
SEQ = 8192
DEPTH = 4

HEAD_DIM = 64
N_Q_HEADS = 16
N_KV_HEADS = 4
ATTN_WIDTH = N_Q_HEADS * HEAD_DIM
KV_WIDTH = N_KV_HEADS * HEAD_DIM
WINDOW = 128
ATTN_BLOCK = 128
ROPE_THETA = 10000.0

GLA_HEADS = 4
GLA_V_WIDTH = D_MODEL - ATTN_WIDTH
GLA_K_WIDTH = GLA_V_WIDTH // 2
GLA_DK = GLA_K_WIDTH // GLA_HEADS
GLA_DV = GLA_V_WIDTH // GLA_HEADS
GLA_GATE_RANK = 16
GLA_TAU = 16.0
GLA_CHUNK = 64

MIX_SPLITS = (ATTN_WIDTH, KV_WIDTH, KV_WIDTH, GLA_K_WIDTH, GLA_K_WIDTH, GLA_V_WIDTH, GLA_V_WIDTH, GLA_GATE_RANK)
MIX_IN_WIDTH = ATTN_WIDTH + 2 * KV_WIDTH + 2 * GLA_K_WIDTH + 2 * GLA_V_WIDTH + GLA_GATE_RANK

D_FF = 5504
NORM_EPS = 1e-6
N_SANDWICH_NORMS = 6

kernel_name = 'hybrid_swa_sink_gla_macaron_sandwich'


def rmsnorm(x, gain):
    xf = x.astype(jnp.float32)
    y = xf * lax.rsqrt(jnp.mean(xf * xf, axis=-1, keepdims=True) + NORM_EPS)
    return (y * gain.astype(jnp.float32)).astype(x.dtype)


def rope(x, positions):
    d = x.shape[-1]
    inv_freq = ROPE_THETA ** (-jnp.arange(0, d, 2, dtype=jnp.float32) / d)
    ang = positions.astype(jnp.float32)[..., None] * inv_freq
    cos = jnp.cos(ang)[:, :, None, :]
    sin = jnp.sin(ang)[:, :, None, :]
    xf = x.astype(jnp.float32)
    x1, x2 = xf[..., : d // 2], xf[..., d // 2:]
    return jnp.concatenate([x1 * cos - x2 * sin, x2 * cos + x1 * sin], axis=-1).astype(x.dtype)


def sliding_window_attention(q, k, v, sinks):
    B, S = q.shape[0], q.shape[1]
    nb = S // ATTN_BLOCK
    G = N_Q_HEADS // N_KV_HEADS
    qb = q.reshape(B, nb, ATTN_BLOCK, N_KV_HEADS, G, HEAD_DIM)

    def with_prev(t):
        tb = t.reshape(B, nb, ATTN_BLOCK, N_KV_HEADS, HEAD_DIM)
        prev = jnp.pad(tb[:, :-1], ((0, 0), (1, 0), (0, 0), (0, 0), (0, 0)))
        return jnp.concatenate([prev, tb], axis=2)

    kb, vb = with_prev(k), with_prev(v)
    scores = jnp.einsum('bnqhgd,bnkhd->bnhgqk', qb, kb,
                        preferred_element_type=jnp.float32) * (HEAD_DIM ** -0.5)
    qi = jnp.arange(ATTN_BLOCK)[:, None]
    kj = jnp.arange(2 * ATTN_BLOCK)[None, :]
    diff = qi + ATTN_BLOCK - kj
    band = (diff >= 0) & (diff < WINDOW)
    key_valid = (jnp.arange(nb)[:, None] > 0) | (kj >= ATTN_BLOCK)
    mask = band[None] & key_valid[:, None, :]
    scores = jnp.where(mask[None, :, None, None], scores, -jnp.inf)
    sink = sinks.astype(jnp.float32).reshape(N_KV_HEADS, G)[None, None, :, :, None]
    m = jnp.maximum(scores.max(axis=-1), sink)
    p = jnp.exp(scores - m[..., None])
    denom = p.sum(axis=-1) + jnp.exp(sink - m)
    p = p / denom[..., None]
    out = jnp.einsum('bnhgqk,bnkhd->bnqhgd', p, vb.astype(jnp.float32))
    return out.reshape(B, S, ATTN_WIDTH).astype(q.dtype)


def gated_linear_attention(q, k, v, log_a):
    B, S = q.shape[0], q.shape[1]
    N, C = S // GLA_CHUNK, GLA_CHUNK
    q = q.astype(jnp.float32).reshape(B, N, C, GLA_HEADS, GLA_DK) * (GLA_DK ** -0.5)
    k = k.astype(jnp.float32).reshape(B, N, C, GLA_HEADS, GLA_DK)
    v = v.astype(jnp.float32).reshape(B, N, C, GLA_HEADS, GLA_DV)
    b = jnp.cumsum(log_a.astype(jnp.float32).reshape(B, N, C, GLA_HEADS, GLA_DK), axis=2)
    b_last = b[:, :, -1:]
    q_dec = q * jnp.exp(b)
    k_dec = k * jnp.exp(-b)
    causal = jnp.tril(jnp.ones((C, C), dtype=bool))
    intra = jnp.einsum('bnthk,bnshk->bnhts', q_dec, k_dec)
    intra = jnp.where(causal, intra, 0.0)
    o_intra = jnp.einsum('bnhts,bnshv->bnthv', intra, v)
    dS = jnp.einsum('bnshk,bnshv->bnhkv', k * jnp.exp(b_last - b), v)
    chunk_decay = jnp.exp(b_last[:, :, 0])

    def step(state, inp):
        dec, ds = inp
        return dec[..., None] * state + ds, state

    init = jnp.zeros((B, GLA_HEADS, GLA_DK, GLA_DV), jnp.float32)
    _, s_before = lax.scan(step, init, (jnp.moveaxis(chunk_decay, 1, 0), jnp.moveaxis(dS, 1, 0)))
    s_before = jnp.moveaxis(s_before, 0, 1)
    o_inter = jnp.einsum('bnthk,bnhkv->bnthv', q_dec, s_before)
    return (o_intra + o_inter).reshape(B, S, GLA_HEADS, GLA_DV)


def hybrid_mixer(h, positions, w_in, sinks, gate_w2, gate_b, gla_norm_gain, w_out):
    B, S = h.shape[0], h.shape[1]
    split_at = tuple(int(i) for i in np.cumsum(MIX_SPLITS)[:-1])
    q_a, k_a, v_a, q_g, k_g, v_g, r_g, g_lr = jnp.split(h @ w_in, split_at, axis=-1)
    q_a = rope(q_a.reshape(B, S, N_Q_HEADS, HEAD_DIM), positions)
    k_a = rope(k_a.reshape(B, S, N_KV_HEADS, HEAD_DIM), positions)
    v_a = v_a.reshape(B, S, N_KV_HEADS, HEAD_DIM)
    attn_out = sliding_window_attention(q_a, k_a, v_a, sinks)
    log_a = jax.nn.log_sigmoid((g_lr @ gate_w2 + gate_b).astype(jnp.float32)) / GLA_TAU
    o = gated_linear_attention(q_g.reshape(B, S, GLA_HEADS, GLA_DK),
                               k_g.reshape(B, S, GLA_HEADS, GLA_DK),
                               v_g.reshape(B, S, GLA_HEADS, GLA_DV),
                               log_a.reshape(B, S, GLA_HEADS, GLA_DK))
    o = rmsnorm(o, gla_norm_gain).reshape(B, S, GLA_V_WIDTH)
    gla_out = (o * jax.nn.silu(r_g.astype(jnp.float32))).astype(h.dtype)
    return jnp.concatenate([attn_out.astype(h.dtype), gla_out], axis=-1) @ w_out


def swiglu(h, w_in, w_out):
    gate, up = jnp.split(h @ w_in, 2, axis=-1)
    return (jax.nn.silu(gate) * up) @ w_out


def setup_inputs(seed: int = 0) -> dict:
    key = jax.random.key(seed)
    ks = jax.random.split(key, 11)
    f32 = jnp.float32
    x = jax.random.normal(ks[0], (BATCH, SEQ, D_MODEL), f32)
    positions = jnp.broadcast_to(jnp.arange(SEQ, dtype=jnp.int32), (BATCH, SEQ))
    norm_gains = 1.0 + 0.05 * jax.random.normal(ks[1], (DEPTH, N_SANDWICH_NORMS, D_MODEL), f32)
    ffn_w_in = jax.random.normal(ks[2], (DEPTH, 2, D_MODEL, 2 * D_FF), f32) * D_MODEL ** -0.5
    ffn_w_out = jax.random.normal(ks[3], (DEPTH, 2, D_FF, D_MODEL), f32) * D_FF ** -0.5
    w_mix_in = jax.random.normal(ks[4], (DEPTH, D_MODEL, MIX_IN_WIDTH), f32) * D_MODEL ** -0.5
    attn_sinks = jax.random.normal(ks[5], (DEPTH, N_Q_HEADS), f32)
    gla_gate_w2 = jax.random.normal(ks[6], (DEPTH, GLA_GATE_RANK, GLA_K_WIDTH), f32) * GLA_GATE_RANK ** -0.5
    gla_gate_b = 0.1 * jax.random.normal(ks[7], (DEPTH, GLA_K_WIDTH), f32)
    gla_norm_gain = 1.0 + 0.05 * jax.random.normal(ks[8], (DEPTH, GLA_DV), f32)
    w_mix_out = jax.random.normal(ks[9], (DEPTH, D_MODEL, D_MODEL), f32) * D_MODEL ** -0.5
    return {'x': x, 'positions': positions, 'norm_gains': norm_gains, 'ffn_w_in': ffn_w_in,
            'ffn_w_out': ffn_w_out, 'w_mix_in': w_mix_in, 'attn_sinks': attn_sinks,
            'gla_gate_w2': gla_gate_w2, 'gla_gate_b': gla_gate_b, 'gla_norm_gain': gla_norm_gain,
            'w_mix_out': w_mix_out}


def reference(x, positions, norm_gains, ffn_w_in, ffn_w_out, w_mix_in, attn_sinks,
              gla_gate_w2, gla_gate_b, gla_norm_gain, w_mix_out):
    for l in range(DEPTH):
        g = norm_gains[l]
        h = swiglu(rmsnorm(x, g[0]), ffn_w_in[l, 0], ffn_w_out[l, 0])
        x = x + 0.5 * rmsnorm(h, g[1])
        h = hybrid_mixer(rmsnorm(x, g[2]), positions, w_mix_in[l], attn_sinks[l],
                         gla_gate_w2[l], gla_gate_b[l], gla_norm_gain[l], w_mix_out[l])
        x = x + rmsnorm(h, g[3])
        h = swiglu(rmsnorm(x, g[4]), ffn_w_in[l, 1], ffn_w_out[l, 1])
        x = x + 0.5 * rmsnorm(h, g[5])
    return x
```

```cpp
#include <hip/hip_runtime.h>
#include <cstdio>
#include <cstdint>
#include <cmath>
namespace pg8 {
#define PG8_LAS __attribute__((address_space(3)))
typedef unsigned short bf16_t;
typedef short bf16x8 __attribute__((ext_vector_type(8)));
typedef float f32x4 __attribute__((ext_vector_type(4)));
typedef unsigned u32x4 __attribute__((ext_vector_type(4)));
constexpr int BM = 256, BK = 64, HALF = 128, HTB = HALF * BK * 2  , STAGE_BYTES = 8 * HTB, NXCD = 8, WGM = 8;

__host__ __device__ __forceinline__ int lds_byte(int r, int c) { const int st = (r >> 4) * 2 + (c >> 5), rr = r & 15, cc = c & 31, ob = rr * 64 + cc * 2; return st * 1024 + (ob ^ (((ob >> 9) & 1) << 5)); }
__host__ __device__ __forceinline__ void stage_rc(int b, int& R, int& C) { const int st = b / 1024, sb = b % 1024, swz = sb ^ (((sb >> 9) & 1) << 5); R = (st >> 1) * 16 + swz / 64; C = (st & 1) * 32 + (swz % 64) / 2; }
__host__ __device__ __forceinline__ int perm32(int rho) { const int n = rho >> 4, i = rho & 15; return 8 * (i >> 2) + 4 * n + (i & 3); }

struct Unit { int pm, pn; };
struct Gemm { const bf16_t* A; const bf16_t* Bt; int M, N, K; };

struct StaticOrder {
    int nM, nN, nwg, G, c;
    __host__ __device__ void init(int M, int N, int G_, int c_) { nM = M / BM; nN = N / BM; nwg = nM * nN; G = G_; c = c_; }
    __host__ __device__ bool next(int i, Unit& u) const {
        const long L = (long)i * G + c; if (L >= nwg) return false;
        int wgid = (int)L; { const int q = nwg / NXCD, r = nwg % NXCD, xcd = wgid % NXCD, off = wgid / NXCD; wgid = (xcd < r ? xcd * (q + 1) : r * (q + 1) + (xcd - r) * q) + off; }
        const int nig = WGM * nN, gid = wgid / nig, fm = gid * WGM, gsz = (nM - fm) < WGM ? (nM - fm) : WGM;
        u.pm = fm + ((wgid % nig) % gsz); u.pn = (wgid % nig) / gsz; return true;
    }
    __device__ __forceinline__ void a_ready(const Unit&) const {}
    __device__ __forceinline__ void done(const Unit&) const {}
};

__device__ __forceinline__ unsigned cvt_pk_bf16(float lo, float hi) { unsigned r; asm volatile("v_cvt_pk_bf16_f32 %0, %1, %2" : "=v"(r) : "v"(lo), "v"(hi)); return r; }
typedef float f32x2 __attribute__((ext_vector_type(2)));

__device__ __forceinline__ float silu_f(float g) { return g * __builtin_amdgcn_rcpf(1.0f + __builtin_amdgcn_exp2f(-1.4426950408889634f * g)); }
struct EpiSwiGLU {
    static constexpr bool PERM = true, AFTER_DRAIN = false;
    bf16_t* O; int ldc;
    __device__ __forceinline__ void operator()(const f32x4 (&acc)[2][2][4][2], const Unit& u, int wr, int wc, int fr, int fq) const {
        const int row0 = u.pm * BM + wr * 64 + fr, col0 = u.pn * HALF + wc * 32 + 8 * fq;
#pragma unroll
        for (int ai = 0; ai < 2; ++ai)
#pragma unroll
            for (int m = 0; m < 4; ++m) { bf16_t* rowp = O + (size_t)(row0 + ai * HALF + m * 16) * ldc + col0;
                const f32x4 g0 = acc[ai][0][m][0], g1 = acc[ai][0][m][1], u0 = acc[ai][1][m][0], u1 = acc[ai][1][m][1];
                u32x4 w; w.x = cvt_pk_bf16(silu_f(g0[0]) * u0[0], silu_f(g0[1]) * u0[1]); w.y = cvt_pk_bf16(silu_f(g0[2]) * u0[2], silu_f(g0[3]) * u0[3]);
                w.z = cvt_pk_bf16(silu_f(g1[0]) * u1[0], silu_f(g1[1]) * u1[1]); w.w = cvt_pk_bf16(silu_f(g1[2]) * u1[2], silu_f(g1[3]) * u1[3]);
                *(u32x4*)rowp = w; }
    }
};
struct EpiPlain {
    static constexpr bool PERM = true, AFTER_DRAIN = false;
    bf16_t* O; int ldc;
    __device__ __forceinline__ void operator()(const f32x4 (&acc)[2][2][4][2], const Unit& u, int wr, int wc, int fr, int fq) const {
        const int row0 = u.pm * BM + wr * 64 + fr, col0 = u.pn * BM + wc * 32 + 8 * fq;
#pragma unroll
        for (int ai = 0; ai < 2; ++ai)
#pragma unroll
            for (int m = 0; m < 4; ++m) { bf16_t* rowp = O + (size_t)(row0 + ai * HALF + m * 16) * ldc + col0;
#pragma unroll
                for (int bj = 0; bj < 2; ++bj) { const f32x4 v0 = acc[ai][bj][m][0], v1 = acc[ai][bj][m][1];
                    u32x4 w; w.x = cvt_pk_bf16(v0[0], v0[1]); w.y = cvt_pk_bf16(v0[2], v0[3]); w.z = cvt_pk_bf16(v1[0], v1[1]); w.w = cvt_pk_bf16(v1[2], v1[3]);
                    *(u32x4*)(rowp + bj * HALF) = w; } }
    }
};
struct EpiMix {
    static constexpr bool PERM = true, AFTER_DRAIN = false;
    bf16_t* O; int ldc; float* G; int npl;
    __device__ __forceinline__ void operator()(const f32x4 (&acc)[2][2][4][2], const Unit& u, int wr, int wc, int fr, int fq) const {
        const int row0 = u.pm * BM + wr * 64 + fr;
        if (u.pn < npl) {
            const int col0 = u.pn * BM + wc * 32 + 8 * fq;
#pragma unroll
            for (int ai = 0; ai < 2; ++ai)
#pragma unroll
                for (int m = 0; m < 4; ++m) { bf16_t* rowp = O + (size_t)(row0 + ai * HALF + m * 16) * ldc + col0;
#pragma unroll
                    for (int bj = 0; bj < 2; ++bj) { const f32x4 v0 = acc[ai][bj][m][0], v1 = acc[ai][bj][m][1];
                        u32x4 w; w.x = cvt_pk_bf16(v0[0], v0[1]); w.y = cvt_pk_bf16(v0[2], v0[3]); w.z = cvt_pk_bf16(v1[0], v1[1]); w.w = cvt_pk_bf16(v1[2], v1[3]);
                        *(u32x4*)(rowp + bj * HALF) = w; } }
        } else if (wc == 0 && fq < 2) {
#pragma unroll
            for (int ai = 0; ai < 2; ++ai)
#pragma unroll
                for (int m = 0; m < 4; ++m) { float* rowp = G + (size_t)(row0 + ai * HALF + m * 16) * 16 + 8 * fq;
                    *(f32x4*)rowp = acc[ai][0][m][0]; *(f32x4*)(rowp + 4) = acc[ai][0][m][1]; }
        }
    }
};
template <class Epi, class Sched, bool ALIGN_EPI = false, bool SP2 = false>
__device__ __forceinline__ void gemm_phase(PG8_LAS unsigned char* lds, const Gemm g, const Sched& S, const Epi& E) {
    int tid_ = threadIdx.x; asm volatile("" : "+v"(tid_));
    const int tid = tid_, wid = __builtin_amdgcn_readfirstlane(tid >> 6), lane = tid & 63, wr = wid >> 2, wc = wid & 3, fr = lane & 15, fq = lane >> 4;
    const int K = g.K, nt = K / BK;
    unsigned voffA[2], voffB[2];
#pragma unroll
    for (int i = 0; i < 2; ++i) { int R, C; stage_rc(tid * 16 + i * 8192, R, C); const int Rb = Epi::PERM ? ((R & ~31) + perm32(R & 31)) : R;
        voffA[i] = (unsigned)(R * K + C) * 2u; voffB[i] = (unsigned)(Rb * K + C) * 2u; }
    const size_t kstep = (size_t)(BK * 2);
    const size_t hstep = (size_t)HALF * K * 2;
    const size_t tstep = 2 * hstep;
    const unsigned ldsw = (unsigned)wid * 1024u;
    const int aoff = lds_byte(wr * 64 + fr, fq * 8), boff = lds_byte(wc * 32 + fr, fq * 8);
#define PG8_SA(b, h) (((b) * 2 + (h)) * HTB)
#define PG8_SB(b, h) ((4 + (b) * 2 + (h)) * HTB)
#define PG8_STAGE(bufoff, gbase, voff) do { _Pragma("unroll") for (int _i = 0; _i < 2; ++_i) \
        __builtin_amdgcn_global_load_lds((const unsigned*)((const char*)(gbase) + (voff)[_i]), (PG8_LAS unsigned*)(lds + (bufoff) + ldsw + _i * 8192), 16, 0, 0); } while (0)
#define PG8_LDA(dst, b, h) do { _Pragma("unroll") for (int m = 0; m < 4; ++m) _Pragma("unroll") for (int k = 0; k < 2; ++k) dst[m][k] = *(const PG8_LAS bf16x8*)(lds + PG8_SA(b, h) + aoff + m * 2048 + k * 1024); } while (0)
#define PG8_LDB(dst, b, h) do { _Pragma("unroll") for (int n = 0; n < 2; ++n) _Pragma("unroll") for (int k = 0; k < 2; ++k) dst[n][k] = *(const PG8_LAS bf16x8*)(lds + PG8_SB(b, h) + boff + n * 2048 + k * 1024); } while (0)
#define PG8_MMA(ai, bj, At, Bt) do { __builtin_amdgcn_s_setprio(1); _Pragma("unroll") for (int m = 0; m < 4; ++m) _Pragma("unroll") for (int n = 0; n < 2; ++n) _Pragma("unroll") for (int k = 0; k < 2; ++k) \
        acc[ai][bj][m][n] = __builtin_amdgcn_mfma_f32_16x16x32_bf16(Bt[n][k], At[m][k], acc[ai][bj][m][n], 0, 0, 0); __builtin_amdgcn_s_setprio(0); } while (0)
#define PG8_WAIT_V(n) asm volatile("s_waitcnt vmcnt(" #n ")" ::: "memory")
#define PG8_WAIT_L(n) asm volatile("s_waitcnt lgkmcnt(" #n ")" ::: "memory")
#define PG8_BAR __builtin_amdgcn_s_barrier()
#define PG8_SCHED __builtin_amdgcn_sched_barrier(0)
    Unit cur, nxt; int ui = 0;
    if (!S.next(0, cur)) return;
    f32x4 acc[2][2][4][2];
#pragma unroll
    for (int a = 0; a < 2; ++a)
#pragma unroll
        for (int b = 0; b < 2; ++b)
#pragma unroll
            for (int m = 0; m < 4; ++m)
#pragma unroll
                for (int n = 0; n < 2; ++n) acc[a][b][m][n] = (f32x4){0.f, 0.f, 0.f, 0.f};
    bf16x8 At[4][2], B0[2][2], B1[2][2];
    const char* cA = (const char*)g.A + (size_t)cur.pm * tstep; const char* cB = (const char*)g.Bt + (size_t)cur.pn * tstep;
    S.a_ready(cur);
    if constexpr (SP2) {
        PG8_STAGE(PG8_SB(0, 0), cB, voffB); PG8_STAGE(PG8_SB(0, 1), cB + hstep, voffB); PG8_STAGE(PG8_SA(0, 0), cA, voffA); PG8_STAGE(PG8_SA(0, 1), cA + hstep, voffA);
        if (wr == 1) PG8_BAR;
        PG8_WAIT_V(2); PG8_BAR;
        PG8_STAGE(PG8_SB(1, 0), cB + kstep, voffB); PG8_STAGE(PG8_SA(1, 0), cA + kstep, voffA); PG8_STAGE(PG8_SB(1, 1), cB + hstep + kstep, voffB);
        PG8_WAIT_V(6); PG8_BAR;
    } else {
        PG8_STAGE(PG8_SB(0, 0), cB, voffB); PG8_STAGE(PG8_SA(0, 0), cA, voffA); PG8_STAGE(PG8_SB(0, 1), cB + hstep, voffB); PG8_STAGE(PG8_SA(0, 1), cA + hstep, voffA);
        if (wr == 1) PG8_BAR;
        PG8_WAIT_V(4); PG8_BAR;
        PG8_STAGE(PG8_SB(1, 0), cB + kstep, voffB); PG8_STAGE(PG8_SA(1, 0), cA + kstep, voffA); PG8_STAGE(PG8_SB(1, 1), cB + hstep + kstep, voffB);
        PG8_WAIT_V(6); PG8_BAR;
    }
    for (;;) {
        const bool has_next = S.next(ui + 1, nxt);
        const char* nA = has_next ? (const char*)g.A + (size_t)nxt.pm * tstep : cA; const char* nB = has_next ? (const char*)g.Bt + (size_t)nxt.pn * tstep : cB;
        for (int t = 0; t < nt; t += 2) {
            const bool last = (t == nt - 2);
            const char* a1 = cA + (size_t)(t + 1) * kstep;
            const char* a2 = last ? nA : cA + (size_t)(t + 2) * kstep; const char* b2 = last ? nB : cB + (size_t)(t + 2) * kstep;
            const char* a3 = a2 + kstep; const char* b3 = b2 + kstep;
            if (last && has_next) S.a_ready(nxt);
            if constexpr (SP2) {
            PG8_LDB(B0, 0, 0); PG8_LDB(B1, 0, 1); PG8_SCHED; PG8_LDA(At, 0, 0); PG8_STAGE(PG8_SA(1, 1), a1 + hstep, voffA);
            PG8_WAIT_V(8); PG8_WAIT_L(0); PG8_BAR; PG8_MMA(0, 0, At, B0); PG8_MMA(0, 1, At, B1); PG8_BAR; PG8_SCHED;
            PG8_LDA(At, 0, 1); PG8_STAGE(PG8_SB(0, 0), b2, voffB); PG8_STAGE(PG8_SB(0, 1), b2 + hstep, voffB); PG8_STAGE(PG8_SA(0, 0), a2, voffA);
            PG8_WAIT_V(8); PG8_WAIT_L(0); PG8_BAR; PG8_MMA(1, 0, At, B0); PG8_MMA(1, 1, At, B1); PG8_BAR; PG8_SCHED;
            PG8_LDB(B0, 1, 0); PG8_LDB(B1, 1, 1); PG8_SCHED; PG8_LDA(At, 1, 0); PG8_STAGE(PG8_SA(0, 1), a2 + hstep, voffA);
            PG8_WAIT_V(8); PG8_WAIT_L(0); PG8_BAR; PG8_MMA(0, 0, At, B0); PG8_MMA(0, 1, At, B1); PG8_BAR; PG8_SCHED;
            PG8_LDA(At, 1, 1); PG8_STAGE(PG8_SB(1, 0), b3, voffB); PG8_STAGE(PG8_SB(1, 1), b3 + hstep, voffB); PG8_STAGE(PG8_SA(1, 0), a3, voffA);
            PG8_WAIT_V(8); PG8_WAIT_L(0); PG8_BAR; PG8_MMA(1, 0, At, B0); PG8_MMA(1, 1, At, B1); PG8_BAR; PG8_SCHED;
            } else {
            PG8_LDB(B0, 0, 0); PG8_SCHED; PG8_LDA(At, 0, 0); PG8_STAGE(PG8_SA(1, 1), a1 + hstep, voffA);
            PG8_WAIT_L(8); PG8_BAR; PG8_WAIT_L(0); PG8_MMA(0, 0, At, B0); PG8_BAR; PG8_SCHED;
            PG8_LDB(B1, 0, 1); PG8_STAGE(PG8_SB(0, 0), b2, voffB);
            PG8_BAR; PG8_WAIT_L(0); PG8_MMA(0, 1, At, B1); PG8_BAR;
            PG8_LDA(At, 0, 1); PG8_STAGE(PG8_SA(0, 0), a2, voffA);
            PG8_BAR; PG8_WAIT_L(0); PG8_MMA(1, 0, At, B0); PG8_BAR; PG8_SCHED;
            PG8_STAGE(PG8_SB(0, 1), b2 + hstep, voffB);
            PG8_WAIT_V(6); PG8_BAR; PG8_MMA(1, 1, At, B1); PG8_BAR;
            PG8_LDB(B0, 1, 0); PG8_SCHED; PG8_LDA(At, 1, 0); PG8_STAGE(PG8_SA(0, 1), a2 + hstep, voffA);
            PG8_WAIT_L(8); PG8_BAR; PG8_WAIT_L(0); PG8_MMA(0, 0, At, B0); PG8_BAR; PG8_SCHED;
            PG8_LDB(B1, 1, 1); PG8_STAGE(PG8_SB(1, 0), b3, voffB);
            PG8_BAR; PG8_WAIT_L(0); PG8_MMA(0, 1, At, B1); PG8_BAR;
            PG8_LDA(At, 1, 1); PG8_STAGE(PG8_SA(1, 0), a3, voffA);
            PG8_BAR; PG8_WAIT_L(0); PG8_MMA(1, 0, At, B0); PG8_BAR; PG8_SCHED;
            PG8_STAGE(PG8_SB(1, 1), b3 + hstep, voffB);
            PG8_WAIT_V(6); PG8_BAR; PG8_MMA(1, 1, At, B1); PG8_BAR;
            }
        }
        if constexpr (ALIGN_EPI) { if (wr == 0) PG8_BAR; }
        if constexpr (!Epi::AFTER_DRAIN) { E(acc, cur, wr, wc, fr, fq); S.done(cur); }
        if (!has_next) break;
#pragma unroll
        for (int a = 0; a < 2; ++a)
#pragma unroll
            for (int b = 0; b < 2; ++b)
#pragma unroll
                for (int m = 0; m < 4; ++m)
#pragma unroll
                    for (int n = 0; n < 2; ++n) acc[a][b][m][n] = (f32x4){0.f, 0.f, 0.f, 0.f};
        cur = nxt; cA = nA; cB = nB; ++ui;
        if constexpr (ALIGN_EPI) { if (wr == 1) PG8_BAR; }
    }
    PG8_WAIT_V(0);
    if constexpr (!ALIGN_EPI) { if (wr == 0) PG8_BAR; }
    PG8_BAR;
    if constexpr (Epi::AFTER_DRAIN) { E.fused(acc, cur, wr, wc, fr, fq, lds, wid, lane); S.done(cur); }
#undef PG8_SA
#undef PG8_SB
#undef PG8_STAGE
#undef PG8_LDA
#undef PG8_LDB
#undef PG8_MMA
#undef PG8_WAIT_V
#undef PG8_WAIT_L
#undef PG8_BAR
#undef PG8_SCHED
}
}

constexpr int NWAVES = 8;
constexpr int BATCH = 2, SEQ = 8192, M = BATCH * SEQ, D = 2048, DEPTH = 4;
constexpr int DFF = 5504, NFF = 2 * DFF;
constexpr int NMIX = 4624, NMIXP = 4864, MIXLD = 4608;
constexpr int C_QA = 0, C_KA = 1024, C_VA = 1280, C_QG = 1536, C_KG = 2048, C_VG = 2560, C_RG = 3584;
constexpr float NORM_EPS = 1e-6f;

constexpr size_t MiB = 1u << 20;
constexpr size_t WS_CTL = 0, CTL_ZERO_BYTES = 1 * MiB;
constexpr size_t SZ_WFI = (size_t)8 * NFF * D * 2, SZ_WFO = (size_t)8 * D * DFF * 2, SZ_WMI = (size_t)4 * NMIXP * D * 2, SZ_WMO = (size_t)4 * D * D * 2;
constexpr size_t WS_WFI = 2 * MiB;
constexpr size_t WS_WFO = WS_WFI + SZ_WFI;
constexpr size_t WS_WMI = WS_WFO + SZ_WFO;
constexpr size_t WS_WMO = WS_WMI + SZ_WMI;
constexpr size_t WS_XN  = WS_WMO + SZ_WMO;
constexpr size_t WS_ACT = WS_XN + (size_t)M * D * 2;
constexpr size_t WS_H   = WS_ACT + (size_t)M * DFF * 2;
constexpr size_t WS_MIX = WS_H + (size_t)M * D * 2;
constexpr size_t WS_GLR = WS_MIX + (size_t)M * MIXLD * 2;
constexpr size_t WS_LOGA = WS_GLR + (size_t)M * 16 * 4;
constexpr size_t WS_ROPE = WS_LOGA + (size_t)M * 512 * 4;
constexpr size_t WS_MO  = WS_ROPE + (size_t)M * 64 * 4;
constexpr size_t WS_OG  = WS_MO + (size_t)M * D * 2;
constexpr size_t WS_END = WS_OG + (size_t)M * 1024 * 4;
static_assert(WS_WFI % 256 == 0 && WS_WFO % 256 == 0 && WS_WMI % 256 == 0 && WS_WMO % 256 == 0 && WS_XN % 256 == 0 && WS_ACT % 256 == 0 && WS_H % 256 == 0 && WS_MIX % 256 == 0 && WS_GLR % 256 == 0 && WS_LOGA % 256 == 0 && WS_ROPE % 256 == 0 && WS_MO % 256 == 0 && WS_OG % 256 == 0, "alignment");
constexpr int CW_BAR = 4096;

constexpr int RING_OFF = 0, RING_BYTES = 131072;
constexpr int LDSCTL_OFF = RING_BYTES, MISC_OFF = LDSCTL_OFF + 320;
constexpr int LDS_BYTES = 147456;
static_assert(MISC_OFF + 128 <= LDS_BYTES, "LDS map");
#define GAS __attribute__((address_space(1)))
#define LAS __attribute__((address_space(3)))
typedef unsigned short bf16;
typedef unsigned v4u __attribute__((ext_vector_type(4)));
typedef float f32x4 __attribute__((ext_vector_type(4)));
typedef short bf16x8 __attribute__((ext_vector_type(8)));
typedef GAS unsigned gu32;
typedef GAS unsigned long long gu64;
#define RLX_AGENT __ATOMIC_RELAXED, __HIP_MEMORY_SCOPE_AGENT
#define LDS_WAIT() asm volatile("s_waitcnt lgkmcnt(0)" ::: "memory")
#define VM_WAIT() asm volatile("s_waitcnt vmcnt(0)" ::: "memory")
__device__ __forceinline__ unsigned long long rt() { return __builtin_amdgcn_s_memrealtime(); }
__device__ __forceinline__ unsigned f2bf(float f) { unsigned u = __builtin_bit_cast(unsigned, f); return (u + 0x7fffu + ((u >> 16) & 1u)) >> 16; }
__device__ __forceinline__ unsigned pk2(float lo, float hi) { return f2bf(lo) | (f2bf(hi) << 16); }
#define XB_TMO      128
#define XB_XCNT(j)  (256  + 64 * (j))
#define XB_XSUB(j)  (1280 + 64 * (j))
#define XB_XGEN(j)  (2304 + 64 * (j))
#define XB_TOP      3328
#define XB_TOPGEN   3392
#define XCD_BAR_WORDS 3456
#define XB_SPIN_CAP (1u << 18)

__device__ __forceinline__ unsigned xb_ld(unsigned* p)              { return __hip_atomic_load(p, __ATOMIC_RELAXED, __HIP_MEMORY_SCOPE_AGENT); }
__device__ __forceinline__ unsigned xb_add(unsigned* p, unsigned v) { return __hip_atomic_fetch_add(p, v, __ATOMIC_RELAXED, __HIP_MEMORY_SCOPE_AGENT); }
__device__ __forceinline__ unsigned xb_xcc_id() { return (unsigned)__builtin_amdgcn_s_getreg((3 << 11) | 20) & 0xFu; }
#define XB_SPIN(cond, bar) do { unsigned _sp = 0; while (cond) { __builtin_amdgcn_s_sleep(1); \
    if ((++_sp & 255u) == 0u) { if (xb_ld(&(bar)[XB_TMO])) break; if (_sp > XB_SPIN_CAP) { atomicAdd(&(bar)[XB_TMO], 1u); break; } } } } while (0)

struct XcdBarrier {
    unsigned* bar; unsigned x;
    volatile LAS unsigned* st;
};

__device__ __forceinline__ XcdBarrier xcd_barrier_post(unsigned* bar, volatile LAS unsigned* st) {
    XcdBarrier b; b.bar = bar; b.x = xb_xcc_id(); b.st = st;
    if (threadIdx.x == 0) (void)xb_add(&bar[XB_XCNT(b.x)], 1u);
    return b;
}
__device__ __forceinline__ void xcd_barrier_complete(unsigned* bar, unsigned x, unsigned& nloc, unsigned& nx) {
    const unsigned G = gridDim.x * gridDim.y * gridDim.z;
    unsigned sum, cnt, mine, sp = 0u;
    for (;;) {
        sum = 0u; cnt = 0u; mine = 0u;
#pragma unroll
        for (unsigned j = 0; j < 16; ++j) { const unsigned c = xb_ld(&bar[XB_XCNT(j)]); sum += c; cnt += (c > 0u) ? 1u : 0u; mine = (j == x) ? c : mine; }
        if (sum == G) break;
        __builtin_amdgcn_s_sleep(1);
        if ((++sp & 255u) == 0u) { if (xb_ld(&bar[XB_TMO])) break; if (sp > XB_SPIN_CAP) { atomicAdd(&bar[XB_TMO], 1u); break; } }
    }
    nloc = mine > 0u ? mine : 1u; nx = cnt > 0u ? cnt : 1u;
}

__device__ __forceinline__ void xcd_barrier(const XcdBarrier& b) {
    asm volatile("s_waitcnt vmcnt(0)" ::: "memory");
    __syncthreads();
    if (threadIdx.x == 0) {
        unsigned* bar = b.bar;
        __builtin_amdgcn_s_waitcnt(0);
        unsigned nloc = b.st[0], nx = b.st[1];
        if (nloc == 0u) { xcd_barrier_complete(bar, b.x, nloc, nx); b.st[0] = nloc; b.st[1] = nx; }
        const unsigned old = xb_add(&bar[XB_XSUB(b.x)], 1u);
        const unsigned gen = old / nloc;
        if (old + 1u == (gen + 1u) * nloc) {
            __builtin_amdgcn_fence(__ATOMIC_RELEASE, "agent");
            asm volatile("s_waitcnt vmcnt(0)" ::: "memory");
            const unsigned og = xb_add(&bar[XB_TOP], 1u);
            const unsigned tg = og / nx;
            if (og + 1u == (tg + 1u) * nx) xb_add(&bar[XB_TOPGEN], 1u);
            else XB_SPIN(xb_ld(&bar[XB_TOPGEN]) == tg, bar);
            __builtin_amdgcn_fence(__ATOMIC_ACQUIRE, "agent");
            xb_add(&bar[XB_XGEN(b.x)], 1u);
            asm volatile("s_waitcnt vmcnt(0)" ::: "memory");
        } else {
            XB_SPIN(xb_ld(&bar[XB_XGEN(b.x)]) == gen, bar);
            __builtin_amdgcn_fence(__ATOMIC_ACQUIRE, "agent");
            asm volatile("s_waitcnt vmcnt(0)" ::: "memory");
        }
    }
    __syncthreads();
}

typedef unsigned v2u __attribute__((ext_vector_type(2)));
struct Frame {
    LAS unsigned char* lds;
    volatile LAS unsigned* MISC;
    gu32* ctl;
    int tid, lane, wave;
    int vcu, G;
    const float* x; const int* pos; const float* gains; const float* w_fi; const float* w_fo; const float* w_mi; const float* sinks; const float* gate_w2; const float* gate_b; const float* gla_gain; const float* w_mo;
    float* out;
    bf16 *WFI, *WFO, *WMI, *WMO, *XN, *ACT, *H, *MIX, *MO;
    float *GLR, *LOGA, *ROPE, *OG;
};
#define RELAUNDER(F) do { int t_ = threadIdx.x; asm volatile("" : "+v"(t_)); (F).tid = t_; (F).lane = t_ & 63; (F).wave = __builtin_amdgcn_readfirstlane(t_ >> 6); } while (0)
__device__ __forceinline__ float wave_sum(float v) {
#pragma unroll
    for (int o = 1; o < 64; o <<= 1) v += __shfl_xor(v, o);
    return v;
}
__device__ __forceinline__ float wave_max(float v) {
#pragma unroll
    for (int o = 1; o < 64; o <<= 1) v = fmaxf(v, __shfl_xor(v, o));
    return v;
}
__device__ __forceinline__ float bf_lo(unsigned w) { return __builtin_bit_cast(float, w << 16); }
__device__ __forceinline__ float bf_hi(unsigned w) { return __builtin_bit_cast(float, w & 0xffff0000u); }
__device__ __forceinline__ float bf1(bf16 h) { return __builtin_bit_cast(float, ((unsigned)h) << 16); }

template <int MODE>
__device__ __forceinline__ void cvt_item(const float* W, int K, int N, bf16* WT, int nb, int kb, int lane) {
    const int nd = nb * 256 + 4 * lane;
    int src = nd; bool valid = true;
    if (MODE == 1) { const int w = 4 * lane; src = ((w >> 7) ? DFF : 0) + nb * 128 + (w & 127); }
    if (MODE == 2) valid = nd < NMIX;
    const float* wp = W + (size_t)(kb * 64) * N + src;
    bf16* op = WT + (size_t)nd * K + kb * 64;
#pragma unroll 1
    for (int ks = 0; ks < 8; ks += 2) {
        f32x4 v[16];
#pragma unroll
        for (int i = 0; i < 16; ++i) v[i] = valid ? *(const f32x4*)(wp + (size_t)(ks * 8 + i) * N) : (f32x4){0.f, 0.f, 0.f, 0.f};
#pragma unroll
        for (int h = 0; h < 2; ++h)
#pragma unroll
            for (int j = 0; j < 4; ++j) {
                v4u o; o.x = pg8::cvt_pk_bf16(v[h * 8 + 0][j], v[h * 8 + 1][j]); o.y = pg8::cvt_pk_bf16(v[h * 8 + 2][j], v[h * 8 + 3][j]);
                o.z = pg8::cvt_pk_bf16(v[h * 8 + 4][j], v[h * 8 + 5][j]); o.w = pg8::cvt_pk_bf16(v[h * 8 + 6][j], v[h * 8 + 7][j]);
                *(v4u*)(op + (size_t)j * K + (ks + h) * 8) = o; }
    }
}
template <bool FIRST>
__device__ __forceinline__ void norm_phase(Frame& F, const float* xsrc, float* xdst, const float* ga, const float* gb, float cres, bool write_xn) {
    RELAUNDER(F);
    const int gw = F.vcu * NWAVES + F.wave, NGW = F.G * NWAVES;
    f32x4 GA[8], GB[8];
#pragma unroll
    for (int j = 0; j < 4; ++j) {
        if (!FIRST) { GA[2 * j] = *(const f32x4*)(ga + 8 * F.lane + 512 * j); GA[2 * j + 1] = *(const f32x4*)(ga + 8 * F.lane + 512 * j + 4); }
        if (write_xn) { GB[2 * j] = *(const f32x4*)(gb + 8 * F.lane + 512 * j); GB[2 * j + 1] = *(const f32x4*)(gb + 8 * F.lane + 512 * j + 4); }
        else { GB[2 * j] = (f32x4){0.f, 0.f, 0.f, 0.f}; GB[2 * j + 1] = (f32x4){0.f, 0.f, 0.f, 0.f}; } }
    for (int m = gw; m < M; m += NGW) {
        const float* xr = xsrc + (size_t)m * D + 8 * F.lane;
        f32x4 xv[8];
#pragma unroll
        for (int j = 0; j < 4; ++j) { xv[2 * j] = *(const f32x4*)(xr + 512 * j); xv[2 * j + 1] = *(const f32x4*)(xr + 512 * j + 4); }
        if (!FIRST) {
            const bf16* hr = F.H + (size_t)m * D + 8 * F.lane;
            v4u hv[4];
#pragma unroll
            for (int j = 0; j < 4; ++j) hv[j] = *(const v4u*)(hr + 512 * j);
            f32x4 hf[8]; float ss = 0.f;
#pragma unroll
            for (int j = 0; j < 4; ++j) {
                hf[2 * j] = (f32x4){bf_lo(hv[j].x), bf_hi(hv[j].x), bf_lo(hv[j].y), bf_hi(hv[j].y)};
                hf[2 * j + 1] = (f32x4){bf_lo(hv[j].z), bf_hi(hv[j].z), bf_lo(hv[j].w), bf_hi(hv[j].w)}; }
#pragma unroll
            for (int j = 0; j < 8; ++j) ss += (hf[j].x * hf[j].x + hf[j].y * hf[j].y) + (hf[j].z * hf[j].z + hf[j].w * hf[j].w);
            const float rs = 1.0f / sqrtf(wave_sum(ss) * (1.0f / D) + NORM_EPS);
            float* xw = xdst + (size_t)m * D + 8 * F.lane;
#pragma unroll
            for (int j = 0; j < 8; ++j) { xv[j] = xv[j] + cres * ((hf[j] * rs) * GA[j]); }
#pragma unroll
            for (int j = 0; j < 4; ++j) { *(f32x4*)(xw + 512 * j) = xv[2 * j]; *(f32x4*)(xw + 512 * j + 4) = xv[2 * j + 1]; }
        }
        if (write_xn) {
            float s2 = 0.f;
#pragma unroll
            for (int j = 0; j < 8; ++j) s2 += (xv[j].x * xv[j].x + xv[j].y * xv[j].y) + (xv[j].z * xv[j].z + xv[j].w * xv[j].w);
            const float r2 = 1.0f / sqrtf(wave_sum(s2) * (1.0f / D) + NORM_EPS);
            bf16* xo = F.XN + (size_t)m * D + 8 * F.lane;
#pragma unroll
            for (int j = 0; j < 4; ++j) { const f32x4 a = (xv[2 * j] * r2) * GB[2 * j], b = (xv[2 * j + 1] * r2) * GB[2 * j + 1];
                v4u o; o.x = pg8::cvt_pk_bf16(a.x, a.y); o.y = pg8::cvt_pk_bf16(a.z, a.w); o.z = pg8::cvt_pk_bf16(b.x, b.y); o.w = pg8::cvt_pk_bf16(b.z, b.w);
                *(v4u*)(xo + 512 * j) = o; }
        }
    }
}
__device__ __forceinline__ void p0_prologue(Frame& F) {
    RELAUNDER(F);
    const int gw = F.vcu * NWAVES + F.wave, NGW = F.G * NWAVES;
    constexpr int PER_FI = (NFF / 256) * (D / 64), PER_FO = (D / 256) * (DFF / 64), PER_MI = (NMIXP / 256) * (D / 64), PER_MO = (D / 256) * (D / 64);
    constexpr int IT_FI = 8 * PER_FI, IT_FO = 8 * PER_FO, IT_MI = 4 * PER_MI, IT_MO = 4 * PER_MO;
    for (int it = gw; it < IT_FI + IT_FO + IT_MI + IT_MO; it += NGW) {
        int r = it;
        if (r < IT_FI) { const int mat = r / PER_FI, q = r % PER_FI, kb = q / (NFF / 256), nb = q % (NFF / 256);
            cvt_item<1>(F.w_fi + (size_t)mat * D * NFF, D, NFF, F.WFI + (size_t)mat * NFF * D, nb, kb, F.lane); continue; } r -= IT_FI;
        if (r < IT_FO) { const int mat = r / PER_FO, q = r % PER_FO, kb = q / (D / 256), nb = q % (D / 256);
            cvt_item<0>(F.w_fo + (size_t)mat * DFF * D, DFF, D, F.WFO + (size_t)mat * D * DFF, nb, kb, F.lane); continue; } r -= IT_FO;
        if (r < IT_MI) { const int mat = r / PER_MI, q = r % PER_MI, kb = q / (NMIXP / 256), nb = q % (NMIXP / 256);
            cvt_item<2>(F.w_mi + (size_t)mat * D * NMIX, D, NMIX, F.WMI + (size_t)mat * NMIXP * D, nb, kb, F.lane); continue; } r -= IT_MI;
        { const int mat = r / PER_MO, q = r % PER_MO, kb = q / (D / 256), nb = q % (D / 256);
            cvt_item<0>(F.w_mo + (size_t)mat * D * D, D, D, F.WMO + (size_t)mat * D * D, nb, kb, F.lane); }
    }
    for (int e = (F.vcu * NWAVES + F.wave) * 64 + F.lane; e < M * 32; e += NGW * 64) {
        const int m = e >> 5, i = e & 31;
        double pw = 1.0; for (int k = 0; k < i; ++k) pw *= 0.7498942093324559;
        const float a = (float)F.pos[m] * (float)pw;
        const double ad = (double)a, k = rint(ad * 0.15915494309189535), r = fma(-k, 6.283185307179586, ad);
        const float rf = (float)r;
        F.ROPE[(size_t)m * 64 + i] = cosf(rf); F.ROPE[(size_t)m * 64 + 32 + i] = sinf(rf);
    }
    norm_phase<true>(F, F.x, nullptr, nullptr, F.gains, 0.f, true);
}

__device__ __forceinline__ void rope8(bf16* p, const f32x4& c0, const f32x4& c1, const f32x4& s0, const f32x4& s1, float scale) {
    const v4u lo = *(const v4u*)p, hi = *(const v4u*)(p + 32);
    const float x1[8] = {bf_lo(lo.x), bf_hi(lo.x), bf_lo(lo.y), bf_hi(lo.y), bf_lo(lo.z), bf_hi(lo.z), bf_lo(lo.w), bf_hi(lo.w)};
    const float x2[8] = {bf_lo(hi.x), bf_hi(hi.x), bf_lo(hi.y), bf_hi(hi.y), bf_lo(hi.z), bf_hi(hi.z), bf_lo(hi.w), bf_hi(hi.w)};
    const float cc[8] = {c0.x, c0.y, c0.z, c0.w, c1.x, c1.y, c1.z, c1.w}, sn[8] = {s0.x, s0.y, s0.z, s0.w, s1.x, s1.y, s1.z, s1.w};
    float o1[8], o2[8];
#pragma unroll
    for (int i = 0; i < 8; ++i) { o1[i] = (x1[i] * cc[i] - x2[i] * sn[i]) * scale; o2[i] = (x2[i] * cc[i] + x1[i] * sn[i]) * scale; }
    v4u a, b; a.x = pg8::cvt_pk_bf16(o1[0], o1[1]); a.y = pg8::cvt_pk_bf16(o1[2], o1[3]); a.z = pg8::cvt_pk_bf16(o1[4], o1[5]); a.w = pg8::cvt_pk_bf16(o1[6], o1[7]);
    b.x = pg8::cvt_pk_bf16(o2[0], o2[1]); b.y = pg8::cvt_pk_bf16(o2[2], o2[3]); b.z = pg8::cvt_pk_bf16(o2[4], o2[5]); b.w = pg8::cvt_pk_bf16(o2[6], o2[7]);
    *(v4u*)p = a; *(v4u*)(p + 32) = b;
}
__device__ __forceinline__ void prep_phase(Frame& F, int l) {
    RELAUNDER(F);
    const int gw = F.vcu * NWAVES + F.wave, NGW = F.G * NWAVES;
    const float* w2 = F.gate_w2 + (size_t)l * 16 * 512 + 8 * F.lane; const float* gb = F.gate_b + (size_t)l * 512 + 8 * F.lane;
    f32x4 W2[16][2];
#pragma unroll
    for (int r = 0; r < 16; ++r) { W2[r][0] = *(const f32x4*)(w2 + r * 512); W2[r][1] = *(const f32x4*)(w2 + r * 512 + 4); }
    const f32x4 B0 = *(const f32x4*)gb, B1 = *(const f32x4*)(gb + 4);
    for (int m = gw; m < M; m += NGW) {
        bf16* row = F.MIX + (size_t)m * MIXLD;
        const float* cs = F.ROPE + (size_t)m * 64;
        { const int head = F.lane >> 2, i0 = 8 * (F.lane & 3);
          const f32x4 c0 = *(const f32x4*)(cs + i0), c1 = *(const f32x4*)(cs + i0 + 4), s0 = *(const f32x4*)(cs + 32 + i0), s1 = *(const f32x4*)(cs + 32 + i0 + 4);
          rope8(row + C_QA + head * 64 + i0, c0, c1, s0, s1, 0.125f);
          if (F.lane < 16) rope8(row + C_KA + head * 64 + i0, c0, c1, s0, s1, 1.0f); }
        { const float* gr = F.GLR + (size_t)m * 16;
          const f32x4 g0 = *(const f32x4*)gr, g1 = *(const f32x4*)(gr + 4), g2 = *(const f32x4*)(gr + 8), g3 = *(const f32x4*)(gr + 12);
          const float g[16] = {g0.x, g0.y, g0.z, g0.w, g1.x, g1.y, g1.z, g1.w, g2.x, g2.y, g2.z, g2.w, g3.x, g3.y, g3.z, g3.w};
          f32x4 z0 = B0, z1 = B1;
#pragma unroll
          for (int r = 0; r < 16; ++r) { z0 = z0 + g[r] * W2[r][0]; z1 = z1 + g[r] * W2[r][1]; }
          float z[8] = {z0.x, z0.y, z0.z, z0.w, z1.x, z1.y, z1.z, z1.w};
#pragma unroll
          for (int e = 0; e < 8; ++e) z[e] = (fminf(z[e], 0.f) - log1pf(expf(-fabsf(z[e])))) * 0.0625f;
          float* lo = F.LOGA + (size_t)m * 512 + 8 * F.lane;
          *(f32x4*)lo = (f32x4){z[0], z[1], z[2], z[3]}; *(f32x4*)(lo + 4) = (f32x4){z[4], z[5], z[6], z[7]}; }
    }
}
__device__ __forceinline__ void attn_naive(Frame& F, int l) {
    RELAUNDER(F);
    const int gw = F.vcu * NWAVES + F.wave, NGW = F.G * NWAVES;
    LAS bf16* qs = (LAS bf16*)(F.lds + RING_OFF + F.wave * 1024);
    const float* sk = F.sinks + l * 16;
    for (int it = gw; it < M * 4; it += NGW) {
        const int m = it >> 2, h = it & 3, t = m & (SEQ - 1);
        const bf16* row = F.MIX + (size_t)m * MIXLD;
        *(LAS v2u*)(qs + 4 * F.lane) = *(const v2u*)(row + C_QA + h * 256 + 4 * F.lane);
        LDS_WAIT();
        float s[2][4]; bool valid[2];
#pragma unroll
        for (int kk = 0; kk < 2; ++kk) {
            const int diff = F.lane + 64 * kk; valid[kk] = (t >= diff);
            const bf16* kr = F.MIX + (size_t)(valid[kk] ? m - diff : m) * MIXLD + C_KA + h * 64;
            float a[4] = {0.f, 0.f, 0.f, 0.f};
#pragma unroll 1
            for (int c = 0; c < 8; ++c) {
                const v4u kv = *(const v4u*)(kr + 8 * c);
                const float kf[8] = {bf_lo(kv.x), bf_hi(kv.x), bf_lo(kv.y), bf_hi(kv.y), bf_lo(kv.z), bf_hi(kv.z), bf_lo(kv.w), bf_hi(kv.w)};
#pragma unroll
                for (int g = 0; g < 4; ++g) { const v4u qv = *(const LAS v4u*)(qs + g * 64 + 8 * c);
                    a[g] += (kf[0] * bf_lo(qv.x) + kf[1] * bf_hi(qv.x)) + (kf[2] * bf_lo(qv.y) + kf[3] * bf_hi(qv.y)) + (kf[4] * bf_lo(qv.z) + kf[5] * bf_hi(qv.z)) + (kf[6] * bf_lo(qv.w) + kf[7] * bf_hi(qv.w)); }
            }
#pragma unroll
            for (int g = 0; g < 4; ++g) s[kk][g] = a[g];
        }
        float p[2][4], inv[4];
#pragma unroll
        for (int g = 0; g < 4; ++g) {
            const float sink = sk[h * 4 + g];
            float mx = fmaxf(valid[0] ? s[0][g] : -INFINITY, valid[1] ? s[1][g] : -INFINITY);
            mx = fmaxf(wave_max(mx), sink);
            p[0][g] = valid[0] ? expf(s[0][g] - mx) : 0.f; p[1][g] = valid[1] ? expf(s[1][g] - mx) : 0.f;
            inv[g] = 1.0f / (wave_sum(p[0][g] + p[1][g]) + expf(sink - mx));
        }
        float acc[4] = {0.f, 0.f, 0.f, 0.f};
        const int nk = (t + 1 < 128) ? t + 1 : 128, n0 = nk < 64 ? nk : 64;
        const bf16* vb = F.MIX + (size_t)m * MIXLD + C_VA + h * 64 + F.lane;
        for (int j = 0; j < n0; ++j) { const float v = bf1(*(vb - (size_t)j * MIXLD));
#pragma unroll
            for (int g = 0; g < 4; ++g) acc[g] += __shfl(p[0][g], j) * v; }
        for (int j = 64; j < nk; ++j) { const float v = bf1(*(vb - (size_t)j * MIXLD));
#pragma unroll
            for (int g = 0; g < 4; ++g) acc[g] += __shfl(p[1][g], j - 64) * v; }
        bf16* op = F.MO + (size_t)m * D + h * 256 + F.lane;
#pragma unroll
        for (int g = 0; g < 4; ++g) op[g * 64] = (bf16)f2bf(acc[g] * inv[g]);
    }
}
__device__ __forceinline__ void gla_naive(Frame& F) {
    RELAUNDER(F);
    LAS float* part = (LAS float*)(F.lds + RING_OFF + 16384);
    for (int u = F.vcu; u < 256; u += F.G) {
        const int b = u >> 7, h = (u >> 5) & 3, cg = u & 31;
        const int dk = F.tid & 127, cp = F.tid >> 7, c0 = cg * 8 + cp * 2;
        float S0 = 0.f, S1 = 0.f;
        for (int t0 = 0; t0 < SEQ; t0 += 64) {
#pragma unroll 1
            for (int tb = 0; tb < 64; tb += 8) {
                float la[8]; bf16 kk[8], qq[8]; unsigned vv[8];
#pragma unroll
                for (int i = 0; i < 8; ++i) { const size_t m = (size_t)b * SEQ + t0 + tb + i;
                    la[i] = F.LOGA[m * 512 + h * 128 + dk]; kk[i] = F.MIX[m * MIXLD + C_KG + h * 128 + dk]; qq[i] = F.MIX[m * MIXLD + C_QG + h * 128 + dk];
                    vv[i] = *(const unsigned*)(F.MIX + m * MIXLD + C_VG + h * 256 + c0); }
#pragma unroll
                for (int i = 0; i < 8; ++i) {
                    const float a = expf(la[i]), k = bf1(kk[i]), q = bf1(qq[i]) * 0.08838834764831845f, v0 = bf_lo(vv[i]), v1 = bf_hi(vv[i]);
                    S0 = a * S0 + k * v0; S1 = a * S1 + k * v1;
                    const float o0 = wave_sum(q * S0), o1 = wave_sum(q * S1);
                    if (F.lane == 0) { part[((tb + i) * 8 + F.wave) * 2] = o0; part[((tb + i) * 8 + F.wave) * 2 + 1] = o1; }
                }
            }
            __syncthreads();
            { const int tt = F.tid >> 3, cc = F.tid & 7, cpp = cc >> 1, e = cc & 1;
              const float o = part[(tt * 8 + 2 * cpp) * 2 + e] + part[(tt * 8 + 2 * cpp + 1) * 2 + e];
              F.OG[((size_t)b * SEQ + t0 + tt) * 1024 + h * 256 + cg * 8 + cc] = o; }
            __syncthreads();
        }
    }
}
__device__ __forceinline__ void gla_fin(Frame& F, int l) {
    RELAUNDER(F);
    const int gw = F.vcu * NWAVES + F.wave, NGW = F.G * NWAVES;
    const f32x4 gv = *(const f32x4*)(F.gla_gain + (size_t)l * 256 + 4 * F.lane);
    for (int it = gw; it < M * 4; it += NGW) {
        const int m = it >> 2, h = it & 3;
        const f32x4 o = *(const f32x4*)(F.OG + (size_t)m * 1024 + h * 256 + 4 * F.lane);
        const float rs = 1.0f / sqrtf(wave_sum((o.x * o.x + o.y * o.y) + (o.z * o.z + o.w * o.w)) * (1.0f / 256.0f) + NORM_EPS);
        const v2u rr = *(const v2u*)(F.MIX + (size_t)m * MIXLD + C_RG + h * 256 + 4 * F.lane);
        const float r[4] = {bf_lo(rr.x), bf_hi(rr.x), bf_lo(rr.y), bf_hi(rr.y)};
        float y[4];
#pragma unroll
        for (int e = 0; e < 4; ++e) y[e] = ((o[e] * rs) * gv[e]) * (r[e] / (1.0f + expf(-r[e])));
        v2u w; w.x = pg8::cvt_pk_bf16(y[0], y[1]); w.y = pg8::cvt_pk_bf16(y[2], y[3]);
        *(v2u*)(F.MO + (size_t)m * D + 1024 + h * 256 + 4 * F.lane) = w;
    }
}

struct Args { const void* in[11]; float* out; unsigned char* ws; };
__global__ void __launch_bounds__(NWAVES * 64, 2) fwd(Args args) {
    extern __shared__ __attribute__((aligned(16))) unsigned char lds[];
    Frame F;
    F.lds = (LAS unsigned char*)lds;
    F.MISC = (volatile LAS unsigned*)(F.lds + MISC_OFF);
    F.tid = threadIdx.x; F.lane = F.tid & 63; F.wave = __builtin_amdgcn_readfirstlane(F.tid >> 6);
    F.G = gridDim.x; { const int bx = blockIdx.x; F.vcu = (F.G % 8 == 0) ? (bx % 8) * (F.G / 8) + bx / 8 : bx; }
    unsigned char* ws = args.ws;
    F.ctl = (gu32*)(ws + WS_CTL);
    F.x = (const float*)args.in[0]; F.pos = (const int*)args.in[1]; F.gains = (const float*)args.in[2]; F.w_fi = (const float*)args.in[3]; F.w_fo = (const float*)args.in[4];
    F.w_mi = (const float*)args.in[5]; F.sinks = (const float*)args.in[6]; F.gate_w2 = (const float*)args.in[7]; F.gate_b = (const float*)args.in[8]; F.gla_gain = (const float*)args.in[9];
    F.w_mo = (const float*)args.in[10]; F.out = args.out;
    F.WFI = (bf16*)(ws + WS_WFI); F.WFO = (bf16*)(ws + WS_WFO); F.WMI = (bf16*)(ws + WS_WMI); F.WMO = (bf16*)(ws + WS_WMO);
    F.XN = (bf16*)(ws + WS_XN); F.ACT = (bf16*)(ws + WS_ACT); F.H = (bf16*)(ws + WS_H); F.MIX = (bf16*)(ws + WS_MIX); F.MO = (bf16*)(ws + WS_MO);
    F.GLR = (float*)(ws + WS_GLR); F.LOGA = (float*)(ws + WS_LOGA); F.ROPE = (float*)(ws + WS_ROPE); F.OG = (float*)(ws + WS_OG);
    for (int u = F.tid; u < (LDS_BYTES - LDSCTL_OFF) / 4; u += NWAVES * 64) ((LAS unsigned*)(F.lds + LDSCTL_OFF))[u] = 0u;
    __syncthreads();
    XcdBarrier bar = xcd_barrier_post((unsigned*)(F.ctl + CW_BAR), F.MISC + 8);

    p0_prologue(F);
    xcd_barrier(bar);

#pragma unroll 1
    for (int l = 0; l < DEPTH; ++l) {
        const float* g = F.gains + (size_t)l * 6 * D;
        { pg8::Gemm gm{F.XN, F.WFI + (size_t)(2 * l) * NFF * D, M, NFF, D}; pg8::StaticOrder S; S.init(M, NFF, F.G, (int)blockIdx.x);
          pg8::EpiSwiGLU E{F.ACT, DFF};
          pg8::gemm_phase<pg8::EpiSwiGLU, pg8::StaticOrder, true, true>(F.lds + RING_OFF, gm, S, E); }
        xcd_barrier(bar);
        { pg8::Gemm gm{F.ACT, F.WFO + (size_t)(2 * l) * D * DFF, M, D, DFF}; pg8::StaticOrder S; S.init(M, D, F.G, (int)blockIdx.x);
          pg8::EpiPlain E{F.H, D};
          pg8::gemm_phase<pg8::EpiPlain, pg8::StaticOrder, true, true>(F.lds + RING_OFF, gm, S, E); }
        xcd_barrier(bar);
        norm_phase<false>(F, l == 0 ? F.x : F.out, F.out, g + 1 * D, g + 2 * D, 0.5f, true);
        xcd_barrier(bar);
        { pg8::Gemm gm{F.XN, F.WMI + (size_t)l * NMIXP * D, M, NMIXP, D}; pg8::StaticOrder S; S.init(M, NMIXP, F.G, (int)blockIdx.x);
          pg8::EpiMix E{F.MIX, MIXLD, F.GLR, MIXLD / 256};
          pg8::gemm_phase<pg8::EpiMix, pg8::StaticOrder, true, true>(F.lds + RING_OFF, gm, S, E); }
        xcd_barrier(bar);
        prep_phase(F, l);
        xcd_barrier(bar);
        gla_naive(F);
        attn_naive(F, l);
        xcd_barrier(bar);
        gla_fin(F, l);
        xcd_barrier(bar);
        { pg8::Gemm gm{F.MO, F.WMO + (size_t)l * D * D, M, D, D}; pg8::StaticOrder S; S.init(M, D, F.G, (int)blockIdx.x);
          pg8::EpiPlain E{F.H, D};
          pg8::gemm_phase<pg8::EpiPlain, pg8::StaticOrder, true, true>(F.lds + RING_OFF, gm, S, E); }
        xcd_barrier(bar);
        norm_phase<false>(F, F.out, F.out, g + 3 * D, g + 4 * D, 1.0f, true);
        xcd_barrier(bar);
        { pg8::Gemm gm{F.XN, F.WFI + (size_t)(2 * l + 1) * NFF * D, M, NFF, D}; pg8::StaticOrder S; S.init(M, NFF, F.G, (int)blockIdx.x);
          pg8::EpiSwiGLU E{F.ACT, DFF};
          pg8::gemm_phase<pg8::EpiSwiGLU, pg8::StaticOrder, true, true>(F.lds + RING_OFF, gm, S, E); }
        xcd_barrier(bar);
        { pg8::Gemm gm{F.ACT, F.WFO + (size_t)(2 * l + 1) * D * DFF, M, D, DFF}; pg8::StaticOrder S; S.init(M, D, F.G, (int)blockIdx.x);
          pg8::EpiPlain E{F.H, D};
          pg8::gemm_phase<pg8::EpiPlain, pg8::StaticOrder, true, true>(F.lds + RING_OFF, gm, S, E); }
        xcd_barrier(bar);
        norm_phase<false>(F, F.out, F.out, g + 5 * D, g + 6 * D  , 0.5f, l + 1 < DEPTH);
        if (l + 1 < DEPTH) xcd_barrier(bar);
    }
}

extern "C" void kernel_launch(void* const* d_in, const int* in_sizes, int n_in, void* d_out, int out_size, void* d_ws, size_t ws_size, hipStream_t stream) {
    static int grid = 0;
    if (grid == 0) {
        if (n_in != 11 || in_sizes[0] != M * D || out_size != M * D || ws_size < WS_END) { fprintf(stderr, "kernel_launch: unexpected shapes (n_in %d, in0 %d, out %d, ws %zu < %zu); nothing launched\n", n_in, n_in > 0 ? in_sizes[0] : -1, out_size, ws_size, (size_t)WS_END); grid = -1; return; }
        int dev = 0, cus = 0, per_cu = 0;
        if (hipGetDevice(&dev) != hipSuccess || hipDeviceGetAttribute(&cus, hipDeviceAttributeMultiprocessorCount, dev) != hipSuccess) { fprintf(stderr, "kernel_launch: device query failed\n"); grid = -1; return; }
        if (hipFuncSetAttribute((const void*)fwd, hipFuncAttributeMaxDynamicSharedMemorySize, LDS_BYTES) != hipSuccess) { fprintf(stderr, "kernel_launch: hipFuncSetAttribute failed\n"); grid = -1; return; }
        if (hipOccupancyMaxActiveBlocksPerMultiprocessor(&per_cu, (const void*)fwd, NWAVES * 64, LDS_BYTES) != hipSuccess || per_cu < 1) { fprintf(stderr, "kernel_launch: occupancy query reports %d workgroups per CU\n", per_cu); }
        (void)hipGetLastError();
        grid = cus;
    }
    if (grid < 0) return;
    if (hipMemsetAsync((char*)d_ws + WS_CTL, 0, CTL_ZERO_BYTES, stream) != hipSuccess) { fprintf(stderr, "kernel_launch: memset failed\n"); return; }
    Args a{};
    for (int i = 0; i < 11; ++i) a.in[i] = d_in[i];
    a.out = (float*)d_out; a.ws = (unsigned char*)d_ws;
    hipLaunchKernelGGL(fwd, dim3(grid), dim3(NWAVES * 64), LDS_BYTES, stream, a);
    const hipError_t le = hipPeekAtLastError();
    if (le != hipSuccess) fprintf(stderr, "kernel_launch: launch failed: %s\n", hipGetErrorName(le));
}
```

```cpp
#include <hip/hip_runtime.h>
#include <cstdio>
#include <cstdint>
#include <cmath>
namespace pg8 {
#define PG8_LAS __attribute__((address_space(3)))
typedef unsigned short bf16_t;
typedef short bf16x8 __attribute__((ext_vector_type(8)));
typedef float f32x4 __attribute__((ext_vector_type(4)));
typedef unsigned u32x4 __attribute__((ext_vector_type(4)));
constexpr int BM = 256, BK = 64, HALF = 128, HTB = HALF * BK * 2  , STAGE_BYTES = 8 * HTB, NXCD = 8, WGM = 8;

__host__ __device__ __forceinline__ int lds_byte(int r, int c) { const int st = (r >> 4) * 2 + (c >> 5), rr = r & 15, cc = c & 31, ob = rr * 64 + cc * 2; return st * 1024 + (ob ^ (((ob >> 9) & 1) << 5)); }
__host__ __device__ __forceinline__ void stage_rc(int b, int& R, int& C) { const int st = b / 1024, sb = b % 1024, swz = sb ^ (((sb >> 9) & 1) << 5); R = (st >> 1) * 16 + swz / 64; C = (st & 1) * 32 + (swz % 64) / 2; }
__host__ __device__ __forceinline__ int perm32(int rho) { const int n = rho >> 4, i = rho & 15; return 8 * (i >> 2) + 4 * n + (i & 3); }

struct Unit { int pm, pn; };
struct Gemm { const bf16_t* A; const bf16_t* Bt; int M, N, K; };

struct StaticOrder {
    int nM, nN, nwg, G, c;
    __host__ __device__ void init(int M, int N, int G_, int c_) { nM = M / BM; nN = N / BM; nwg = nM * nN; G = G_; c = c_; }
    __host__ __device__ bool next(int i, Unit& u) const {
        const long L = (long)i * G + c; if (L >= nwg) return false;
        int wgid = (int)L; { const int q = nwg / NXCD, r = nwg % NXCD, xcd = wgid % NXCD, off = wgid / NXCD; wgid = (xcd < r ? xcd * (q + 1) : r * (q + 1) + (xcd - r) * q) + off; }
        const int nig = WGM * nN, gid = wgid / nig, fm = gid * WGM, gsz = (nM - fm) < WGM ? (nM - fm) : WGM;
        u.pm = fm + ((wgid % nig) % gsz); u.pn = (wgid % nig) / gsz; return true;
    }
    __device__ __forceinline__ void a_ready(const Unit&) const {}
    __device__ __forceinline__ void done(const Unit&) const {}
};

__device__ __forceinline__ unsigned cvt_pk_bf16(float lo, float hi) { unsigned r; asm volatile("v_cvt_pk_bf16_f32 %0, %1, %2" : "=v"(r) : "v"(lo), "v"(hi)); return r; }
typedef float f32x2 __attribute__((ext_vector_type(2)));

__device__ __forceinline__ float silu_f(float g) { return g * __builtin_amdgcn_rcpf(1.0f + __builtin_amdgcn_exp2f(-1.4426950408889634f * g)); }
struct EpiSwiGLU {
    static constexpr bool PERM = true, AFTER_DRAIN = false;
    bf16_t* O; int ldc;
    __device__ __forceinline__ void operator()(const f32x4 (&acc)[2][2][4][2], const Unit& u, int wr, int wc, int fr, int fq) const {
        const int row0 = u.pm * BM + wr * 64 + fr, col0 = u.pn * HALF + wc * 32 + 8 * fq;
#pragma unroll
        for (int ai = 0; ai < 2; ++ai)
#pragma unroll
            for (int m = 0; m < 4; ++m) { bf16_t* rowp = O + (size_t)(row0 + ai * HALF + m * 16) * ldc + col0;
                const f32x4 g0 = acc[ai][0][m][0], g1 = acc[ai][0][m][1], u0 = acc[ai][1][m][0], u1 = acc[ai][1][m][1];
                u32x4 w; w.x = cvt_pk_bf16(silu_f(g0[0]) * u0[0], silu_f(g0[1]) * u0[1]); w.y = cvt_pk_bf16(silu_f(g0[2]) * u0[2], silu_f(g0[3]) * u0[3]);
                w.z = cvt_pk_bf16(silu_f(g1[0]) * u1[0], silu_f(g1[1]) * u1[1]); w.w = cvt_pk_bf16(silu_f(g1[2]) * u1[2], silu_f(g1[3]) * u1[3]);
                *(u32x4*)rowp = w; }
    }
};
struct EpiPlain {
    static constexpr bool PERM = true, AFTER_DRAIN = false;
    bf16_t* O; int ldc;
    __device__ __forceinline__ void operator()(const f32x4 (&acc)[2][2][4][2], const Unit& u, int wr, int wc, int fr, int fq) const {
        const int row0 = u.pm * BM + wr * 64 + fr, col0 = u.pn * BM + wc * 32 + 8 * fq;
#pragma unroll
        for (int ai = 0; ai < 2; ++ai)
#pragma unroll
            for (int m = 0; m < 4; ++m) { bf16_t* rowp = O + (size_t)(row0 + ai * HALF + m * 16) * ldc + col0;
#pragma unroll
                for (int bj = 0; bj < 2; ++bj) { const f32x4 v0 = acc[ai][bj][m][0], v1 = acc[ai][bj][m][1];
                    u32x4 w; w.x = cvt_pk_bf16(v0[0], v0[1]); w.y = cvt_pk_bf16(v0[2], v0[3]); w.z = cvt_pk_bf16(v1[0], v1[1]); w.w = cvt_pk_bf16(v1[2], v1[3]);
                    *(u32x4*)(rowp + bj * HALF) = w; } }
    }
};
struct EpiMix {
    static constexpr bool PERM = true, AFTER_DRAIN = false;
    bf16_t* O; int ldc; float* G; int npl;
    __device__ __forceinline__ void operator()(const f32x4 (&acc)[2][2][4][2], const Unit& u, int wr, int wc, int fr, int fq) const {
        const int row0 = u.pm * BM + wr * 64 + fr;
        if (u.pn < npl) {
            const int col0 = u.pn * BM + wc * 32 + 8 * fq;
#pragma unroll
            for (int ai = 0; ai < 2; ++ai)
#pragma unroll
                for (int m = 0; m < 4; ++m) { bf16_t* rowp = O + (size_t)(row0 + ai * HALF + m * 16) * ldc + col0;
#pragma unroll
                    for (int bj = 0; bj < 2; ++bj) { const f32x4 v0 = acc[ai][bj][m][0], v1 = acc[ai][bj][m][1];
                        u32x4 w; w.x = cvt_pk_bf16(v0[0], v0[1]); w.y = cvt_pk_bf16(v0[2], v0[3]); w.z = cvt_pk_bf16(v1[0], v1[1]); w.w = cvt_pk_bf16(v1[2], v1[3]);
                        *(u32x4*)(rowp + bj * HALF) = w; } }
        } else if (wc == 0 && fq < 2) {
#pragma unroll
            for (int ai = 0; ai < 2; ++ai)
#pragma unroll
                for (int m = 0; m < 4; ++m) { float* rowp = G + (size_t)(row0 + ai * HALF + m * 16) * 16 + 8 * fq;
                    *(f32x4*)rowp = acc[ai][0][m][0]; *(f32x4*)(rowp + 4) = acc[ai][0][m][1]; }
        }
    }
};
template <class Epi, class Sched, bool ALIGN_EPI = false, bool SP2 = false>
__device__ __forceinline__ void gemm_phase(PG8_LAS unsigned char* lds, const Gemm g, const Sched& S, const Epi& E) {
    int tid_ = threadIdx.x; asm volatile("" : "+v"(tid_));
    const int tid = tid_, wid = __builtin_amdgcn_readfirstlane(tid >> 6), lane = tid & 63, wr = wid >> 2, wc = wid & 3, fr = lane & 15, fq = lane >> 4;
    int K_ = g.K; asm volatile("" : "+s"(K_));
    const int K = K_, nt = K / BK;
    unsigned voffA[2], voffB[2];
#pragma unroll
    for (int i = 0; i < 2; ++i) { int R, C; stage_rc(tid * 16 + i * 8192, R, C); const int Rb = Epi::PERM ? ((R & ~31) + perm32(R & 31)) : R;
        voffA[i] = (unsigned)(R * K + C) * 2u; voffB[i] = (unsigned)(Rb * K + C) * 2u; }
    const size_t kstep = (size_t)(BK * 2);
    const size_t hstep = (size_t)HALF * K * 2;
    const size_t tstep = 2 * hstep;
    const unsigned ldsw = (unsigned)wid * 1024u;
    const int aoff = lds_byte(wr * 64 + fr, fq * 8), boff = lds_byte(wc * 32 + fr, fq * 8);
#define PG8_SA(b, h) (((b) * 2 + (h)) * HTB)
#define PG8_SB(b, h) ((4 + (b) * 2 + (h)) * HTB)
#define PG8_STAGE(bufoff, gbase, voff) do { _Pragma("unroll") for (int _i = 0; _i < 2; ++_i) \
        __builtin_amdgcn_global_load_lds((const unsigned*)((const char*)(gbase) + (voff)[_i]), (PG8_LAS unsigned*)(lds + (bufoff) + ldsw + _i * 8192), 16, 0, 0); } while (0)
#define PG8_LDA(dst, b, h) do { _Pragma("unroll") for (int m = 0; m < 4; ++m) _Pragma("unroll") for (int k = 0; k < 2; ++k) dst[m][k] = *(const PG8_LAS bf16x8*)(lds + PG8_SA(b, h) + aoff + m * 2048 + k * 1024); } while (0)
#define PG8_LDB(dst, b, h) do { _Pragma("unroll") for (int n = 0; n < 2; ++n) _Pragma("unroll") for (int k = 0; k < 2; ++k) dst[n][k] = *(const PG8_LAS bf16x8*)(lds + PG8_SB(b, h) + boff + n * 2048 + k * 1024); } while (0)
#define PG8_MMA(ai, bj, At, Bt) do { __builtin_amdgcn_s_setprio(1); _Pragma("unroll") for (int m = 0; m < 4; ++m) _Pragma("unroll") for (int n = 0; n < 2; ++n) _Pragma("unroll") for (int k = 0; k < 2; ++k) \
        acc[ai][bj][m][n] = __builtin_amdgcn_mfma_f32_16x16x32_bf16(Bt[n][k], At[m][k], acc[ai][bj][m][n], 0, 0, 0); __builtin_amdgcn_s_setprio(0); } while (0)
#define PG8_WAIT_V(n) asm volatile("s_waitcnt vmcnt(" #n ")" ::: "memory")
#define PG8_WAIT_L(n) asm volatile("s_waitcnt lgkmcnt(" #n ")" ::: "memory")
#define PG8_BAR __builtin_amdgcn_s_barrier()
#define PG8_SCHED __builtin_amdgcn_sched_barrier(0)
    Unit cur, nxt; int ui = 0;
    if (!S.next(0, cur)) return;
    f32x4 acc[2][2][4][2];
#pragma unroll
    for (int a = 0; a < 2; ++a)
#pragma unroll
        for (int b = 0; b < 2; ++b)
#pragma unroll
            for (int m = 0; m < 4; ++m)
#pragma unroll
                for (int n = 0; n < 2; ++n) acc[a][b][m][n] = (f32x4){0.f, 0.f, 0.f, 0.f};
    bf16x8 At[4][2], B0[2][2], B1[2][2];
    const char* cA = (const char*)g.A + (size_t)cur.pm * tstep; const char* cB = (const char*)g.Bt + (size_t)cur.pn * tstep;
    S.a_ready(cur);
    if constexpr (SP2) {
        PG8_STAGE(PG8_SB(0, 0), cB, voffB); PG8_STAGE(PG8_SB(0, 1), cB + hstep, voffB); PG8_STAGE(PG8_SA(0, 0), cA, voffA); PG8_STAGE(PG8_SA(0, 1), cA + hstep, voffA);
        if (wr == 1) PG8_BAR;
        PG8_WAIT_V(2); PG8_BAR;
        PG8_STAGE(PG8_SB(1, 0), cB + kstep, voffB); PG8_STAGE(PG8_SA(1, 0), cA + kstep, voffA); PG8_STAGE(PG8_SB(1, 1), cB + hstep + kstep, voffB);
        PG8_WAIT_V(6); PG8_BAR;
    } else {
        PG8_STAGE(PG8_SB(0, 0), cB, voffB); PG8_STAGE(PG8_SA(0, 0), cA, voffA); PG8_STAGE(PG8_SB(0, 1), cB + hstep, voffB); PG8_STAGE(PG8_SA(0, 1), cA + hstep, voffA);
        if (wr == 1) PG8_BAR;
        PG8_WAIT_V(4); PG8_BAR;
        PG8_STAGE(PG8_SB(1, 0), cB + kstep, voffB); PG8_STAGE(PG8_SA(1, 0), cA + kstep, voffA); PG8_STAGE(PG8_SB(1, 1), cB + hstep + kstep, voffB);
        PG8_WAIT_V(6); PG8_BAR;
    }
    for (;;) {
        const bool has_next = S.next(ui + 1, nxt);
        const char* nA = has_next ? (const char*)g.A + (size_t)nxt.pm * tstep : cA; const char* nB = has_next ? (const char*)g.Bt + (size_t)nxt.pn * tstep : cB;
        for (int t = 0; t < nt; t += 2) {
            const bool last = (t == nt - 2);
            const char* a1 = cA + (size_t)(t + 1) * kstep;
            const char* a2 = last ? nA : cA + (size_t)(t + 2) * kstep; const char* b2 = last ? nB : cB + (size_t)(t + 2) * kstep;
            const char* a3 = a2 + kstep; const char* b3 = b2 + kstep;
            if (last && has_next) S.a_ready(nxt);
            if constexpr (SP2) {
            PG8_LDB(B0, 0, 0); PG8_LDB(B1, 0, 1); PG8_SCHED; PG8_LDA(At, 0, 0); PG8_STAGE(PG8_SA(1, 1), a1 + hstep, voffA);
            PG8_WAIT_V(8); PG8_WAIT_L(0); PG8_BAR; PG8_MMA(0, 0, At, B0); PG8_MMA(0, 1, At, B1); PG8_BAR; PG8_SCHED;
            PG8_LDA(At, 0, 1); PG8_STAGE(PG8_SB(0, 0), b2, voffB); PG8_STAGE(PG8_SB(0, 1), b2 + hstep, voffB); PG8_STAGE(PG8_SA(0, 0), a2, voffA);
            PG8_WAIT_V(8); PG8_WAIT_L(0); PG8_BAR; PG8_MMA(1, 0, At, B0); PG8_MMA(1, 1, At, B1); PG8_BAR; PG8_SCHED;
            PG8_LDB(B0, 1, 0); PG8_LDB(B1, 1, 1); PG8_SCHED; PG8_LDA(At, 1, 0); PG8_STAGE(PG8_SA(0, 1), a2 + hstep, voffA);
            PG8_WAIT_V(8); PG8_WAIT_L(0); PG8_BAR; PG8_MMA(0, 0, At, B0); PG8_MMA(0, 1, At, B1); PG8_BAR; PG8_SCHED;
            PG8_LDA(At, 1, 1); PG8_STAGE(PG8_SB(1, 0), b3, voffB); PG8_STAGE(PG8_SB(1, 1), b3 + hstep, voffB); PG8_STAGE(PG8_SA(1, 0), a3, voffA);
            PG8_WAIT_V(8); PG8_WAIT_L(0); PG8_BAR; PG8_MMA(1, 0, At, B0); PG8_MMA(1, 1, At, B1); PG8_BAR; PG8_SCHED;
            } else {
            PG8_LDB(B0, 0, 0); PG8_SCHED; PG8_LDA(At, 0, 0); PG8_STAGE(PG8_SA(1, 1), a1 + hstep, voffA);
            PG8_WAIT_L(8); PG8_BAR; PG8_WAIT_L(0); PG8_MMA(0, 0, At, B0); PG8_BAR; PG8_SCHED;
            PG8_LDB(B1, 0, 1); PG8_STAGE(PG8_SB(0, 0), b2, voffB);
            PG8_BAR; PG8_WAIT_L(0); PG8_MMA(0, 1, At, B1); PG8_BAR;
            PG8_LDA(At, 0, 1); PG8_STAGE(PG8_SA(0, 0), a2, voffA);
            PG8_BAR; PG8_WAIT_L(0); PG8_MMA(1, 0, At, B0); PG8_BAR; PG8_SCHED;
            PG8_STAGE(PG8_SB(0, 1), b2 + hstep, voffB);
            PG8_WAIT_V(6); PG8_BAR; PG8_MMA(1, 1, At, B1); PG8_BAR;
            PG8_LDB(B0, 1, 0); PG8_SCHED; PG8_LDA(At, 1, 0); PG8_STAGE(PG8_SA(0, 1), a2 + hstep, voffA);
            PG8_WAIT_L(8); PG8_BAR; PG8_WAIT_L(0); PG8_MMA(0, 0, At, B0); PG8_BAR; PG8_SCHED;
            PG8_LDB(B1, 1, 1); PG8_STAGE(PG8_SB(1, 0), b3, voffB);
            PG8_BAR; PG8_WAIT_L(0); PG8_MMA(0, 1, At, B1); PG8_BAR;
            PG8_LDA(At, 1, 1); PG8_STAGE(PG8_SA(1, 0), a3, voffA);
            PG8_BAR; PG8_WAIT_L(0); PG8_MMA(1, 0, At, B0); PG8_BAR; PG8_SCHED;
            PG8_STAGE(PG8_SB(1, 1), b3 + hstep, voffB);
            PG8_WAIT_V(6); PG8_BAR; PG8_MMA(1, 1, At, B1); PG8_BAR;
            }
        }
        if constexpr (ALIGN_EPI) { if (wr == 0) PG8_BAR; }
        if constexpr (!Epi::AFTER_DRAIN) { E(acc, cur, wr, wc, fr, fq); S.done(cur); }
        if (!has_next) break;
#pragma unroll
        for (int a = 0; a < 2; ++a)
#pragma unroll
            for (int b = 0; b < 2; ++b)
#pragma unroll
                for (int m = 0; m < 4; ++m)
#pragma unroll
                    for (int n = 0; n < 2; ++n) acc[a][b][m][n] = (f32x4){0.f, 0.f, 0.f, 0.f};
        cur = nxt; cA = nA; cB = nB; ++ui;
        if constexpr (ALIGN_EPI) { if (wr == 1) PG8_BAR; }
    }
    PG8_WAIT_V(0);
    if constexpr (!ALIGN_EPI) { if (wr == 0) PG8_BAR; }
    PG8_BAR;
    if constexpr (Epi::AFTER_DRAIN) { E.fused(acc, cur, wr, wc, fr, fq, lds, wid, lane); S.done(cur); }
#undef PG8_SA
#undef PG8_SB
#undef PG8_STAGE
#undef PG8_LDA
#undef PG8_LDB
#undef PG8_MMA
#undef PG8_WAIT_V
#undef PG8_WAIT_L
#undef PG8_BAR
#undef PG8_SCHED
}
}

constexpr int NWAVES = 8;
constexpr int BATCH = 2, SEQ = 8192, M = BATCH * SEQ, D = 2048, DEPTH = 4;
constexpr int DFF = 5504, NFF = 2 * DFF;
constexpr int NMIX = 4624, NMIXP = 4864, MIXLD = 4608;
constexpr int C_QA = 0, C_KA = 1024, C_VA = 1280, C_QG = 1536, C_KG = 2048, C_VG = 2560, C_RG = 3584;
constexpr float NORM_EPS = 1e-6f;

constexpr size_t MiB = 1u << 20;
constexpr size_t WS_CTL = 0, CTL_ZERO_BYTES = 1 * MiB;
constexpr size_t SZ_WFI = (size_t)8 * NFF * D * 2, SZ_WFO = (size_t)8 * D * DFF * 2, SZ_WMI = (size_t)4 * NMIXP * D * 2, SZ_WMO = (size_t)4 * D * D * 2;
constexpr size_t WS_WFI = 2 * MiB;
constexpr size_t WS_WFO = WS_WFI + SZ_WFI;
constexpr size_t WS_WMI = WS_WFO + SZ_WFO;
constexpr size_t WS_WMO = WS_WMI + SZ_WMI;
constexpr size_t WS_XN  = WS_WMO + SZ_WMO;
constexpr size_t WS_ACT = WS_XN + (size_t)M * D * 2;
constexpr size_t WS_H   = WS_ACT + (size_t)M * DFF * 2;
constexpr size_t WS_MIX = WS_H + (size_t)M * D * 2;
constexpr size_t WS_GLR = WS_MIX + (size_t)M * MIXLD * 2;
constexpr size_t WS_LOGA = WS_GLR + (size_t)M * 16 * 4;
constexpr size_t WS_ROPE = WS_LOGA + (size_t)M * 512 * 4;
constexpr size_t WS_MO  = WS_ROPE + (size_t)M * 64 * 4;
constexpr size_t WS_OG  = WS_MO + (size_t)M * D * 2;
constexpr size_t WS_BC  = WS_OG + (size_t)M * 1024 * 4;
constexpr size_t WS_DEC = WS_BC + (size_t)M * 512 * 4;
constexpr size_t WS_DS  = WS_DEC + (size_t)1024 * 128 * 4;
constexpr size_t WS_ST  = WS_DS + (size_t)1024 * 32768 * 4;
constexpr size_t WS_END = WS_ST + (size_t)1024 * 32768 * 2;
static_assert(WS_WFI % 256 == 0 && WS_WFO % 256 == 0 && WS_WMI % 256 == 0 && WS_WMO % 256 == 0 && WS_XN % 256 == 0 && WS_ACT % 256 == 0 && WS_H % 256 == 0 && WS_MIX % 256 == 0 && WS_GLR % 256 == 0 && WS_LOGA % 256 == 0 && WS_ROPE % 256 == 0 && WS_MO % 256 == 0 && WS_OG % 256 == 0 && WS_BC % 256 == 0 && WS_DEC % 256 == 0 && WS_DS % 256 == 0 && WS_ST % 256 == 0, "alignment");
constexpr int CW_BAR = 4096;

constexpr int RING_OFF = 0, RING_BYTES = 131072;
constexpr int LDSCTL_OFF = RING_BYTES, MISC_OFF = LDSCTL_OFF + 320;
constexpr int LDS_BYTES = 147456;
static_assert(MISC_OFF + 128 <= LDS_BYTES, "LDS map");
constexpr int G_KT = 0;
constexpr int G_VT = 18432;
constexpr int G_SEG = 55296;
constexpr int G3_QD = 57344;
constexpr int G3_KD = 74752;
constexpr int G3_IN = 92160;
constexpr int G3_SS = 101376;
static_assert(G3_SS + 2048 <= RING_BYTES, "GLA LDS map");
#define GAS __attribute__((address_space(1)))
#define LAS __attribute__((address_space(3)))
typedef unsigned short bf16;
typedef unsigned v4u __attribute__((ext_vector_type(4)));
typedef float f32x4 __attribute__((ext_vector_type(4)));
typedef short bf16x8 __attribute__((ext_vector_type(8)));
typedef GAS unsigned gu32;
typedef GAS unsigned long long gu64;
#define RLX_AGENT __ATOMIC_RELAXED, __HIP_MEMORY_SCOPE_AGENT
#define LDS_WAIT() asm volatile("s_waitcnt lgkmcnt(0)" ::: "memory")
#define VM_WAIT() asm volatile("s_waitcnt vmcnt(0)" ::: "memory")
__device__ __forceinline__ unsigned long long rt() { return __builtin_amdgcn_s_memrealtime(); }
__device__ __forceinline__ unsigned f2bf(float f) { unsigned u = __builtin_bit_cast(unsigned, f); return (u + 0x7fffu + ((u >> 16) & 1u)) >> 16; }
__device__ __forceinline__ unsigned pk2(float lo, float hi) { return f2bf(lo) | (f2bf(hi) << 16); }
#define XB_TMO      128
#define XB_XCNT(j)  (256  + 64 * (j))
#define XB_XSUB(j)  (1280 + 64 * (j))
#define XB_XGEN(j)  (2304 + 64 * (j))
#define XB_TOP      3328
#define XB_TOPGEN   3392
#define XCD_BAR_WORDS 3456
#define XB_SPIN_CAP (1u << 18)

__device__ __forceinline__ unsigned xb_ld(unsigned* p)              { return __hip_atomic_load(p, __ATOMIC_RELAXED, __HIP_MEMORY_SCOPE_AGENT); }
__device__ __forceinline__ unsigned xb_add(unsigned* p, unsigned v) { return __hip_atomic_fetch_add(p, v, __ATOMIC_RELAXED, __HIP_MEMORY_SCOPE_AGENT); }
__device__ __forceinline__ unsigned xb_xcc_id() { return (unsigned)__builtin_amdgcn_s_getreg((3 << 11) | 20) & 0xFu; }
#define XB_SPIN(cond, bar) do { unsigned _sp = 0; while (cond) { __builtin_amdgcn_s_sleep(1); \
    if ((++_sp & 255u) == 0u) { if (xb_ld(&(bar)[XB_TMO])) break; if (_sp > XB_SPIN_CAP) { atomicAdd(&(bar)[XB_TMO], 1u); break; } } } } while (0)

struct XcdBarrier {
    unsigned* bar; unsigned x;
    volatile LAS unsigned* st;
};

__device__ __forceinline__ XcdBarrier xcd_barrier_post(unsigned* bar, volatile LAS unsigned* st) {
    XcdBarrier b; b.bar = bar; b.x = xb_xcc_id(); b.st = st;
    if (threadIdx.x == 0) (void)xb_add(&bar[XB_XCNT(b.x)], 1u);
    return b;
}
__device__ __forceinline__ void xcd_barrier_complete(unsigned* bar, unsigned x, unsigned& nloc, unsigned& nx) {
    const unsigned G = gridDim.x * gridDim.y * gridDim.z;
    unsigned sum, cnt, mine, sp = 0u;
    for (;;) {
        sum = 0u; cnt = 0u; mine = 0u;
#pragma unroll
        for (unsigned j = 0; j < 16; ++j) { const unsigned c = xb_ld(&bar[XB_XCNT(j)]); sum += c; cnt += (c > 0u) ? 1u : 0u; mine = (j == x) ? c : mine; }
        if (sum == G) break;
        __builtin_amdgcn_s_sleep(1);
        if ((++sp & 255u) == 0u) { if (xb_ld(&bar[XB_TMO])) break; if (sp > XB_SPIN_CAP) { atomicAdd(&bar[XB_TMO], 1u); break; } }
    }
    nloc = mine > 0u ? mine : 1u; nx = cnt > 0u ? cnt : 1u;
}

__device__ __forceinline__ void xcd_barrier(const XcdBarrier& b) {
    asm volatile("s_waitcnt vmcnt(0)" ::: "memory");
    __syncthreads();
    if (threadIdx.x == 0) {
        unsigned* bar = b.bar;
        __builtin_amdgcn_s_waitcnt(0);
        unsigned nloc = b.st[0], nx = b.st[1];
        if (nloc == 0u) { xcd_barrier_complete(bar, b.x, nloc, nx); b.st[0] = nloc; b.st[1] = nx; }
        const unsigned old = xb_add(&bar[XB_XSUB(b.x)], 1u);
        const unsigned gen = old / nloc;
        if (old + 1u == (gen + 1u) * nloc) {
            __builtin_amdgcn_fence(__ATOMIC_RELEASE, "agent");
            asm volatile("s_waitcnt vmcnt(0)" ::: "memory");
            const unsigned og = xb_add(&bar[XB_TOP], 1u);
            const unsigned tg = og / nx;
            if (og + 1u == (tg + 1u) * nx) xb_add(&bar[XB_TOPGEN], 1u);
            else XB_SPIN(xb_ld(&bar[XB_TOPGEN]) == tg, bar);
            __builtin_amdgcn_fence(__ATOMIC_ACQUIRE, "agent");
            xb_add(&bar[XB_XGEN(b.x)], 1u);
            asm volatile("s_waitcnt vmcnt(0)" ::: "memory");
        } else {
            XB_SPIN(xb_ld(&bar[XB_XGEN(b.x)]) == gen, bar);
            __builtin_amdgcn_fence(__ATOMIC_ACQUIRE, "agent");
            asm volatile("s_waitcnt vmcnt(0)" ::: "memory");
        }
    }
    __syncthreads();
}

typedef unsigned v2u __attribute__((ext_vector_type(2)));
typedef float v2f __attribute__((ext_vector_type(2)));
struct Frame {
    LAS unsigned char* lds;
    volatile LAS unsigned* MISC;
    gu32* ctl;
    int tid, lane, wave;
    int vcu, G;
    const float* x; const int* pos; const float* gains; const float* w_fi; const float* w_fo; const float* w_mi; const float* sinks; const float* gate_w2; const float* gate_b; const float* gla_gain; const float* w_mo;
    float* out;
    bf16 *WFI, *WFO, *WMI, *WMO, *XN, *ACT, *H, *MIX, *MO;
    float *GLR, *LOGA, *ROPE, *OG, *BC, *DEC, *DS; bf16* ST;
};
#define RELAUNDER(F) do { int t_ = threadIdx.x; asm volatile("" : "+v"(t_)); (F).tid = t_; (F).lane = t_ & 63; (F).wave = __builtin_amdgcn_readfirstlane(t_ >> 6); \
    const __attribute__((address_space(4))) char* kb_ = (const __attribute__((address_space(4))) char*)__builtin_amdgcn_kernarg_segment_ptr(); asm volatile("" : "+s"(kb_)); \
    GAS void* const __attribute__((address_space(4)))* ka_ = (GAS void* const __attribute__((address_space(4)))*)kb_;     \
    (F).x = (const float*)ka_[0]; (F).pos = (const int*)ka_[1]; (F).gains = (const float*)ka_[2]; (F).w_fi = (const float*)ka_[3]; (F).w_fo = (const float*)ka_[4]; (F).w_mi = (const float*)ka_[5]; \
    (F).sinks = (const float*)ka_[6]; (F).gate_w2 = (const float*)ka_[7]; (F).gate_b = (const float*)ka_[8]; (F).gla_gain = (const float*)ka_[9]; (F).w_mo = (const float*)ka_[10]; (F).out = (float*)ka_[11]; \
    unsigned char* ws_ = (unsigned char*)ka_[12]; \
    (F).WFI = (bf16*)(ws_ + WS_WFI); (F).WFO = (bf16*)(ws_ + WS_WFO); (F).WMI = (bf16*)(ws_ + WS_WMI); (F).WMO = (bf16*)(ws_ + WS_WMO); \
    (F).XN = (bf16*)(ws_ + WS_XN); (F).ACT = (bf16*)(ws_ + WS_ACT); (F).H = (bf16*)(ws_ + WS_H); (F).MIX = (bf16*)(ws_ + WS_MIX); (F).MO = (bf16*)(ws_ + WS_MO); \
    (F).GLR = (float*)(ws_ + WS_GLR); (F).LOGA = (float*)(ws_ + WS_LOGA); (F).ROPE = (float*)(ws_ + WS_ROPE); (F).OG = (float*)(ws_ + WS_OG); (F).BC = (float*)(ws_ + WS_BC); (F).DEC = (float*)(ws_ + WS_DEC); (F).DS = (float*)(ws_ + WS_DS); (F).ST = (bf16*)(ws_ + WS_ST); } while (0)
__device__ __forceinline__ float wave_sum(float v) {
#pragma unroll
    for (int o = 1; o < 64; o <<= 1) v += __shfl_xor(v, o);
    return v;
}
__device__ __forceinline__ float wave_max(float v) {
#pragma unroll
    for (int o = 1; o < 64; o <<= 1) v = fmaxf(v, __shfl_xor(v, o));
    return v;
}
__device__ __forceinline__ float bf_lo(unsigned w) { return __builtin_bit_cast(float, w << 16); }
__device__ __forceinline__ float bf_hi(unsigned w) { return __builtin_bit_cast(float, w & 0xffff0000u); }
__device__ __forceinline__ float bf1(bf16 h) { return __builtin_bit_cast(float, ((unsigned)h) << 16); }

template <int MODE>
__device__ __forceinline__ void cvt_item(const float* W, int K, int N, bf16* WT, int nb, int kb, int lane) {
    const int nd = nb * 256 + 4 * lane;
    int src = nd; bool valid = true;
    if (MODE == 1) { const int w = 4 * lane; src = ((w >> 7) ? DFF : 0) + nb * 128 + (w & 127); }
    if (MODE == 2) valid = nd < NMIX;
    const float* wp = W + (size_t)(kb * 64) * N + src;
    bf16* op = WT + (size_t)nd * K + kb * 64;
#pragma unroll 1
    for (int ks = 0; ks < 8; ks += 2) {
        f32x4 v[16];
#pragma unroll
        for (int i = 0; i < 16; ++i) v[i] = valid ? *(const f32x4*)(wp + (size_t)(ks * 8 + i) * N) : (f32x4){0.f, 0.f, 0.f, 0.f};
#pragma unroll
        for (int h = 0; h < 2; ++h)
#pragma unroll
            for (int j = 0; j < 4; ++j) {
                v4u o; o.x = pg8::cvt_pk_bf16(v[h * 8 + 0][j], v[h * 8 + 1][j]); o.y = pg8::cvt_pk_bf16(v[h * 8 + 2][j], v[h * 8 + 3][j]);
                o.z = pg8::cvt_pk_bf16(v[h * 8 + 4][j], v[h * 8 + 5][j]); o.w = pg8::cvt_pk_bf16(v[h * 8 + 6][j], v[h * 8 + 7][j]);
                *(v4u*)(op + (size_t)j * K + (ks + h) * 8) = o; }
    }
}
template <bool FIRST>
__device__ __forceinline__ void norm_phase(Frame& F, bool from_input, int ia, int ib, float cres, bool write_xn) {
    RELAUNDER(F);
    const float* xsrc = from_input ? F.x : F.out; float* xdst = F.out; const float* ga = F.gains + (size_t)ia * D; const float* gb = F.gains + (size_t)ib * D;
    const int gw = F.vcu * NWAVES + F.wave, NGW = F.G * NWAVES;
    f32x4 GA[8], GB[8];
#pragma unroll
    for (int j = 0; j < 4; ++j) {
        if (!FIRST) { GA[2 * j] = *(const f32x4*)(ga + 8 * F.lane + 512 * j); GA[2 * j + 1] = *(const f32x4*)(ga + 8 * F.lane + 512 * j + 4); }
        if (write_xn) { GB[2 * j] = *(const f32x4*)(gb + 8 * F.lane + 512 * j); GB[2 * j + 1] = *(const f32x4*)(gb + 8 * F.lane + 512 * j + 4); }
        else { GB[2 * j] = (f32x4){0.f, 0.f, 0.f, 0.f}; GB[2 * j + 1] = (f32x4){0.f, 0.f, 0.f, 0.f}; } }
    for (int m = gw; m < M; m += NGW) {
        const float* xr = xsrc + (size_t)m * D + 8 * F.lane;
        f32x4 xv[8];
#pragma unroll
        for (int j = 0; j < 4; ++j) { xv[2 * j] = *(const f32x4*)(xr + 512 * j); xv[2 * j + 1] = *(const f32x4*)(xr + 512 * j + 4); }
        if (!FIRST) {
            const bf16* hr = F.H + (size_t)m * D + 8 * F.lane;
            v4u hv[4];
#pragma unroll
            for (int j = 0; j < 4; ++j) hv[j] = *(const v4u*)(hr + 512 * j);
            f32x4 hf[8]; float ss = 0.f;
#pragma unroll
            for (int j = 0; j < 4; ++j) {
                hf[2 * j] = (f32x4){bf_lo(hv[j].x), bf_hi(hv[j].x), bf_lo(hv[j].y), bf_hi(hv[j].y)};
                hf[2 * j + 1] = (f32x4){bf_lo(hv[j].z), bf_hi(hv[j].z), bf_lo(hv[j].w), bf_hi(hv[j].w)}; }
#pragma unroll
            for (int j = 0; j < 8; ++j) ss += (hf[j].x * hf[j].x + hf[j].y * hf[j].y) + (hf[j].z * hf[j].z + hf[j].w * hf[j].w);
            const float rs = 1.0f / sqrtf(wave_sum(ss) * (1.0f / D) + NORM_EPS);
            float* xw = xdst + (size_t)m * D + 8 * F.lane;
#pragma unroll
            for (int j = 0; j < 8; ++j) { xv[j] = xv[j] + cres * ((hf[j] * rs) * GA[j]); }
#pragma unroll
            for (int j = 0; j < 4; ++j) { *(f32x4*)(xw + 512 * j) = xv[2 * j]; *(f32x4*)(xw + 512 * j + 4) = xv[2 * j + 1]; }
        }
        if (write_xn) {
            float s2 = 0.f;
#pragma unroll
            for (int j = 0; j < 8; ++j) s2 += (xv[j].x * xv[j].x + xv[j].y * xv[j].y) + (xv[j].z * xv[j].z + xv[j].w * xv[j].w);
            const float r2 = 1.0f / sqrtf(wave_sum(s2) * (1.0f / D) + NORM_EPS);
            bf16* xo = F.XN + (size_t)m * D + 8 * F.lane;
#pragma unroll
            for (int j = 0; j < 4; ++j) { const f32x4 a = (xv[2 * j] * r2) * GB[2 * j], b = (xv[2 * j + 1] * r2) * GB[2 * j + 1];
                v4u o; o.x = pg8::cvt_pk_bf16(a.x, a.y); o.y = pg8::cvt_pk_bf16(a.z, a.w); o.z = pg8::cvt_pk_bf16(b.x, b.y); o.w = pg8::cvt_pk_bf16(b.z, b.w);
                *(v4u*)(xo + 512 * j) = o; }
        }
    }
}
__device__ __forceinline__ void p0_prologue(Frame& F) {
    RELAUNDER(F);
    const int gw = F.vcu * NWAVES + F.wave, NGW = F.G * NWAVES;
    constexpr int PER_FI = (NFF / 256) * (D / 64), PER_FO = (D / 256) * (DFF / 64), PER_MI = (NMIXP / 256) * (D / 64), PER_MO = (D / 256) * (D / 64);
    constexpr int IT_FI = 8 * PER_FI, IT_FO = 8 * PER_FO, IT_MI = 4 * PER_MI, IT_MO = 4 * PER_MO;
    for (int it = gw; it < IT_FI + IT_FO + IT_MI + IT_MO; it += NGW) {
        int r = it;
        if (r < IT_FI) { const int mat = r / PER_FI, q = r % PER_FI, kb = q / (NFF / 256), nb = q % (NFF / 256);
            cvt_item<1>(F.w_fi + (size_t)mat * D * NFF, D, NFF, F.WFI + (size_t)mat * NFF * D, nb, kb, F.lane); continue; } r -= IT_FI;
        if (r < IT_FO) { const int mat = r / PER_FO, q = r % PER_FO, kb = q / (D / 256), nb = q % (D / 256);
            cvt_item<0>(F.w_fo + (size_t)mat * DFF * D, DFF, D, F.WFO + (size_t)mat * D * DFF, nb, kb, F.lane); continue; } r -= IT_FO;
        if (r < IT_MI) { const int mat = r / PER_MI, q = r % PER_MI, kb = q / (NMIXP / 256), nb = q % (NMIXP / 256);
            cvt_item<2>(F.w_mi + (size_t)mat * D * NMIX, D, NMIX, F.WMI + (size_t)mat * NMIXP * D, nb, kb, F.lane); continue; } r -= IT_MI;
        { const int mat = r / PER_MO, q = r % PER_MO, kb = q / (D / 256), nb = q % (D / 256);
            cvt_item<0>(F.w_mo + (size_t)mat * D * D, D, D, F.WMO + (size_t)mat * D * D, nb, kb, F.lane); }
    }
    for (int e = (F.vcu * NWAVES + F.wave) * 64 + F.lane; e < M * 32; e += NGW * 64) {
        const int m = e >> 5, i = e & 31;
        double pw = 1.0; for (int k = 0; k < i; ++k) pw *= 0.7498942093324559;
        const float a = (float)F.pos[m] * (float)pw;
        const double ad = (double)a, k = rint(ad * 0.15915494309189535), r = fma(-k, 6.283185307179586, ad);
        const float rf = (float)r;
        F.ROPE[(size_t)m * 64 + i] = cosf(rf); F.ROPE[(size_t)m * 64 + 32 + i] = sinf(rf);
    }
    norm_phase<true>(F, true, 0, 0, 0.f, true);
}

__device__ __forceinline__ void rope8(bf16* p, const f32x4& c0, const f32x4& c1, const f32x4& s0, const f32x4& s1, float scale) {
    const v4u lo = *(const v4u*)p, hi = *(const v4u*)(p + 32);
    const float x1[8] = {bf_lo(lo.x), bf_hi(lo.x), bf_lo(lo.y), bf_hi(lo.y), bf_lo(lo.z), bf_hi(lo.z), bf_lo(lo.w), bf_hi(lo.w)};
    const float x2[8] = {bf_lo(hi.x), bf_hi(hi.x), bf_lo(hi.y), bf_hi(hi.y), bf_lo(hi.z), bf_hi(hi.z), bf_lo(hi.w), bf_hi(hi.w)};
    const float cc[8] = {c0.x, c0.y, c0.z, c0.w, c1.x, c1.y, c1.z, c1.w}, sn[8] = {s0.x, s0.y, s0.z, s0.w, s1.x, s1.y, s1.z, s1.w};
    float o1[8], o2[8];
#pragma unroll
    for (int i = 0; i < 8; ++i) { o1[i] = (x1[i] * cc[i] - x2[i] * sn[i]) * scale; o2[i] = (x2[i] * cc[i] + x1[i] * sn[i]) * scale; }
    v4u a, b; a.x = pg8::cvt_pk_bf16(o1[0], o1[1]); a.y = pg8::cvt_pk_bf16(o1[2], o1[3]); a.z = pg8::cvt_pk_bf16(o1[4], o1[5]); a.w = pg8::cvt_pk_bf16(o1[6], o1[7]);
    b.x = pg8::cvt_pk_bf16(o2[0], o2[1]); b.y = pg8::cvt_pk_bf16(o2[2], o2[3]); b.z = pg8::cvt_pk_bf16(o2[4], o2[5]); b.w = pg8::cvt_pk_bf16(o2[6], o2[7]);
    *(v4u*)p = a; *(v4u*)(p + 32) = b;
}
__device__ __forceinline__ void prep_phase(Frame& F, int l) {
    RELAUNDER(F);
    const int gw = F.vcu * NWAVES + F.wave, NGW = F.G * NWAVES;
    const float* w2 = F.gate_w2 + (size_t)l * 16 * 512 + 8 * F.lane; const float* gb = F.gate_b + (size_t)l * 512 + 8 * F.lane;
    f32x4 W2[16][2];
#pragma unroll
    for (int r = 0; r < 16; ++r) { W2[r][0] = *(const f32x4*)(w2 + r * 512); W2[r][1] = *(const f32x4*)(w2 + r * 512 + 4); }
    const f32x4 B0 = *(const f32x4*)gb, B1 = *(const f32x4*)(gb + 4);
    for (int m = gw; m < M; m += NGW) {
        bf16* row = F.MIX + (size_t)m * MIXLD;
        const float* cs = F.ROPE + (size_t)m * 64;
        { const int head = F.lane >> 2, i0 = 8 * (F.lane & 3);
          const f32x4 c0 = *(const f32x4*)(cs + i0), c1 = *(const f32x4*)(cs + i0 + 4), s0 = *(const f32x4*)(cs + 32 + i0), s1 = *(const f32x4*)(cs + 32 + i0 + 4);
          rope8(row + C_QA + head * 64 + i0, c0, c1, s0, s1, 0.125f);
          if (F.lane < 16) rope8(row + C_KA + head * 64 + i0, c0, c1, s0, s1, 1.0f); }
        { const float* gr = F.GLR + (size_t)m * 16;
          const f32x4 g0 = *(const f32x4*)gr, g1 = *(const f32x4*)(gr + 4), g2 = *(const f32x4*)(gr + 8), g3 = *(const f32x4*)(gr + 12);
          const float g[16] = {g0.x, g0.y, g0.z, g0.w, g1.x, g1.y, g1.z, g1.w, g2.x, g2.y, g2.z, g2.w, g3.x, g3.y, g3.z, g3.w};
          f32x4 z0 = B0, z1 = B1;
#pragma unroll
          for (int r = 0; r < 16; ++r) { z0 = z0 + g[r] * W2[r][0]; z1 = z1 + g[r] * W2[r][1]; }
          float z[8] = {z0.x, z0.y, z0.z, z0.w, z1.x, z1.y, z1.z, z1.w};
#pragma unroll
          for (int e = 0; e < 8; ++e) z[e] = (fminf(z[e], 0.f) - log1pf(expf(-fabsf(z[e])))) * 0.0625f;
          float* lo = F.LOGA + (size_t)m * 512 + 8 * F.lane;
          *(f32x4*)lo = (f32x4){z[0], z[1], z[2], z[3]}; *(f32x4*)(lo + 4) = (f32x4){z[4], z[5], z[6], z[7]}; }
    }
}
__device__ __forceinline__ void attn_naive(Frame& F, int l) {
    RELAUNDER(F);
    const int gw = F.vcu * NWAVES + F.wave, NGW = F.G * NWAVES;
    LAS bf16* qs = (LAS bf16*)(F.lds + RING_OFF + F.wave * 1024);
    const float* sk = F.sinks + l * 16;
    for (int it = gw; it < M * 4; it += NGW) {
        const int m = it >> 2, h = it & 3, t = m & (SEQ - 1);
        const bf16* row = F.MIX + (size_t)m * MIXLD;
        *(LAS v2u*)(qs + 4 * F.lane) = *(const v2u*)(row + C_QA + h * 256 + 4 * F.lane);
        LDS_WAIT();
        float s[2][4]; bool valid[2];
#pragma unroll
        for (int kk = 0; kk < 2; ++kk) {
            const int diff = F.lane + 64 * kk; valid[kk] = (t >= diff);
            const bf16* kr = F.MIX + (size_t)(valid[kk] ? m - diff : m) * MIXLD + C_KA + h * 64;
            float a[4] = {0.f, 0.f, 0.f, 0.f};
#pragma unroll 1
            for (int c = 0; c < 8; ++c) {
                const v4u kv = *(const v4u*)(kr + 8 * c);
                const float kf[8] = {bf_lo(kv.x), bf_hi(kv.x), bf_lo(kv.y), bf_hi(kv.y), bf_lo(kv.z), bf_hi(kv.z), bf_lo(kv.w), bf_hi(kv.w)};
#pragma unroll
                for (int g = 0; g < 4; ++g) { const v4u qv = *(const LAS v4u*)(qs + g * 64 + 8 * c);
                    a[g] += (kf[0] * bf_lo(qv.x) + kf[1] * bf_hi(qv.x)) + (kf[2] * bf_lo(qv.y) + kf[3] * bf_hi(qv.y)) + (kf[4] * bf_lo(qv.z) + kf[5] * bf_hi(qv.z)) + (kf[6] * bf_lo(qv.w) + kf[7] * bf_hi(qv.w)); }
            }
#pragma unroll
            for (int g = 0; g < 4; ++g) s[kk][g] = a[g];
        }
        float p[2][4], inv[4];
#pragma unroll
        for (int g = 0; g < 4; ++g) {
            const float sink = sk[h * 4 + g];
            float mx = fmaxf(valid[0] ? s[0][g] : -INFINITY, valid[1] ? s[1][g] : -INFINITY);
            mx = fmaxf(wave_max(mx), sink);
            p[0][g] = valid[0] ? expf(s[0][g] - mx) : 0.f; p[1][g] = valid[1] ? expf(s[1][g] - mx) : 0.f;
            inv[g] = 1.0f / (wave_sum(p[0][g] + p[1][g]) + expf(sink - mx));
        }
        float acc[4] = {0.f, 0.f, 0.f, 0.f};
        const int nk = (t + 1 < 128) ? t + 1 : 128, n0 = nk < 64 ? nk : 64;
        const bf16* vb = F.MIX + (size_t)m * MIXLD + C_VA + h * 64 + F.lane;
        for (int j = 0; j < n0; ++j) { const float v = bf1(*(vb - (size_t)j * MIXLD));
#pragma unroll
            for (int g = 0; g < 4; ++g) acc[g] += __shfl(p[0][g], j) * v; }
        for (int j = 64; j < nk; ++j) { const float v = bf1(*(vb - (size_t)j * MIXLD));
#pragma unroll
            for (int g = 0; g < 4; ++g) acc[g] += __shfl(p[1][g], j - 64) * v; }
        bf16* op = F.MO + (size_t)m * D + h * 256 + F.lane;
#pragma unroll
        for (int g = 0; g < 4; ++g) op[g * 64] = (bf16)f2bf(acc[g] * inv[g]);
    }
}
__device__ __forceinline__ void gla_naive(Frame& F) {
    RELAUNDER(F);
    LAS float* part = (LAS float*)(F.lds + RING_OFF + 16384);
    for (int u = F.vcu; u < 256; u += F.G) {
        const int b = u >> 7, h = (u >> 5) & 3, cg = u & 31;
        const int dk = F.tid & 127, cp = F.tid >> 7, c0 = cg * 8 + cp * 2;
        float S0 = 0.f, S1 = 0.f;
        for (int t0 = 0; t0 < SEQ; t0 += 64) {
#pragma unroll 1
            for (int tb = 0; tb < 64; tb += 8) {
                float la[8]; bf16 kk[8], qq[8]; unsigned vv[8];
#pragma unroll
                for (int i = 0; i < 8; ++i) { const size_t m = (size_t)b * SEQ + t0 + tb + i;
                    la[i] = F.LOGA[m * 512 + h * 128 + dk]; kk[i] = F.MIX[m * MIXLD + C_KG + h * 128 + dk]; qq[i] = F.MIX[m * MIXLD + C_QG + h * 128 + dk];
                    vv[i] = *(const unsigned*)(F.MIX + m * MIXLD + C_VG + h * 256 + c0); }
#pragma unroll
                for (int i = 0; i < 8; ++i) {
                    const float a = expf(la[i]), k = bf1(kk[i]), q = bf1(qq[i]) * 0.08838834764831845f, v0 = bf_lo(vv[i]), v1 = bf_hi(vv[i]);
                    S0 = a * S0 + k * v0; S1 = a * S1 + k * v1;
                    const float o0 = wave_sum(q * S0), o1 = wave_sum(q * S1);
                    if (F.lane == 0) { part[((tb + i) * 8 + F.wave) * 2] = o0; part[((tb + i) * 8 + F.wave) * 2 + 1] = o1; }
                }
            }
            __syncthreads();
            { const int tt = F.tid >> 3, cc = F.tid & 7, cpp = cc >> 1, e = cc & 1;
              const float o = part[(tt * 8 + 2 * cpp) * 2 + e] + part[(tt * 8 + 2 * cpp + 1) * 2 + e];
              F.OG[((size_t)b * SEQ + t0 + tt) * 1024 + h * 256 + cg * 8 + cc] = o; }
            __syncthreads();
        }
    }
}
__device__ __forceinline__ void gla_fin(Frame& F, int l) {
    RELAUNDER(F);
    const int gw = F.vcu * NWAVES + F.wave, NGW = F.G * NWAVES;
    const f32x4 gv = *(const f32x4*)(F.gla_gain + (size_t)l * 256 + 4 * F.lane);
    for (int it = gw; it < M * 4; it += NGW) {
        const int m = it >> 2, h = it & 3;
        const f32x4 o = *(const f32x4*)(F.OG + (size_t)m * 1024 + h * 256 + 4 * F.lane);
        const float rs = 1.0f / sqrtf(wave_sum((o.x * o.x + o.y * o.y) + (o.z * o.z + o.w * o.w)) * (1.0f / 256.0f) + NORM_EPS);
        const v2u rr = *(const v2u*)(F.MIX + (size_t)m * MIXLD + C_RG + h * 256 + 4 * F.lane);
        const float r[4] = {bf_lo(rr.x), bf_hi(rr.x), bf_lo(rr.y), bf_hi(rr.y)};
        float y[4];
#pragma unroll
        for (int e = 0; e < 4; ++e) y[e] = ((o[e] * rs) * gv[e]) * (r[e] / (1.0f + expf(-r[e])));
        v2u w; w.x = pg8::cvt_pk_bf16(y[0], y[1]); w.y = pg8::cvt_pk_bf16(y[2], y[3]);
        *(v2u*)(F.MO + (size_t)m * D + 1024 + h * 256 + 4 * F.lane) = w;
    }
}


__device__ __forceinline__ pg8::f32x4 mma16(bf16x8 x, bf16x8 y, pg8::f32x4 c) { return __builtin_amdgcn_mfma_f32_16x16x32_bf16(x, y, c, 0, 0, 0); }
__device__ __forceinline__ void gla_stage_vt(Frame& F, LAS unsigned char* L, size_t m0, int h) {
    const int dv = F.tid & 255, th = F.tid >> 8; const bf16* vp = F.MIX + (m0 + th * 32) * MIXLD + C_VG + h * 256 + dv;
    unsigned pk[16];
#pragma unroll
    for (int i = 0; i < 16; ++i) pk[i] = (unsigned)vp[(size_t)(2 * i) * MIXLD] | ((unsigned)vp[(size_t)(2 * i + 1) * MIXLD] << 16);
    LAS v4u* dst = (LAS v4u*)(L + G_VT + dv * 144 + th * 64);
#pragma unroll
    for (int j = 0; j < 4; ++j) dst[j] = (v4u){pk[4 * j], pk[4 * j + 1], pk[4 * j + 2], pk[4 * j + 3]};
}
__device__ __forceinline__ void gla_g1(Frame& F) {
    RELAUNDER(F);
    LAS unsigned char* L = F.lds + RING_OFF;
    const int r16 = F.lane & 15, q4 = F.lane >> 4, w = F.wave;
    for (int u = F.vcu; u < 1024; u += F.G) {
        const int c = u >> 2, h = u & 3; const size_t m0 = (size_t)c * 64;
        const int dk = F.tid & 127, tq = F.tid >> 7;
        float bb[16];
        { const float* lp = F.LOGA + (m0 + tq * 16) * 512 + h * 128 + dk; float run = 0.f;
#pragma unroll
          for (int i = 0; i < 16; ++i) { run += lp[(size_t)i * 512]; bb[i] = run; } }
        LAS float* seg = (LAS float*)(L + G_SEG);
        seg[tq * 128 + dk] = bb[15];
        gla_stage_vt(F, L, m0, h);
        __syncthreads();
        float off = 0.f, tot = 0.f;
#pragma unroll
        for (int q = 0; q < 4; ++q) { const float sg = seg[q * 128 + dk]; tot += sg; if (q < tq) off += sg; }
        { const bf16* kp = F.MIX + (m0 + tq * 16) * MIXLD + C_KG + h * 128 + dk; float* bp = F.BC + (m0 + tq * 16) * 512 + h * 128 + dk;
          unsigned pk[8];
#pragma unroll
          for (int i = 0; i < 8; ++i) { const float b0 = bb[2 * i] + off, b1 = bb[2 * i + 1] + off;
              bp[(size_t)(2 * i) * 512] = b0; bp[(size_t)(2 * i + 1) * 512] = b1;
              pk[i] = pg8::cvt_pk_bf16(bf1(kp[(size_t)(2 * i) * MIXLD]) * expf(tot - b0), bf1(kp[(size_t)(2 * i + 1) * MIXLD]) * expf(tot - b1)); }
          LAS v4u* dst = (LAS v4u*)(L + G_KT + dk * 144 + tq * 32);
          dst[0] = (v4u){pk[0], pk[1], pk[2], pk[3]}; dst[1] = (v4u){pk[4], pk[5], pk[6], pk[7]}; }
        if (tq == 0) F.DEC[(size_t)u * 128 + dk] = expf(tot);
        __syncthreads();
        bf16x8 av[2][2];
#pragma unroll
        for (int rb = 0; rb < 2; ++rb)
#pragma unroll
            for (int ks = 0; ks < 2; ++ks) av[rb][ks] = *(const LAS bf16x8*)(L + G_VT + (32 * w + 16 * rb + r16) * 144 + (32 * ks + 8 * q4) * 2);
        float* dsb = F.DS + (size_t)u * 32768;
#pragma unroll
        for (int cb = 0; cb < 8; ++cb) {
            bf16x8 kv[2];
#pragma unroll
            for (int ks = 0; ks < 2; ++ks) kv[ks] = *(const LAS bf16x8*)(L + G_KT + (16 * cb + r16) * 144 + (32 * ks + 8 * q4) * 2);
#pragma unroll
            for (int rb = 0; rb < 2; ++rb) { pg8::f32x4 acc = {0.f, 0.f, 0.f, 0.f};
#pragma unroll
                for (int ks = 0; ks < 2; ++ks) acc = mma16(kv[ks], av[rb][ks], acc);
                *(pg8::f32x4*)(dsb + (size_t)(32 * w + 16 * rb + r16) * 128 + 16 * cb + 4 * q4) = acc; }
        }
        __syncthreads();
    }
}
__device__ __forceinline__ void gla_scan(Frame& F) {
    RELAUNDER(F);
    for (int g = (F.vcu * NWAVES + F.wave) * 64 + F.lane; g < 131072; g += F.G * NWAVES * 64) {
        const int dk2 = g & 63, dv = (g >> 6) & 255, h = (g >> 14) & 3, b = g >> 16;
        const size_t base = (((size_t)b * 128 * 4 + h) * 256 + dv) * 128 + 2 * dk2, nstr = (size_t)4 * 32768;
        const size_t dbase = ((size_t)b * 128 * 4 + h) * 128 + 2 * dk2, dstr = 4 * 128;
        float s0 = 0.f, s1 = 0.f;
#pragma unroll 1
        for (int n = 0; n < 128; n += 8) {
            v2f d[8], dc[8];
#pragma unroll
            for (int i = 0; i < 8; ++i) { d[i] = *(const v2f*)(F.DS + base + (size_t)(n + i) * nstr); dc[i] = *(const v2f*)(F.DEC + dbase + (size_t)(n + i) * dstr); }
#pragma unroll
            for (int i = 0; i < 8; ++i) { *(unsigned*)(F.ST + base + (size_t)(n + i) * nstr) = pg8::cvt_pk_bf16(s0, s1);
                s0 = dc[i].x * s0 + d[i].x; s1 = dc[i].y * s1 + d[i].y; }
        }
    }
}
__device__ __forceinline__ void gla_g3(Frame& F, int l) {
    RELAUNDER(F);
    LAS unsigned char* L = F.lds + RING_OFF;
    const int r16 = F.lane & 15, q4 = F.lane >> 4, w = F.wave;
    for (int u = F.vcu; u < 1024; u += F.G) {
        const int c = u >> 2, h = u & 3; const size_t m0 = (size_t)c * 64;
        const bf16* stb = F.ST + (size_t)u * 32768;
        bf16x8 sf[2][4];
#pragma unroll
        for (int rb = 0; rb < 2; ++rb)
#pragma unroll
            for (int ks = 0; ks < 4; ++ks) sf[rb][ks] = *(const bf16x8*)(stb + (size_t)(32 * w + 16 * rb + r16) * 128 + 32 * ks + 8 * q4);
        { const int t = F.tid >> 3, d0 = (F.tid & 7) * 16; const size_t m = m0 + t;
          const float* bp = F.BC + m * 512 + h * 128 + d0;
          const v4u q0 = *(const v4u*)(F.MIX + m * MIXLD + C_QG + h * 128 + d0), q1 = *(const v4u*)(F.MIX + m * MIXLD + C_QG + h * 128 + d0 + 8);
          const v4u k0 = *(const v4u*)(F.MIX + m * MIXLD + C_KG + h * 128 + d0), k1 = *(const v4u*)(F.MIX + m * MIXLD + C_KG + h * 128 + d0 + 8);
          const unsigned qw[8] = {q0.x, q0.y, q0.z, q0.w, q1.x, q1.y, q1.z, q1.w}, kw[8] = {k0.x, k0.y, k0.z, k0.w, k1.x, k1.y, k1.z, k1.w};
          unsigned qo[8], ko[8];
#pragma unroll
          for (int j = 0; j < 4; ++j) { const f32x4 bv = *(const f32x4*)(bp + 4 * j);
              const float e0 = expf(bv.x), e1 = expf(bv.y), e2 = expf(bv.z), e3 = expf(bv.w), n0 = expf(-bv.x), n1 = expf(-bv.y), n2 = expf(-bv.z), n3 = expf(-bv.w);
              qo[2 * j] = pg8::cvt_pk_bf16(bf_lo(qw[2 * j]) * 0.08838834764831845f * e0, bf_hi(qw[2 * j]) * 0.08838834764831845f * e1);
              qo[2 * j + 1] = pg8::cvt_pk_bf16(bf_lo(qw[2 * j + 1]) * 0.08838834764831845f * e2, bf_hi(qw[2 * j + 1]) * 0.08838834764831845f * e3);
              ko[2 * j] = pg8::cvt_pk_bf16(bf_lo(kw[2 * j]) * n0, bf_hi(kw[2 * j]) * n1);
              ko[2 * j + 1] = pg8::cvt_pk_bf16(bf_lo(kw[2 * j + 1]) * n2, bf_hi(kw[2 * j + 1]) * n3); }
          LAS v4u* qd = (LAS v4u*)(L + G3_QD + t * 272 + d0 * 2); LAS v4u* kd = (LAS v4u*)(L + G3_KD + t * 272 + d0 * 2);
          qd[0] = (v4u){qo[0], qo[1], qo[2], qo[3]}; qd[1] = (v4u){qo[4], qo[5], qo[6], qo[7]};
          kd[0] = (v4u){ko[0], ko[1], ko[2], ko[3]}; kd[1] = (v4u){ko[4], ko[5], ko[6], ko[7]}; }
        gla_stage_vt(F, L, m0, h);
        __syncthreads();
#pragma unroll
        for (int j = 0; j < 2; ++j) {
            const int id = 2 * w + j, tr = id >> 2, sc = id & 3;
            pg8::f32x4 acc = {0.f, 0.f, 0.f, 0.f};
            if (sc <= tr) {
#pragma unroll
                for (int ks = 0; ks < 4; ++ks) acc = mma16(*(const LAS bf16x8*)(L + G3_KD + (16 * sc + r16) * 272 + (32 * ks + 8 * q4) * 2),
                                                           *(const LAS bf16x8*)(L + G3_QD + (16 * tr + r16) * 272 + (32 * ks + 8 * q4) * 2), acc);
                const int t = 16 * tr + r16, s0 = 16 * sc + 4 * q4;
#pragma unroll
                for (int i = 0; i < 4; ++i) if (s0 + i > t) acc[i] = 0.f;
            }
            v2u pk; pk.x = pg8::cvt_pk_bf16(acc[0], acc[1]); pk.y = pg8::cvt_pk_bf16(acc[2], acc[3]);
            *(LAS v2u*)(L + G3_IN + (16 * tr + r16) * 144 + (16 * sc + 4 * q4) * 2) = pk;
        }
        __syncthreads();
        bf16x8 vf[2][2];
#pragma unroll
        for (int rb = 0; rb < 2; ++rb)
#pragma unroll
            for (int ks = 0; ks < 2; ++ks) vf[rb][ks] = *(const LAS bf16x8*)(L + G_VT + (32 * w + 16 * rb + r16) * 144 + (32 * ks + 8 * q4) * 2);
        pg8::f32x4 o[2][4]; float ss[4];
#pragma unroll
        for (int cb = 0; cb < 4; ++cb) {
            bf16x8 qf[4], nf[2];
#pragma unroll
            for (int ks = 0; ks < 4; ++ks) qf[ks] = *(const LAS bf16x8*)(L + G3_QD + (16 * cb + r16) * 272 + (32 * ks + 8 * q4) * 2);
#pragma unroll
            for (int ks = 0; ks < 2; ++ks) nf[ks] = *(const LAS bf16x8*)(L + G3_IN + (16 * cb + r16) * 144 + (32 * ks + 8 * q4) * 2);
            float sq = 0.f;
#pragma unroll
            for (int rb = 0; rb < 2; ++rb) { pg8::f32x4 acc = {0.f, 0.f, 0.f, 0.f};
#pragma unroll
                for (int ks = 0; ks < 4; ++ks) acc = mma16(sf[rb][ks], qf[ks], acc);
#pragma unroll
                for (int ks = 0; ks < 2; ++ks) acc = mma16(vf[rb][ks], nf[ks], acc);
                o[rb][cb] = acc; sq += (acc[0] * acc[0] + acc[1] * acc[1]) + (acc[2] * acc[2] + acc[3] * acc[3]); }
            sq += __shfl_xor(sq, 16); sq += __shfl_xor(sq, 32);
            ss[cb] = sq;
        }
        LAS float* SS = (LAS float*)(L + G3_SS);
        if (q4 == 0) {
#pragma unroll
            for (int cb = 0; cb < 4; ++cb) SS[w * 64 + 16 * cb + r16] = ss[cb]; }
        __syncthreads();
#pragma unroll
        for (int cb = 0; cb < 4; ++cb) {
            float tot = 0.f;
#pragma unroll
            for (int ww = 0; ww < 8; ++ww) tot += SS[ww * 64 + 16 * cb + r16];
            const float rs = 1.0f / sqrtf(tot * (1.0f / 256.0f) + NORM_EPS);
            const size_t m = m0 + 16 * cb + r16;
#pragma unroll
            for (int rb = 0; rb < 2; ++rb) { const int dv = 32 * w + 16 * rb + 4 * q4;
                const f32x4 gv = *(const f32x4*)(F.gla_gain + (size_t)l * 256 + dv);
                const v2u rr = *(const v2u*)(F.MIX + m * MIXLD + C_RG + h * 256 + dv);
                const float r[4] = {bf_lo(rr.x), bf_hi(rr.x), bf_lo(rr.y), bf_hi(rr.y)};
                float y[4];
#pragma unroll
                for (int e = 0; e < 4; ++e) y[e] = ((o[rb][cb][e] * rs) * gv[e]) * (r[e] / (1.0f + expf(-r[e])));
                v2u wv; wv.x = pg8::cvt_pk_bf16(y[0], y[1]); wv.y = pg8::cvt_pk_bf16(y[2], y[3]);
                *(v2u*)(F.MO + m * D + 1024 + h * 256 + dv) = wv; }
        }
        __syncthreads();
    }
}

struct Args { const void* in[11]; float* out; unsigned char* ws; };
__global__ void __launch_bounds__(NWAVES * 64, 2) fwd(Args args) {
    extern __shared__ __attribute__((aligned(16))) unsigned char lds[];
    Frame F;
    F.lds = (LAS unsigned char*)lds;
    F.MISC = (volatile LAS unsigned*)(F.lds + MISC_OFF);
    F.tid = threadIdx.x; F.lane = F.tid & 63; F.wave = __builtin_amdgcn_readfirstlane(F.tid >> 6);
    F.G = gridDim.x; { const int bx = blockIdx.x; F.vcu = (F.G % 8 == 0) ? (bx % 8) * (F.G / 8) + bx / 8 : bx; }
    unsigned char* ws = args.ws;
    F.ctl = (gu32*)(ws + WS_CTL);
    RELAUNDER(F);
    for (int u = F.tid; u < (LDS_BYTES - LDSCTL_OFF) / 4; u += NWAVES * 64) ((LAS unsigned*)(F.lds + LDSCTL_OFF))[u] = 0u;
    __syncthreads();
    XcdBarrier bar = xcd_barrier_post((unsigned*)(F.ctl + CW_BAR), F.MISC + 8);

#define GRID_BAR() do { XcdBarrier b_ = bar; GAS unsigned* gb_ = (GAS unsigned*)bar.bar; asm volatile("" : "+s"(gb_), "+s"(b_.x)); b_.bar = (unsigned*)gb_; xcd_barrier(b_); } while (0)
    p0_prologue(F);
    GRID_BAR();

#pragma unroll 1
    for (int l = 0; l < DEPTH; ++l) {
        RELAUNDER(F);
        { pg8::Gemm gm{F.XN, F.WFI + (size_t)(2 * l) * NFF * D, M, NFF, D}; pg8::StaticOrder S; S.init(M, NFF, F.G, (int)blockIdx.x);
          pg8::EpiSwiGLU E{F.ACT, DFF};
          pg8::gemm_phase<pg8::EpiSwiGLU, pg8::StaticOrder, true, true>(F.lds + RING_OFF, gm, S, E); }
        GRID_BAR();
        RELAUNDER(F);
        { pg8::Gemm gm{F.ACT, F.WFO + (size_t)(2 * l) * D * DFF, M, D, DFF}; pg8::StaticOrder S; S.init(M, D, F.G, (int)blockIdx.x);
          pg8::EpiPlain E{F.H, D};
          pg8::gemm_phase<pg8::EpiPlain, pg8::StaticOrder, true, true>(F.lds + RING_OFF, gm, S, E); }
        GRID_BAR();
        norm_phase<false>(F, l == 0, l * 6 + 1, l * 6 + 2, 0.5f, true);
        GRID_BAR();
        RELAUNDER(F);
        { pg8::Gemm gm{F.XN, F.WMI + (size_t)l * NMIXP * D, M, NMIXP, D}; pg8::StaticOrder S; S.init(M, NMIXP, F.G, (int)blockIdx.x);
          pg8::EpiMix E{F.MIX, MIXLD, F.GLR, MIXLD / 256};
          pg8::gemm_phase<pg8::EpiMix, pg8::StaticOrder, true, true>(F.lds + RING_OFF, gm, S, E); }
        GRID_BAR();
        prep_phase(F, l);
        GRID_BAR();
        gla_g1(F);
        attn_naive(F, l);
        GRID_BAR();
        gla_scan(F);
        GRID_BAR();
        gla_g3(F, l);
        GRID_BAR();
        RELAUNDER(F);
        { pg8::Gemm gm{F.MO, F.WMO + (size_t)l * D * D, M, D, D}; pg8::StaticOrder S; S.init(M, D, F.G, (int)blockIdx.x);
          pg8::EpiPlain E{F.H, D};
          pg8::gemm_phase<pg8::EpiPlain, pg8::StaticOrder, true, true>(F.lds + RING_OFF, gm, S, E); }
        GRID_BAR();
        norm_phase<false>(F, false, l * 6 + 3, l * 6 + 4, 1.0f, true);
        GRID_BAR();
        RELAUNDER(F);
        { pg8::Gemm gm{F.XN, F.WFI + (size_t)(2 * l + 1) * NFF * D, M, NFF, D}; pg8::StaticOrder S; S.init(M, NFF, F.G, (int)blockIdx.x);
          pg8::EpiSwiGLU E{F.ACT, DFF};
          pg8::gemm_phase<pg8::EpiSwiGLU, pg8::StaticOrder, true, true>(F.lds + RING_OFF, gm, S, E); }
        GRID_BAR();
        RELAUNDER(F);
        { pg8::Gemm gm{F.ACT, F.WFO + (size_t)(2 * l + 1) * D * DFF, M, D, DFF}; pg8::StaticOrder S; S.init(M, D, F.G, (int)blockIdx.x);
          pg8::EpiPlain E{F.H, D};
          pg8::gemm_phase<pg8::EpiPlain, pg8::StaticOrder, true, true>(F.lds + RING_OFF, gm, S, E); }
        GRID_BAR();
        norm_phase<false>(F, false, l * 6 + 5, l * 6 + 6  , 0.5f, l + 1 < DEPTH);
        if (l + 1 < DEPTH) GRID_BAR();
    }
}

extern "C" void kernel_launch(void* const* d_in, const int* in_sizes, int n_in, void* d_out, int out_size, void* d_ws, size_t ws_size, hipStream_t stream) {
    static int grid = 0;
    if (grid == 0) {
        if (n_in != 11 || in_sizes[0] != M * D || out_size != M * D || ws_size < WS_END) { fprintf(stderr, "kernel_launch: unexpected shapes (n_in %d, in0 %d, out %d, ws %zu < %zu); nothing launched\n", n_in, n_in > 0 ? in_sizes[0] : -1, out_size, ws_size, (size_t)WS_END); grid = -1; return; }
        int dev = 0, cus = 0, per_cu = 0;
        if (hipGetDevice(&dev) != hipSuccess || hipDeviceGetAttribute(&cus, hipDeviceAttributeMultiprocessorCount, dev) != hipSuccess) { fprintf(stderr, "kernel_launch: device query failed\n"); grid = -1; return; }
        if (hipFuncSetAttribute((const void*)fwd, hipFuncAttributeMaxDynamicSharedMemorySize, LDS_BYTES) != hipSuccess) { fprintf(stderr, "kernel_launch: hipFuncSetAttribute failed\n"); grid = -1; return; }
        if (hipOccupancyMaxActiveBlocksPerMultiprocessor(&per_cu, (const void*)fwd, NWAVES * 64, LDS_BYTES) != hipSuccess || per_cu < 1) { fprintf(stderr, "kernel_launch: occupancy query reports %d workgroups per CU\n", per_cu); }
        (void)hipGetLastError();
        grid = cus;
    }
    if (grid < 0) return;
    if (hipMemsetAsync((char*)d_ws + WS_CTL, 0, CTL_ZERO_BYTES, stream) != hipSuccess) { fprintf(stderr, "kernel_launch: memset failed\n"); return; }
    Args a{};
    for (int i = 0; i < 11; ++i) a.in[i] = d_in[i];
    a.out = (float*)d_out; a.ws = (unsigned char*)d_ws;
    hipLaunchKernelGGL(fwd, dim3(grid), dim3(NWAVES * 64), LDS_BYTES, stream, a);
    const hipError_t le = hipPeekAtLastError();
    if (le != hipSuccess) fprintf(stderr, "kernel_launch: launch failed: %s\n", hipGetErrorName(le));
}
```

```cpp
#include <hip/hip_runtime.h>
#include <cstdio>
#include <cstdint>
#include <cmath>
namespace pg8 {
#define PG8_LAS __attribute__((address_space(3)))
typedef unsigned short bf16_t;
typedef short bf16x8 __attribute__((ext_vector_type(8)));
typedef float f32x4 __attribute__((ext_vector_type(4)));
typedef unsigned u32x4 __attribute__((ext_vector_type(4)));
constexpr int BM = 256, BK = 64, HALF = 128, HTB = HALF * BK * 2  , STAGE_BYTES = 8 * HTB, NXCD = 8, WGM = 8;

__host__ __device__ __forceinline__ int lds_byte(int r, int c) { const int st = (r >> 4) * 2 + (c >> 5), rr = r & 15, cc = c & 31, ob = rr * 64 + cc * 2; return st * 1024 + (ob ^ (((ob >> 9) & 1) << 5)); }
__host__ __device__ __forceinline__ void stage_rc(int b, int& R, int& C) { const int st = b / 1024, sb = b % 1024, swz = sb ^ (((sb >> 9) & 1) << 5); R = (st >> 1) * 16 + swz / 64; C = (st & 1) * 32 + (swz % 64) / 2; }
__host__ __device__ __forceinline__ int perm32(int rho) { const int n = rho >> 4, i = rho & 15; return 8 * (i >> 2) + 4 * n + (i & 3); }

struct Unit { int pm, pn; };
struct Gemm { const bf16_t* A; const bf16_t* Bt; int M, N, K; };

struct StaticOrder {
    int nM, nN, nwg, G, c;
    __host__ __device__ void init(int M, int N, int G_, int c_) { nM = M / BM; nN = N / BM; nwg = nM * nN; G = G_; c = c_; }
    __host__ __device__ bool next(int i, Unit& u) const {
        const long L = (long)i * G + c; if (L >= nwg) return false;
        int wgid = (int)L; { const int q = nwg / NXCD, r = nwg % NXCD, xcd = wgid % NXCD, off = wgid / NXCD; wgid = (xcd < r ? xcd * (q + 1) : r * (q + 1) + (xcd - r) * q) + off; }
        const int nig = WGM * nN, gid = wgid / nig, fm = gid * WGM, gsz = (nM - fm) < WGM ? (nM - fm) : WGM;
        u.pm = fm + ((wgid % nig) % gsz); u.pn = (wgid % nig) / gsz; return true;
    }
    __device__ __forceinline__ void a_ready(const Unit&) const {}
    __device__ __forceinline__ void done(const Unit&) const {}
};

__device__ __forceinline__ unsigned cvt_pk_bf16(float lo, float hi) { unsigned r; asm volatile("v_cvt_pk_bf16_f32 %0, %1, %2" : "=v"(r) : "v"(lo), "v"(hi)); return r; }
typedef float f32x2 __attribute__((ext_vector_type(2)));

__device__ __forceinline__ float silu_f(float g) { return g * __builtin_amdgcn_rcpf(1.0f + __builtin_amdgcn_exp2f(-1.4426950408889634f * g)); }
struct EpiSwiGLU {
    static constexpr bool PERM = true, AFTER_DRAIN = false;
    bf16_t* O; int ldc;
    __device__ __forceinline__ void operator()(const f32x4 (&acc)[2][2][4][2], const Unit& u, int wr, int wc, int fr, int fq) const {
        const int row0 = u.pm * BM + wr * 64 + fr, col0 = u.pn * HALF + wc * 32 + 8 * fq;
#pragma unroll
        for (int ai = 0; ai < 2; ++ai)
#pragma unroll
            for (int m = 0; m < 4; ++m) { bf16_t* rowp = O + (size_t)(row0 + ai * HALF + m * 16) * ldc + col0;
                const f32x4 g0 = acc[ai][0][m][0], g1 = acc[ai][0][m][1], u0 = acc[ai][1][m][0], u1 = acc[ai][1][m][1];
                u32x4 w; w.x = cvt_pk_bf16(silu_f(g0[0]) * u0[0], silu_f(g0[1]) * u0[1]); w.y = cvt_pk_bf16(silu_f(g0[2]) * u0[2], silu_f(g0[3]) * u0[3]);
                w.z = cvt_pk_bf16(silu_f(g1[0]) * u1[0], silu_f(g1[1]) * u1[1]); w.w = cvt_pk_bf16(silu_f(g1[2]) * u1[2], silu_f(g1[3]) * u1[3]);
                *(u32x4*)rowp = w; }
    }
};
struct EpiPlain {
    static constexpr bool PERM = true, AFTER_DRAIN = false;
    bf16_t* O; int ldc;
    __device__ __forceinline__ void operator()(const f32x4 (&acc)[2][2][4][2], const Unit& u, int wr, int wc, int fr, int fq) const {
        const int row0 = u.pm * BM + wr * 64 + fr, col0 = u.pn * BM + wc * 32 + 8 * fq;
#pragma unroll
        for (int ai = 0; ai < 2; ++ai)
#pragma unroll
            for (int m = 0; m < 4; ++m) { bf16_t* rowp = O + (size_t)(row0 + ai * HALF + m * 16) * ldc + col0;
#pragma unroll
                for (int bj = 0; bj < 2; ++bj) { const f32x4 v0 = acc[ai][bj][m][0], v1 = acc[ai][bj][m][1];
                    u32x4 w; w.x = cvt_pk_bf16(v0[0], v0[1]); w.y = cvt_pk_bf16(v0[2], v0[3]); w.z = cvt_pk_bf16(v1[0], v1[1]); w.w = cvt_pk_bf16(v1[2], v1[3]);
                    *(u32x4*)(rowp + bj * HALF) = w; } }
    }
};
struct EpiMix {
    static constexpr bool PERM = true, AFTER_DRAIN = false;
    bf16_t* O; int ldc; float* G; int npl;
    __device__ __forceinline__ void operator()(const f32x4 (&acc)[2][2][4][2], const Unit& u, int wr, int wc, int fr, int fq) const {
        const int row0 = u.pm * BM + wr * 64 + fr;
        if (u.pn < npl) {
            const int col0 = u.pn * BM + wc * 32 + 8 * fq;
#pragma unroll
            for (int ai = 0; ai < 2; ++ai)
#pragma unroll
                for (int m = 0; m < 4; ++m) { bf16_t* rowp = O + (size_t)(row0 + ai * HALF + m * 16) * ldc + col0;
#pragma unroll
                    for (int bj = 0; bj < 2; ++bj) { const f32x4 v0 = acc[ai][bj][m][0], v1 = acc[ai][bj][m][1];
                        u32x4 w; w.x = cvt_pk_bf16(v0[0], v0[1]); w.y = cvt_pk_bf16(v0[2], v0[3]); w.z = cvt_pk_bf16(v1[0], v1[1]); w.w = cvt_pk_bf16(v1[2], v1[3]);
                        *(u32x4*)(rowp + bj * HALF) = w; } }
        } else if (wc == 0 && fq < 2) {
#pragma unroll
            for (int ai = 0; ai < 2; ++ai)
#pragma unroll
                for (int m = 0; m < 4; ++m) { float* rowp = G + (size_t)(row0 + ai * HALF + m * 16) * 16 + 8 * fq;
                    *(f32x4*)rowp = acc[ai][0][m][0]; *(f32x4*)(rowp + 4) = acc[ai][0][m][1]; }
        }
    }
};
template <class Epi, class Sched, bool ALIGN_EPI = false, bool SP2 = false>
__device__ __forceinline__ void gemm_phase(PG8_LAS unsigned char* lds, const Gemm g, const Sched& S, const Epi& E) {
    int tid_ = threadIdx.x; asm volatile("" : "+v"(tid_));
    const int tid = tid_, wid = __builtin_amdgcn_readfirstlane(tid >> 6), lane = tid & 63, wr = wid >> 2, wc = wid & 3, fr = lane & 15, fq = lane >> 4;
    int K_ = g.K; asm volatile("" : "+s"(K_));
    const int K = K_, nt = K / BK;
    unsigned voffA[2], voffB[2];
#pragma unroll
    for (int i = 0; i < 2; ++i) { int R, C; stage_rc(tid * 16 + i * 8192, R, C); const int Rb = Epi::PERM ? ((R & ~31) + perm32(R & 31)) : R;
        voffA[i] = (unsigned)(R * K + C) * 2u; voffB[i] = (unsigned)(Rb * K + C) * 2u; }
    const size_t kstep = (size_t)(BK * 2);
    const size_t hstep = (size_t)HALF * K * 2;
    const size_t tstep = 2 * hstep;
    const unsigned ldsw = (unsigned)wid * 1024u;
    const int aoff = lds_byte(wr * 64 + fr, fq * 8), boff = lds_byte(wc * 32 + fr, fq * 8);
#define PG8_SA(b, h) (((b) * 2 + (h)) * HTB)
#define PG8_SB(b, h) ((4 + (b) * 2 + (h)) * HTB)
#define PG8_STAGE(bufoff, gbase, voff) do { _Pragma("unroll") for (int _i = 0; _i < 2; ++_i) \
        __builtin_amdgcn_global_load_lds((const unsigned*)((const char*)(gbase) + (voff)[_i]), (PG8_LAS unsigned*)(lds + (bufoff) + ldsw + _i * 8192), 16, 0, 0); } while (0)
#define PG8_LDA(dst, b, h) do { _Pragma("unroll") for (int m = 0; m < 4; ++m) _Pragma("unroll") for (int k = 0; k < 2; ++k) dst[m][k] = *(const PG8_LAS bf16x8*)(lds + PG8_SA(b, h) + aoff + m * 2048 + k * 1024); } while (0)
#define PG8_LDB(dst, b, h) do { _Pragma("unroll") for (int n = 0; n < 2; ++n) _Pragma("unroll") for (int k = 0; k < 2; ++k) dst[n][k] = *(const PG8_LAS bf16x8*)(lds + PG8_SB(b, h) + boff + n * 2048 + k * 1024); } while (0)
#define PG8_MMA(ai, bj, At, Bt) do { __builtin_amdgcn_s_setprio(1); _Pragma("unroll") for (int m = 0; m < 4; ++m) _Pragma("unroll") for (int n = 0; n < 2; ++n) _Pragma("unroll") for (int k = 0; k < 2; ++k) \
        acc[ai][bj][m][n] = __builtin_amdgcn_mfma_f32_16x16x32_bf16(Bt[n][k], At[m][k], acc[ai][bj][m][n], 0, 0, 0); __builtin_amdgcn_s_setprio(0); } while (0)
#define PG8_WAIT_V(n) asm volatile("s_waitcnt vmcnt(" #n ")" ::: "memory")
#define PG8_WAIT_L(n) asm volatile("s_waitcnt lgkmcnt(" #n ")" ::: "memory")
#define PG8_BAR __builtin_amdgcn_s_barrier()
#define PG8_SCHED __builtin_amdgcn_sched_barrier(0)
    Unit cur, nxt; int ui = 0;
    if (!S.next(0, cur)) return;
    f32x4 acc[2][2][4][2];
#pragma unroll
    for (int a = 0; a < 2; ++a)
#pragma unroll
        for (int b = 0; b < 2; ++b)
#pragma unroll
            for (int m = 0; m < 4; ++m)
#pragma unroll
                for (int n = 0; n < 2; ++n) acc[a][b][m][n] = (f32x4){0.f, 0.f, 0.f, 0.f};
    bf16x8 At[4][2], B0[2][2], B1[2][2];
    const char* cA = (const char*)g.A + (size_t)cur.pm * tstep; const char* cB = (const char*)g.Bt + (size_t)cur.pn * tstep;
    S.a_ready(cur);
    if constexpr (SP2) {
        PG8_STAGE(PG8_SB(0, 0), cB, voffB); PG8_STAGE(PG8_SB(0, 1), cB + hstep, voffB); PG8_STAGE(PG8_SA(0, 0), cA, voffA); PG8_STAGE(PG8_SA(0, 1), cA + hstep, voffA);
        if (wr == 1) PG8_BAR;
        PG8_WAIT_V(2); PG8_BAR;
        PG8_STAGE(PG8_SB(1, 0), cB + kstep, voffB); PG8_STAGE(PG8_SA(1, 0), cA + kstep, voffA); PG8_STAGE(PG8_SB(1, 1), cB + hstep + kstep, voffB);
        PG8_WAIT_V(6); PG8_BAR;
    } else {
        PG8_STAGE(PG8_SB(0, 0), cB, voffB); PG8_STAGE(PG8_SA(0, 0), cA, voffA); PG8_STAGE(PG8_SB(0, 1), cB + hstep, voffB); PG8_STAGE(PG8_SA(0, 1), cA + hstep, voffA);
        if (wr == 1) PG8_BAR;
        PG8_WAIT_V(4); PG8_BAR;
        PG8_STAGE(PG8_SB(1, 0), cB + kstep, voffB); PG8_STAGE(PG8_SA(1, 0), cA + kstep, voffA); PG8_STAGE(PG8_SB(1, 1), cB + hstep + kstep, voffB);
        PG8_WAIT_V(6); PG8_BAR;
    }
    for (;;) {
        const bool has_next = S.next(ui + 1, nxt);
        const char* nA = has_next ? (const char*)g.A + (size_t)nxt.pm * tstep : cA; const char* nB = has_next ? (const char*)g.Bt + (size_t)nxt.pn * tstep : cB;
        for (int t = 0; t < nt; t += 2) {
            const bool last = (t == nt - 2);
            const char* a1 = cA + (size_t)(t + 1) * kstep;
            const char* a2 = last ? nA : cA + (size_t)(t + 2) * kstep; const char* b2 = last ? nB : cB + (size_t)(t + 2) * kstep;
            const char* a3 = a2 + kstep; const char* b3 = b2 + kstep;
            if (last && has_next) S.a_ready(nxt);
            if constexpr (SP2) {
            PG8_LDB(B0, 0, 0); PG8_LDB(B1, 0, 1); PG8_SCHED; PG8_LDA(At, 0, 0); PG8_STAGE(PG8_SA(1, 1), a1 + hstep, voffA);
            PG8_WAIT_V(8); PG8_WAIT_L(0); PG8_BAR; PG8_MMA(0, 0, At, B0); PG8_MMA(0, 1, At, B1); PG8_BAR; PG8_SCHED;
            PG8_LDA(At, 0, 1); PG8_STAGE(PG8_SB(0, 0), b2, voffB); PG8_STAGE(PG8_SB(0, 1), b2 + hstep, voffB); PG8_STAGE(PG8_SA(0, 0), a2, voffA);
            PG8_WAIT_V(8); PG8_WAIT_L(0); PG8_BAR; PG8_MMA(1, 0, At, B0); PG8_MMA(1, 1, At, B1); PG8_BAR; PG8_SCHED;
            PG8_LDB(B0, 1, 0); PG8_LDB(B1, 1, 1); PG8_SCHED; PG8_LDA(At, 1, 0); PG8_STAGE(PG8_SA(0, 1), a2 + hstep, voffA);
            PG8_WAIT_V(8); PG8_WAIT_L(0); PG8_BAR; PG8_MMA(0, 0, At, B0); PG8_MMA(0, 1, At, B1); PG8_BAR; PG8_SCHED;
            PG8_LDA(At, 1, 1); PG8_STAGE(PG8_SB(1, 0), b3, voffB); PG8_STAGE(PG8_SB(1, 1), b3 + hstep, voffB); PG8_STAGE(PG8_SA(1, 0), a3, voffA);
            PG8_WAIT_V(8); PG8_WAIT_L(0); PG8_BAR; PG8_MMA(1, 0, At, B0); PG8_MMA(1, 1, At, B1); PG8_BAR; PG8_SCHED;
            } else {
            PG8_LDB(B0, 0, 0); PG8_SCHED; PG8_LDA(At, 0, 0); PG8_STAGE(PG8_SA(1, 1), a1 + hstep, voffA);
            PG8_WAIT_L(8); PG8_BAR; PG8_WAIT_L(0); PG8_MMA(0, 0, At, B0); PG8_BAR; PG8_SCHED;
            PG8_LDB(B1, 0, 1); PG8_STAGE(PG8_SB(0, 0), b2, voffB);
            PG8_BAR; PG8_WAIT_L(0); PG8_MMA(0, 1, At, B1); PG8_BAR;
            PG8_LDA(At, 0, 1); PG8_STAGE(PG8_SA(0, 0), a2, voffA);
            PG8_BAR; PG8_WAIT_L(0); PG8_MMA(1, 0, At, B0); PG8_BAR; PG8_SCHED;
            PG8_STAGE(PG8_SB(0, 1), b2 + hstep, voffB);
            PG8_WAIT_V(6); PG8_BAR; PG8_MMA(1, 1, At, B1); PG8_BAR;
            PG8_LDB(B0, 1, 0); PG8_SCHED; PG8_LDA(At, 1, 0); PG8_STAGE(PG8_SA(0, 1), a2 + hstep, voffA);
            PG8_WAIT_L(8); PG8_BAR; PG8_WAIT_L(0); PG8_MMA(0, 0, At, B0); PG8_BAR; PG8_SCHED;
            PG8_LDB(B1, 1, 1); PG8_STAGE(PG8_SB(1, 0), b3, voffB);
            PG8_BAR; PG8_WAIT_L(0); PG8_MMA(0, 1, At, B1); PG8_BAR;
            PG8_LDA(At, 1, 1); PG8_STAGE(PG8_SA(1, 0), a3, voffA);
            PG8_BAR; PG8_WAIT_L(0); PG8_MMA(1, 0, At, B0); PG8_BAR; PG8_SCHED;
            PG8_STAGE(PG8_SB(1, 1), b3 + hstep, voffB);
            PG8_WAIT_V(6); PG8_BAR; PG8_MMA(1, 1, At, B1); PG8_BAR;
            }
        }
        if constexpr (ALIGN_EPI) { if (wr == 0) PG8_BAR; }
        if constexpr (!Epi::AFTER_DRAIN) { E(acc, cur, wr, wc, fr, fq); S.done(cur); }
        if (!has_next) break;
#pragma unroll
        for (int a = 0; a < 2; ++a)
#pragma unroll
            for (int b = 0; b < 2; ++b)
#pragma unroll
                for (int m = 0; m < 4; ++m)
#pragma unroll
                    for (int n = 0; n < 2; ++n) acc[a][b][m][n] = (f32x4){0.f, 0.f, 0.f, 0.f};
        cur = nxt; cA = nA; cB = nB; ++ui;
        if constexpr (ALIGN_EPI) { if (wr == 1) PG8_BAR; }
    }
    PG8_WAIT_V(0);
    if constexpr (!ALIGN_EPI) { if (wr == 0) PG8_BAR; }
    PG8_BAR;
    if constexpr (Epi::AFTER_DRAIN) { E.fused(acc, cur, wr, wc, fr, fq, lds, wid, lane); S.done(cur); }
#undef PG8_SA
#undef PG8_SB
#undef PG8_STAGE
#undef PG8_LDA
#undef PG8_LDB
#undef PG8_MMA
#undef PG8_WAIT_V
#undef PG8_WAIT_L
#undef PG8_BAR
#undef PG8_SCHED
}
}

constexpr int NWAVES = 8;
constexpr int BATCH = 2, SEQ = 8192, M = BATCH * SEQ, D = 2048, DEPTH = 4;
constexpr int DFF = 5504, NFF = 2 * DFF;
constexpr int NMIX = 4624, NMIXP = 4864, MIXLD = 4608;
constexpr int C_QA = 0, C_KA = 1024, C_VA = 1280, C_QG = 1536, C_KG = 2048, C_VG = 2560, C_RG = 3584;
constexpr float NORM_EPS = 1e-6f;

constexpr size_t MiB = 1u << 20;
constexpr size_t WS_CTL = 0, CTL_ZERO_BYTES = 1 * MiB;
constexpr size_t SZ_WFI = (size_t)8 * NFF * D * 2, SZ_WFO = (size_t)8 * D * DFF * 2, SZ_WMI = (size_t)4 * NMIXP * D * 2, SZ_WMO = (size_t)4 * D * D * 2;
constexpr size_t WS_WFI = 2 * MiB;
constexpr size_t WS_WFO = WS_WFI + SZ_WFI;
constexpr size_t WS_WMI = WS_WFO + SZ_WFO;
constexpr size_t WS_WMO = WS_WMI + SZ_WMI;
constexpr size_t WS_XN  = WS_WMO + SZ_WMO;
constexpr size_t WS_ACT = WS_XN + (size_t)M * D * 2;
constexpr size_t WS_H   = WS_ACT + (size_t)M * DFF * 2;
constexpr size_t WS_MIX = WS_H + (size_t)M * D * 2;
constexpr size_t WS_GLR = WS_MIX + (size_t)M * MIXLD * 2;
constexpr size_t WS_LOGA = WS_GLR + (size_t)M * 16 * 4;
constexpr size_t WS_ROPE = WS_LOGA + (size_t)M * 512 * 4;
constexpr size_t WS_MO  = WS_ROPE + (size_t)M * 64 * 4;
constexpr size_t WS_OG  = WS_MO + (size_t)M * D * 2;
constexpr size_t WS_BC  = WS_OG + (size_t)M * 1024 * 4;
constexpr size_t WS_DEC = WS_BC + (size_t)M * 512 * 4;
constexpr size_t WS_DS  = WS_DEC + (size_t)1024 * 128 * 4;
constexpr size_t WS_ST  = WS_DS + (size_t)1024 * 32768 * 4;
constexpr size_t WS_END = WS_ST + (size_t)1024 * 32768 * 2;
static_assert(WS_WFI % 256 == 0 && WS_WFO % 256 == 0 && WS_WMI % 256 == 0 && WS_WMO % 256 == 0 && WS_XN % 256 == 0 && WS_ACT % 256 == 0 && WS_H % 256 == 0 && WS_MIX % 256 == 0 && WS_GLR % 256 == 0 && WS_LOGA % 256 == 0 && WS_ROPE % 256 == 0 && WS_MO % 256 == 0 && WS_OG % 256 == 0 && WS_BC % 256 == 0 && WS_DEC % 256 == 0 && WS_DS % 256 == 0 && WS_ST % 256 == 0, "alignment");
constexpr int CW_BAR = 4096;

constexpr int RING_OFF = 0, RING_BYTES = 131072;
constexpr int LDSCTL_OFF = RING_BYTES, MISC_OFF = LDSCTL_OFF + 320;
constexpr int LDS_BYTES = 147456;
static_assert(MISC_OFF + 128 <= LDS_BYTES, "LDS map");
constexpr int G_KT = 0;
constexpr int G_VT = 18432;
constexpr int G_SEG = 55296;
constexpr int G3_QD = 57344;
constexpr int G3_KD = 74752;
constexpr int G3_IN = 92160;
constexpr int G3_SS = 101376;
static_assert(G3_SS + 2048 <= RING_BYTES, "GLA LDS map");
constexpr int A_KS = 0;
constexpr int A_VT = 36864;
static_assert(A_VT + 64 * 528 <= RING_BYTES, "attention LDS map");
#define GAS __attribute__((address_space(1)))
#define LAS __attribute__((address_space(3)))
typedef unsigned short bf16;
typedef unsigned v4u __attribute__((ext_vector_type(4)));
typedef float f32x4 __attribute__((ext_vector_type(4)));
typedef short bf16x8 __attribute__((ext_vector_type(8)));
typedef GAS unsigned gu32;
typedef GAS unsigned long long gu64;
#define RLX_AGENT __ATOMIC_RELAXED, __HIP_MEMORY_SCOPE_AGENT
#define LDS_WAIT() asm volatile("s_waitcnt lgkmcnt(0)" ::: "memory")
#define VM_WAIT() asm volatile("s_waitcnt vmcnt(0)" ::: "memory")
__device__ __forceinline__ unsigned long long rt() { return __builtin_amdgcn_s_memrealtime(); }
__device__ __forceinline__ unsigned f2bf(float f) { unsigned u = __builtin_bit_cast(unsigned, f); return (u + 0x7fffu + ((u >> 16) & 1u)) >> 16; }
__device__ __forceinline__ unsigned pk2(float lo, float hi) { return f2bf(lo) | (f2bf(hi) << 16); }
#define XB_TMO      128
#define XB_XCNT(j)  (256  + 64 * (j))
#define XB_XSUB(j)  (1280 + 64 * (j))
#define XB_XGEN(j)  (2304 + 64 * (j))
#define XB_TOP      3328
#define XB_TOPGEN   3392
#define XCD_BAR_WORDS 3456
#define XB_SPIN_CAP (1u << 18)

__device__ __forceinline__ unsigned xb_ld(unsigned* p)              { return __hip_atomic_load(p, __ATOMIC_RELAXED, __HIP_MEMORY_SCOPE_AGENT); }
__device__ __forceinline__ unsigned xb_add(unsigned* p, unsigned v) { return __hip_atomic_fetch_add(p, v, __ATOMIC_RELAXED, __HIP_MEMORY_SCOPE_AGENT); }
__device__ __forceinline__ unsigned xb_xcc_id() { return (unsigned)__builtin_amdgcn_s_getreg((3 << 11) | 20) & 0xFu; }
#define XB_SPIN(cond, bar) do { unsigned _sp = 0; while (cond) { __builtin_amdgcn_s_sleep(1); \
    if ((++_sp & 255u) == 0u) { if (xb_ld(&(bar)[XB_TMO])) break; if (_sp > XB_SPIN_CAP) { atomicAdd(&(bar)[XB_TMO], 1u); break; } } } } while (0)

struct XcdBarrier {
    unsigned* bar; unsigned x;
    volatile LAS unsigned* st;
};

__device__ __forceinline__ XcdBarrier xcd_barrier_post(unsigned* bar, volatile LAS unsigned* st) {
    XcdBarrier b; b.bar = bar; b.x = xb_xcc_id(); b.st = st;
    if (threadIdx.x == 0) (void)xb_add(&bar[XB_XCNT(b.x)], 1u);
    return b;
}
__device__ __forceinline__ void xcd_barrier_complete(unsigned* bar, unsigned x, unsigned& nloc, unsigned& nx) {
    const unsigned G = gridDim.x * gridDim.y * gridDim.z;
    unsigned sum, cnt, mine, sp = 0u;
    for (;;) {
        sum = 0u; cnt = 0u; mine = 0u;
#pragma unroll
        for (unsigned j = 0; j < 16; ++j) { const unsigned c = xb_ld(&bar[XB_XCNT(j)]); sum += c; cnt += (c > 0u) ? 1u : 0u; mine = (j == x) ? c : mine; }
        if (sum == G) break;
        __builtin_amdgcn_s_sleep(1);
        if ((++sp & 255u) == 0u) { if (xb_ld(&bar[XB_TMO])) break; if (sp > XB_SPIN_CAP) { atomicAdd(&bar[XB_TMO], 1u); break; } }
    }
    nloc = mine > 0u ? mine : 1u; nx = cnt > 0u ? cnt : 1u;
}

__device__ __forceinline__ void xcd_barrier(const XcdBarrier& b) {
    asm volatile("s_waitcnt vmcnt(0)" ::: "memory");
    __syncthreads();
    if (threadIdx.x == 0) {
        unsigned* bar = b.bar;
        __builtin_amdgcn_s_waitcnt(0);
        unsigned nloc = b.st[0], nx = b.st[1];
        if (nloc == 0u) { xcd_barrier_complete(bar, b.x, nloc, nx); b.st[0] = nloc; b.st[1] = nx; }
        const unsigned old = xb_add(&bar[XB_XSUB(b.x)], 1u);
        const unsigned gen = old / nloc;
        if (old + 1u == (gen + 1u) * nloc) {
            __builtin_amdgcn_fence(__ATOMIC_RELEASE, "agent");
            asm volatile("s_waitcnt vmcnt(0)" ::: "memory");
            const unsigned og = xb_add(&bar[XB_TOP], 1u);
            const unsigned tg = og / nx;
            if (og + 1u == (tg + 1u) * nx) xb_add(&bar[XB_TOPGEN], 1u);
            else XB_SPIN(xb_ld(&bar[XB_TOPGEN]) == tg, bar);
            __builtin_amdgcn_fence(__ATOMIC_ACQUIRE, "agent");
            xb_add(&bar[XB_XGEN(b.x)], 1u);
            asm volatile("s_waitcnt vmcnt(0)" ::: "memory");
        } else {
            XB_SPIN(xb_ld(&bar[XB_XGEN(b.x)]) == gen, bar);
            __builtin_amdgcn_fence(__ATOMIC_ACQUIRE, "agent");
            asm volatile("s_waitcnt vmcnt(0)" ::: "memory");
        }
    }
    __syncthreads();
}

typedef unsigned v2u __attribute__((ext_vector_type(2)));
typedef float v2f __attribute__((ext_vector_type(2)));
struct Frame {
    LAS unsigned char* lds;
    volatile LAS unsigned* MISC;
    gu32* ctl;
    int tid, lane, wave;
    int vcu, G;
    const float* x; const int* pos; const float* gains; const float* w_fi; const float* w_fo; const float* w_mi; const float* sinks; const float* gate_w2; const float* gate_b; const float* gla_gain; const float* w_mo;
    float* out;
    bf16 *WFI, *WFO, *WMI, *WMO, *XN, *ACT, *H, *MIX, *MO;
    float *GLR, *LOGA, *ROPE, *OG, *BC, *DEC, *DS; bf16* ST;
};
#define RELAUNDER(F) do { int t_ = threadIdx.x; asm volatile("" : "+v"(t_)); (F).tid = t_; (F).lane = t_ & 63; (F).wave = __builtin_amdgcn_readfirstlane(t_ >> 6); \
    const __attribute__((address_space(4))) char* kb_ = (const __attribute__((address_space(4))) char*)__builtin_amdgcn_kernarg_segment_ptr(); asm volatile("" : "+s"(kb_)); \
    GAS void* const __attribute__((address_space(4)))* ka_ = (GAS void* const __attribute__((address_space(4)))*)kb_;     \
    (F).x = (const float*)ka_[0]; (F).pos = (const int*)ka_[1]; (F).gains = (const float*)ka_[2]; (F).w_fi = (const float*)ka_[3]; (F).w_fo = (const float*)ka_[4]; (F).w_mi = (const float*)ka_[5]; \
    (F).sinks = (const float*)ka_[6]; (F).gate_w2 = (const float*)ka_[7]; (F).gate_b = (const float*)ka_[8]; (F).gla_gain = (const float*)ka_[9]; (F).w_mo = (const float*)ka_[10]; (F).out = (float*)ka_[11]; \
    unsigned char* ws_ = (unsigned char*)ka_[12]; \
    (F).WFI = (bf16*)(ws_ + WS_WFI); (F).WFO = (bf16*)(ws_ + WS_WFO); (F).WMI = (bf16*)(ws_ + WS_WMI); (F).WMO = (bf16*)(ws_ + WS_WMO); \
    (F).XN = (bf16*)(ws_ + WS_XN); (F).ACT = (bf16*)(ws_ + WS_ACT); (F).H = (bf16*)(ws_ + WS_H); (F).MIX = (bf16*)(ws_ + WS_MIX); (F).MO = (bf16*)(ws_ + WS_MO); \
    (F).GLR = (float*)(ws_ + WS_GLR); (F).LOGA = (float*)(ws_ + WS_LOGA); (F).ROPE = (float*)(ws_ + WS_ROPE); (F).OG = (float*)(ws_ + WS_OG); (F).BC = (float*)(ws_ + WS_BC); (F).DEC = (float*)(ws_ + WS_DEC); (F).DS = (float*)(ws_ + WS_DS); (F).ST = (bf16*)(ws_ + WS_ST); } while (0)
__device__ __forceinline__ float wave_sum(float v) {
#pragma unroll
    for (int o = 1; o < 64; o <<= 1) v += __shfl_xor(v, o);
    return v;
}
__device__ __forceinline__ float wave_max(float v) {
#pragma unroll
    for (int o = 1; o < 64; o <<= 1) v = fmaxf(v, __shfl_xor(v, o));
    return v;
}
__device__ __forceinline__ float bf_lo(unsigned w) { return __builtin_bit_cast(float, w << 16); }
__device__ __forceinline__ float bf_hi(unsigned w) { return __builtin_bit_cast(float, w & 0xffff0000u); }
__device__ __forceinline__ float bf1(bf16 h) { return __builtin_bit_cast(float, ((unsigned)h) << 16); }

template <int MODE>
__device__ __forceinline__ void cvt_item(const float* W, int K, int N, bf16* WT, int nb, int kb, int lane) {
    const int nd = nb * 256 + 4 * lane;
    int src = nd; bool valid = true;
    if (MODE == 1) { const int w = 4 * lane; src = ((w >> 7) ? DFF : 0) + nb * 128 + (w & 127); }
    if (MODE == 2) valid = nd < NMIX;
    const float* wp = W + (size_t)(kb * 64) * N + src;
    bf16* op = WT + (size_t)nd * K + kb * 64;
#pragma unroll 1
    for (int ks = 0; ks < 8; ks += 2) {
        f32x4 v[16];
#pragma unroll
        for (int i = 0; i < 16; ++i) v[i] = valid ? *(const f32x4*)(wp + (size_t)(ks * 8 + i) * N) : (f32x4){0.f, 0.f, 0.f, 0.f};
#pragma unroll
        for (int h = 0; h < 2; ++h)
#pragma unroll
            for (int j = 0; j < 4; ++j) {
                v4u o; o.x = pg8::cvt_pk_bf16(v[h * 8 + 0][j], v[h * 8 + 1][j]); o.y = pg8::cvt_pk_bf16(v[h * 8 + 2][j], v[h * 8 + 3][j]);
                o.z = pg8::cvt_pk_bf16(v[h * 8 + 4][j], v[h * 8 + 5][j]); o.w = pg8::cvt_pk_bf16(v[h * 8 + 6][j], v[h * 8 + 7][j]);
                *(v4u*)(op + (size_t)j * K + (ks + h) * 8) = o; }
    }
}
template <bool FIRST>
__device__ __forceinline__ void norm_phase(Frame& F, bool from_input, int ia, int ib, float cres, bool write_xn) {
    RELAUNDER(F);
    const float* xsrc = from_input ? F.x : F.out; float* xdst = F.out; const float* ga = F.gains + (size_t)ia * D; const float* gb = F.gains + (size_t)ib * D;
    const int gw = F.vcu * NWAVES + F.wave, NGW = F.G * NWAVES;
    f32x4 GA[8], GB[8];
#pragma unroll
    for (int j = 0; j < 4; ++j) {
        if (!FIRST) { GA[2 * j] = *(const f32x4*)(ga + 8 * F.lane + 512 * j); GA[2 * j + 1] = *(const f32x4*)(ga + 8 * F.lane + 512 * j + 4); }
        if (write_xn) { GB[2 * j] = *(const f32x4*)(gb + 8 * F.lane + 512 * j); GB[2 * j + 1] = *(const f32x4*)(gb + 8 * F.lane + 512 * j + 4); }
        else { GB[2 * j] = (f32x4){0.f, 0.f, 0.f, 0.f}; GB[2 * j + 1] = (f32x4){0.f, 0.f, 0.f, 0.f}; } }
    for (int m = gw; m < M; m += NGW) {
        const float* xr = xsrc + (size_t)m * D + 8 * F.lane;
        f32x4 xv[8];
#pragma unroll
        for (int j = 0; j < 4; ++j) { xv[2 * j] = *(const f32x4*)(xr + 512 * j); xv[2 * j + 1] = *(const f32x4*)(xr + 512 * j + 4); }
        if (!FIRST) {
            const bf16* hr = F.H + (size_t)m * D + 8 * F.lane;
            v4u hv[4];
#pragma unroll
            for (int j = 0; j < 4; ++j) hv[j] = *(const v4u*)(hr + 512 * j);
            f32x4 hf[8]; float ss = 0.f;
#pragma unroll
            for (int j = 0; j < 4; ++j) {
                hf[2 * j] = (f32x4){bf_lo(hv[j].x), bf_hi(hv[j].x), bf_lo(hv[j].y), bf_hi(hv[j].y)};
                hf[2 * j + 1] = (f32x4){bf_lo(hv[j].z), bf_hi(hv[j].z), bf_lo(hv[j].w), bf_hi(hv[j].w)}; }
#pragma unroll
            for (int j = 0; j < 8; ++j) ss += (hf[j].x * hf[j].x + hf[j].y * hf[j].y) + (hf[j].z * hf[j].z + hf[j].w * hf[j].w);
            const float rs = 1.0f / sqrtf(wave_sum(ss) * (1.0f / D) + NORM_EPS);
            float* xw = xdst + (size_t)m * D + 8 * F.lane;
#pragma unroll
            for (int j = 0; j < 8; ++j) { xv[j] = xv[j] + cres * ((hf[j] * rs) * GA[j]); }
#pragma unroll
            for (int j = 0; j < 4; ++j) { *(f32x4*)(xw + 512 * j) = xv[2 * j]; *(f32x4*)(xw + 512 * j + 4) = xv[2 * j + 1]; }
        }
        if (write_xn) {
            float s2 = 0.f;
#pragma unroll
            for (int j = 0; j < 8; ++j) s2 += (xv[j].x * xv[j].x + xv[j].y * xv[j].y) + (xv[j].z * xv[j].z + xv[j].w * xv[j].w);
            const float r2 = 1.0f / sqrtf(wave_sum(s2) * (1.0f / D) + NORM_EPS);
            bf16* xo = F.XN + (size_t)m * D + 8 * F.lane;
#pragma unroll
            for (int j = 0; j < 4; ++j) { const f32x4 a = (xv[2 * j] * r2) * GB[2 * j], b = (xv[2 * j + 1] * r2) * GB[2 * j + 1];
                v4u o; o.x = pg8::cvt_pk_bf16(a.x, a.y); o.y = pg8::cvt_pk_bf16(a.z, a.w); o.z = pg8::cvt_pk_bf16(b.x, b.y); o.w = pg8::cvt_pk_bf16(b.z, b.w);
                *(v4u*)(xo + 512 * j) = o; }
        }
    }
}
__device__ __forceinline__ void p0_prologue(Frame& F) {
    RELAUNDER(F);
    const int gw = F.vcu * NWAVES + F.wave, NGW = F.G * NWAVES;
    constexpr int PER_FI = (NFF / 256) * (D / 64), PER_FO = (D / 256) * (DFF / 64), PER_MI = (NMIXP / 256) * (D / 64), PER_MO = (D / 256) * (D / 64);
    constexpr int IT_FI = 8 * PER_FI, IT_FO = 8 * PER_FO, IT_MI = 4 * PER_MI, IT_MO = 4 * PER_MO;
    for (int it = gw; it < IT_FI + IT_FO + IT_MI + IT_MO; it += NGW) {
        int r = it;
        if (r < IT_FI) { const int mat = r / PER_FI, q = r % PER_FI, kb = q / (NFF / 256), nb = q % (NFF / 256);
            cvt_item<1>(F.w_fi + (size_t)mat * D * NFF, D, NFF, F.WFI + (size_t)mat * NFF * D, nb, kb, F.lane); continue; } r -= IT_FI;
        if (r < IT_FO) { const int mat = r / PER_FO, q = r % PER_FO, kb = q / (D / 256), nb = q % (D / 256);
            cvt_item<0>(F.w_fo + (size_t)mat * DFF * D, DFF, D, F.WFO + (size_t)mat * D * DFF, nb, kb, F.lane); continue; } r -= IT_FO;
        if (r < IT_MI) { const int mat = r / PER_MI, q = r % PER_MI, kb = q / (NMIXP / 256), nb = q % (NMIXP / 256);
            cvt_item<2>(F.w_mi + (size_t)mat * D * NMIX, D, NMIX, F.WMI + (size_t)mat * NMIXP * D, nb, kb, F.lane); continue; } r -= IT_MI;
        { const int mat = r / PER_MO, q = r % PER_MO, kb = q / (D / 256), nb = q % (D / 256);
            cvt_item<0>(F.w_mo + (size_t)mat * D * D, D, D, F.WMO + (size_t)mat * D * D, nb, kb, F.lane); }
    }
    for (int e = (F.vcu * NWAVES + F.wave) * 64 + F.lane; e < M * 32; e += NGW * 64) {
        const int m = e >> 5, i = e & 31;
        double pw = 1.0; for (int k = 0; k < i; ++k) pw *= 0.7498942093324559;
        const float a = (float)F.pos[m] * (float)pw;
        const double ad = (double)a, k = rint(ad * 0.15915494309189535), r = fma(-k, 6.283185307179586, ad);
        const float rf = (float)r;
        F.ROPE[(size_t)m * 64 + i] = cosf(rf); F.ROPE[(size_t)m * 64 + 32 + i] = sinf(rf);
    }
    norm_phase<true>(F, true, 0, 0, 0.f, true);
}

__device__ __forceinline__ void rope8(bf16* p, const f32x4& c0, const f32x4& c1, const f32x4& s0, const f32x4& s1, float scale) {
    const v4u lo = *(const v4u*)p, hi = *(const v4u*)(p + 32);
    const float x1[8] = {bf_lo(lo.x), bf_hi(lo.x), bf_lo(lo.y), bf_hi(lo.y), bf_lo(lo.z), bf_hi(lo.z), bf_lo(lo.w), bf_hi(lo.w)};
    const float x2[8] = {bf_lo(hi.x), bf_hi(hi.x), bf_lo(hi.y), bf_hi(hi.y), bf_lo(hi.z), bf_hi(hi.z), bf_lo(hi.w), bf_hi(hi.w)};
    const float cc[8] = {c0.x, c0.y, c0.z, c0.w, c1.x, c1.y, c1.z, c1.w}, sn[8] = {s0.x, s0.y, s0.z, s0.w, s1.x, s1.y, s1.z, s1.w};
    float o1[8], o2[8];
#pragma unroll
    for (int i = 0; i < 8; ++i) { o1[i] = (x1[i] * cc[i] - x2[i] * sn[i]) * scale; o2[i] = (x2[i] * cc[i] + x1[i] * sn[i]) * scale; }
    v4u a, b; a.x = pg8::cvt_pk_bf16(o1[0], o1[1]); a.y = pg8::cvt_pk_bf16(o1[2], o1[3]); a.z = pg8::cvt_pk_bf16(o1[4], o1[5]); a.w = pg8::cvt_pk_bf16(o1[6], o1[7]);
    b.x = pg8::cvt_pk_bf16(o2[0], o2[1]); b.y = pg8::cvt_pk_bf16(o2[2], o2[3]); b.z = pg8::cvt_pk_bf16(o2[4], o2[5]); b.w = pg8::cvt_pk_bf16(o2[6], o2[7]);
    *(v4u*)p = a; *(v4u*)(p + 32) = b;
}
__device__ __forceinline__ void prep_phase(Frame& F, int l) {
    RELAUNDER(F);
    const int gw = F.vcu * NWAVES + F.wave, NGW = F.G * NWAVES;
    const float* w2 = F.gate_w2 + (size_t)l * 16 * 512 + 8 * F.lane; const float* gb = F.gate_b + (size_t)l * 512 + 8 * F.lane;
    f32x4 W2[16][2];
#pragma unroll
    for (int r = 0; r < 16; ++r) { W2[r][0] = *(const f32x4*)(w2 + r * 512); W2[r][1] = *(const f32x4*)(w2 + r * 512 + 4); }
    const f32x4 B0 = *(const f32x4*)gb, B1 = *(const f32x4*)(gb + 4);
    for (int m = gw; m < M; m += NGW) {
        bf16* row = F.MIX + (size_t)m * MIXLD;
        const float* cs = F.ROPE + (size_t)m * 64;
        { const int head = F.lane >> 2, i0 = 8 * (F.lane & 3);
          const f32x4 c0 = *(const f32x4*)(cs + i0), c1 = *(const f32x4*)(cs + i0 + 4), s0 = *(const f32x4*)(cs + 32 + i0), s1 = *(const f32x4*)(cs + 32 + i0 + 4);
          rope8(row + C_QA + head * 64 + i0, c0, c1, s0, s1, 0.125f);
          if (F.lane < 16) rope8(row + C_KA + head * 64 + i0, c0, c1, s0, s1, 1.0f); }
        { const float* gr = F.GLR + (size_t)m * 16;
          const f32x4 g0 = *(const f32x4*)gr, g1 = *(const f32x4*)(gr + 4), g2 = *(const f32x4*)(gr + 8), g3 = *(const f32x4*)(gr + 12);
          const float g[16] = {g0.x, g0.y, g0.z, g0.w, g1.x, g1.y, g1.z, g1.w, g2.x, g2.y, g2.z, g2.w, g3.x, g3.y, g3.z, g3.w};
          f32x4 z0 = B0, z1 = B1;
#pragma unroll
          for (int r = 0; r < 16; ++r) { z0 = z0 + g[r] * W2[r][0]; z1 = z1 + g[r] * W2[r][1]; }
          float z[8] = {z0.x, z0.y, z0.z, z0.w, z1.x, z1.y, z1.z, z1.w};
#pragma unroll
          for (int e = 0; e < 8; ++e) z[e] = (fminf(z[e], 0.f) - log1pf(expf(-fabsf(z[e])))) * 0.0625f;
          float* lo = F.LOGA + (size_t)m * 512 + 8 * F.lane;
          *(f32x4*)lo = (f32x4){z[0], z[1], z[2], z[3]}; *(f32x4*)(lo + 4) = (f32x4){z[4], z[5], z[6], z[7]}; }
    }
}
__device__ __forceinline__ void attn_naive(Frame& F, int l) {
    RELAUNDER(F);
    const int gw = F.vcu * NWAVES + F.wave, NGW = F.G * NWAVES;
    LAS bf16* qs = (LAS bf16*)(F.lds + RING_OFF + F.wave * 1024);
    const float* sk = F.sinks + l * 16;
    for (int it = gw; it < M * 4; it += NGW) {
        const int m = it >> 2, h = it & 3, t = m & (SEQ - 1);
        const bf16* row = F.MIX + (size_t)m * MIXLD;
        *(LAS v2u*)(qs + 4 * F.lane) = *(const v2u*)(row + C_QA + h * 256 + 4 * F.lane);
        LDS_WAIT();
        float s[2][4]; bool valid[2];
#pragma unroll
        for (int kk = 0; kk < 2; ++kk) {
            const int diff = F.lane + 64 * kk; valid[kk] = (t >= diff);
            const bf16* kr = F.MIX + (size_t)(valid[kk] ? m - diff : m) * MIXLD + C_KA + h * 64;
            float a[4] = {0.f, 0.f, 0.f, 0.f};
#pragma unroll 1
            for (int c = 0; c < 8; ++c) {
                const v4u kv = *(const v4u*)(kr + 8 * c);
                const float kf[8] = {bf_lo(kv.x), bf_hi(kv.x), bf_lo(kv.y), bf_hi(kv.y), bf_lo(kv.z), bf_hi(kv.z), bf_lo(kv.w), bf_hi(kv.w)};
#pragma unroll
                for (int g = 0; g < 4; ++g) { const v4u qv = *(const LAS v4u*)(qs + g * 64 + 8 * c);
                    a[g] += (kf[0] * bf_lo(qv.x) + kf[1] * bf_hi(qv.x)) + (kf[2] * bf_lo(qv.y) + kf[3] * bf_hi(qv.y)) + (kf[4] * bf_lo(qv.z) + kf[5] * bf_hi(qv.z)) + (kf[6] * bf_lo(qv.w) + kf[7] * bf_hi(qv.w)); }
            }
#pragma unroll
            for (int g = 0; g < 4; ++g) s[kk][g] = a[g];
        }
        float p[2][4], inv[4];
#pragma unroll
        for (int g = 0; g < 4; ++g) {
            const float sink = sk[h * 4 + g];
            float mx = fmaxf(valid[0] ? s[0][g] : -INFINITY, valid[1] ? s[1][g] : -INFINITY);
            mx = fmaxf(wave_max(mx), sink);
            p[0][g] = valid[0] ? expf(s[0][g] - mx) : 0.f; p[1][g] = valid[1] ? expf(s[1][g] - mx) : 0.f;
            inv[g] = 1.0f / (wave_sum(p[0][g] + p[1][g]) + expf(sink - mx));
        }
        float acc[4] = {0.f, 0.f, 0.f, 0.f};
        const int nk = (t + 1 < 128) ? t + 1 : 128, n0 = nk < 64 ? nk : 64;
        const bf16* vb = F.MIX + (size_t)m * MIXLD + C_VA + h * 64 + F.lane;
        for (int j = 0; j < n0; ++j) { const float v = bf1(*(vb - (size_t)j * MIXLD));
#pragma unroll
            for (int g = 0; g < 4; ++g) acc[g] += __shfl(p[0][g], j) * v; }
        for (int j = 64; j < nk; ++j) { const float v = bf1(*(vb - (size_t)j * MIXLD));
#pragma unroll
            for (int g = 0; g < 4; ++g) acc[g] += __shfl(p[1][g], j - 64) * v; }
        bf16* op = F.MO + (size_t)m * D + h * 256 + F.lane;
#pragma unroll
        for (int g = 0; g < 4; ++g) op[g * 64] = (bf16)f2bf(acc[g] * inv[g]);
    }
}
__device__ __forceinline__ void gla_naive(Frame& F) {
    RELAUNDER(F);
    LAS float* part = (LAS float*)(F.lds + RING_OFF + 16384);
    for (int u = F.vcu; u < 256; u += F.G) {
        const int b = u >> 7, h = (u >> 5) & 3, cg = u & 31;
        const int dk = F.tid & 127, cp = F.tid >> 7, c0 = cg * 8 + cp * 2;
        float S0 = 0.f, S1 = 0.f;
        for (int t0 = 0; t0 < SEQ; t0 += 64) {
#pragma unroll 1
            for (int tb = 0; tb < 64; tb += 8) {
                float la[8]; bf16 kk[8], qq[8]; unsigned vv[8];
#pragma unroll
                for (int i = 0; i < 8; ++i) { const size_t m = (size_t)b * SEQ + t0 + tb + i;
                    la[i] = F.LOGA[m * 512 + h * 128 + dk]; kk[i] = F.MIX[m * MIXLD + C_KG + h * 128 + dk]; qq[i] = F.MIX[m * MIXLD + C_QG + h * 128 + dk];
                    vv[i] = *(const unsigned*)(F.MIX + m * MIXLD + C_VG + h * 256 + c0); }
#pragma unroll
                for (int i = 0; i < 8; ++i) {
                    const float a = expf(la[i]), k = bf1(kk[i]), q = bf1(qq[i]) * 0.08838834764831845f, v0 = bf_lo(vv[i]), v1 = bf_hi(vv[i]);
                    S0 = a * S0 + k * v0; S1 = a * S1 + k * v1;
                    const float o0 = wave_sum(q * S0), o1 = wave_sum(q * S1);
                    if (F.lane == 0) { part[((tb + i) * 8 + F.wave) * 2] = o0; part[((tb + i) * 8 + F.wave) * 2 + 1] = o1; }
                }
            }
            __syncthreads();
            { const int tt = F.tid >> 3, cc = F.tid & 7, cpp = cc >> 1, e = cc & 1;
              const float o = part[(tt * 8 + 2 * cpp) * 2 + e] + part[(tt * 8 + 2 * cpp + 1) * 2 + e];
              F.OG[((size_t)b * SEQ + t0 + tt) * 1024 + h * 256 + cg * 8 + cc] = o; }
            __syncthreads();
        }
    }
}
__device__ __forceinline__ void gla_fin(Frame& F, int l) {
    RELAUNDER(F);
    const int gw = F.vcu * NWAVES + F.wave, NGW = F.G * NWAVES;
    const f32x4 gv = *(const f32x4*)(F.gla_gain + (size_t)l * 256 + 4 * F.lane);
    for (int it = gw; it < M * 4; it += NGW) {
        const int m = it >> 2, h = it & 3;
        const f32x4 o = *(const f32x4*)(F.OG + (size_t)m * 1024 + h * 256 + 4 * F.lane);
        const float rs = 1.0f / sqrtf(wave_sum((o.x * o.x + o.y * o.y) + (o.z * o.z + o.w * o.w)) * (1.0f / 256.0f) + NORM_EPS);
        const v2u rr = *(const v2u*)(F.MIX + (size_t)m * MIXLD + C_RG + h * 256 + 4 * F.lane);
        const float r[4] = {bf_lo(rr.x), bf_hi(rr.x), bf_lo(rr.y), bf_hi(rr.y)};
        float y[4];
#pragma unroll
        for (int e = 0; e < 4; ++e) y[e] = ((o[e] * rs) * gv[e]) * (r[e] / (1.0f + expf(-r[e])));
        v2u w; w.x = pg8::cvt_pk_bf16(y[0], y[1]); w.y = pg8::cvt_pk_bf16(y[2], y[3]);
        *(v2u*)(F.MO + (size_t)m * D + 1024 + h * 256 + 4 * F.lane) = w;
    }
}


__device__ __forceinline__ pg8::f32x4 mma16(bf16x8 x, bf16x8 y, pg8::f32x4 c) { return __builtin_amdgcn_mfma_f32_16x16x32_bf16(x, y, c, 0, 0, 0); }
__device__ __forceinline__ void gla_stage_vt(Frame& F, LAS unsigned char* L, size_t m0, int h) {
    const int dv = F.tid & 255, th = F.tid >> 8; const bf16* vp = F.MIX + (m0 + th * 32) * MIXLD + C_VG + h * 256 + dv;
    unsigned pk[16];
#pragma unroll
    for (int i = 0; i < 16; ++i) pk[i] = (unsigned)vp[(size_t)(2 * i) * MIXLD] | ((unsigned)vp[(size_t)(2 * i + 1) * MIXLD] << 16);
    LAS v4u* dst = (LAS v4u*)(L + G_VT + dv * 144 + th * 64);
#pragma unroll
    for (int j = 0; j < 4; ++j) dst[j] = (v4u){pk[4 * j], pk[4 * j + 1], pk[4 * j + 2], pk[4 * j + 3]};
}
__device__ __forceinline__ void gla_g1(Frame& F) {
    RELAUNDER(F);
    LAS unsigned char* L = F.lds + RING_OFF;
    const int r16 = F.lane & 15, q4 = F.lane >> 4, w = F.wave;
    for (int u = F.vcu; u < 1024; u += F.G) {
        const int c = u >> 2, h = u & 3; const size_t m0 = (size_t)c * 64;
        const int dk = F.tid & 127, tq = F.tid >> 7;
        float bb[16];
        { const float* lp = F.LOGA + (m0 + tq * 16) * 512 + h * 128 + dk; float run = 0.f;
#pragma unroll
          for (int i = 0; i < 16; ++i) { run += lp[(size_t)i * 512]; bb[i] = run; } }
        LAS float* seg = (LAS float*)(L + G_SEG);
        seg[tq * 128 + dk] = bb[15];
        gla_stage_vt(F, L, m0, h);
        __syncthreads();
        float off = 0.f, tot = 0.f;
#pragma unroll
        for (int q = 0; q < 4; ++q) { const float sg = seg[q * 128 + dk]; tot += sg; if (q < tq) off += sg; }
        { const bf16* kp = F.MIX + (m0 + tq * 16) * MIXLD + C_KG + h * 128 + dk; float* bp = F.BC + (m0 + tq * 16) * 512 + h * 128 + dk;
          unsigned pk[8];
#pragma unroll
          for (int i = 0; i < 8; ++i) { const float b0 = bb[2 * i] + off, b1 = bb[2 * i + 1] + off;
              bp[(size_t)(2 * i) * 512] = b0; bp[(size_t)(2 * i + 1) * 512] = b1;
              pk[i] = pg8::cvt_pk_bf16(bf1(kp[(size_t)(2 * i) * MIXLD]) * expf(tot - b0), bf1(kp[(size_t)(2 * i + 1) * MIXLD]) * expf(tot - b1)); }
          LAS v4u* dst = (LAS v4u*)(L + G_KT + dk * 144 + tq * 32);
          dst[0] = (v4u){pk[0], pk[1], pk[2], pk[3]}; dst[1] = (v4u){pk[4], pk[5], pk[6], pk[7]}; }
        if (tq == 0) F.DEC[(size_t)u * 128 + dk] = expf(tot);
        __syncthreads();
        bf16x8 av[2][2];
#pragma unroll
        for (int rb = 0; rb < 2; ++rb)
#pragma unroll
            for (int ks = 0; ks < 2; ++ks) av[rb][ks] = *(const LAS bf16x8*)(L + G_VT + (32 * w + 16 * rb + r16) * 144 + (32 * ks + 8 * q4) * 2);
        float* dsb = F.DS + (size_t)u * 32768;
#pragma unroll
        for (int cb = 0; cb < 8; ++cb) {
            bf16x8 kv[2];
#pragma unroll
            for (int ks = 0; ks < 2; ++ks) kv[ks] = *(const LAS bf16x8*)(L + G_KT + (16 * cb + r16) * 144 + (32 * ks + 8 * q4) * 2);
#pragma unroll
            for (int rb = 0; rb < 2; ++rb) { pg8::f32x4 acc = {0.f, 0.f, 0.f, 0.f};
#pragma unroll
                for (int ks = 0; ks < 2; ++ks) acc = mma16(kv[ks], av[rb][ks], acc);
                *(pg8::f32x4*)(dsb + (size_t)(32 * w + 16 * rb + r16) * 128 + 16 * cb + 4 * q4) = acc; }
        }
        __syncthreads();
    }
}
__device__ __forceinline__ void gla_scan(Frame& F) {
    RELAUNDER(F);
    for (int g = (F.vcu * NWAVES + F.wave) * 64 + F.lane; g < 131072; g += F.G * NWAVES * 64) {
        const int dk2 = g & 63, dv = (g >> 6) & 255, h = (g >> 14) & 3, b = g >> 16;
        const size_t base = (((size_t)b * 128 * 4 + h) * 256 + dv) * 128 + 2 * dk2, nstr = (size_t)4 * 32768;
        const size_t dbase = ((size_t)b * 128 * 4 + h) * 128 + 2 * dk2, dstr = 4 * 128;
        float s0 = 0.f, s1 = 0.f;
#pragma unroll 1
        for (int n = 0; n < 128; n += 8) {
            v2f d[8], dc[8];
#pragma unroll
            for (int i = 0; i < 8; ++i) { d[i] = *(const v2f*)(F.DS + base + (size_t)(n + i) * nstr); dc[i] = *(const v2f*)(F.DEC + dbase + (size_t)(n + i) * dstr); }
#pragma unroll
            for (int i = 0; i < 8; ++i) { *(unsigned*)(F.ST + base + (size_t)(n + i) * nstr) = pg8::cvt_pk_bf16(s0, s1);
                s0 = dc[i].x * s0 + d[i].x; s1 = dc[i].y * s1 + d[i].y; }
        }
    }
}
__device__ __forceinline__ void gla_g3(Frame& F, int l) {
    RELAUNDER(F);
    LAS unsigned char* L = F.lds + RING_OFF;
    const int r16 = F.lane & 15, q4 = F.lane >> 4, w = F.wave;
    for (int u = F.vcu; u < 1024; u += F.G) {
        const int c = u >> 2, h = u & 3; const size_t m0 = (size_t)c * 64;
        const bf16* stb = F.ST + (size_t)u * 32768;
        bf16x8 sf[2][4];
#pragma unroll
        for (int rb = 0; rb < 2; ++rb)
#pragma unroll
            for (int ks = 0; ks < 4; ++ks) sf[rb][ks] = *(const bf16x8*)(stb + (size_t)(32 * w + 16 * rb + r16) * 128 + 32 * ks + 8 * q4);
        { const int t = F.tid >> 3, d0 = (F.tid & 7) * 16; const size_t m = m0 + t;
          const float* bp = F.BC + m * 512 + h * 128 + d0;
          const v4u q0 = *(const v4u*)(F.MIX + m * MIXLD + C_QG + h * 128 + d0), q1 = *(const v4u*)(F.MIX + m * MIXLD + C_QG + h * 128 + d0 + 8);
          const v4u k0 = *(const v4u*)(F.MIX + m * MIXLD + C_KG + h * 128 + d0), k1 = *(const v4u*)(F.MIX + m * MIXLD + C_KG + h * 128 + d0 + 8);
          const unsigned qw[8] = {q0.x, q0.y, q0.z, q0.w, q1.x, q1.y, q1.z, q1.w}, kw[8] = {k0.x, k0.y, k0.z, k0.w, k1.x, k1.y, k1.z, k1.w};
          unsigned qo[8], ko[8];
#pragma unroll
          for (int j = 0; j < 4; ++j) { const f32x4 bv = *(const f32x4*)(bp + 4 * j);
              const float e0 = expf(bv.x), e1 = expf(bv.y), e2 = expf(bv.z), e3 = expf(bv.w), n0 = expf(-bv.x), n1 = expf(-bv.y), n2 = expf(-bv.z), n3 = expf(-bv.w);
              qo[2 * j] = pg8::cvt_pk_bf16(bf_lo(qw[2 * j]) * 0.08838834764831845f * e0, bf_hi(qw[2 * j]) * 0.08838834764831845f * e1);
              qo[2 * j + 1] = pg8::cvt_pk_bf16(bf_lo(qw[2 * j + 1]) * 0.08838834764831845f * e2, bf_hi(qw[2 * j + 1]) * 0.08838834764831845f * e3);
              ko[2 * j] = pg8::cvt_pk_bf16(bf_lo(kw[2 * j]) * n0, bf_hi(kw[2 * j]) * n1);
              ko[2 * j + 1] = pg8::cvt_pk_bf16(bf_lo(kw[2 * j + 1]) * n2, bf_hi(kw[2 * j + 1]) * n3); }
          LAS v4u* qd = (LAS v4u*)(L + G3_QD + t * 272 + d0 * 2); LAS v4u* kd = (LAS v4u*)(L + G3_KD + t * 272 + d0 * 2);
          qd[0] = (v4u){qo[0], qo[1], qo[2], qo[3]}; qd[1] = (v4u){qo[4], qo[5], qo[6], qo[7]};
          kd[0] = (v4u){ko[0], ko[1], ko[2], ko[3]}; kd[1] = (v4u){ko[4], ko[5], ko[6], ko[7]}; }
        gla_stage_vt(F, L, m0, h);
        __syncthreads();
#pragma unroll
        for (int j = 0; j < 2; ++j) {
            const int id = 2 * w + j, tr = id >> 2, sc = id & 3;
            pg8::f32x4 acc = {0.f, 0.f, 0.f, 0.f};
            if (sc <= tr) {
#pragma unroll
                for (int ks = 0; ks < 4; ++ks) acc = mma16(*(const LAS bf16x8*)(L + G3_KD + (16 * sc + r16) * 272 + (32 * ks + 8 * q4) * 2),
                                                           *(const LAS bf16x8*)(L + G3_QD + (16 * tr + r16) * 272 + (32 * ks + 8 * q4) * 2), acc);
                const int t = 16 * tr + r16, s0 = 16 * sc + 4 * q4;
#pragma unroll
                for (int i = 0; i < 4; ++i) if (s0 + i > t) acc[i] = 0.f;
            }
            v2u pk; pk.x = pg8::cvt_pk_bf16(acc[0], acc[1]); pk.y = pg8::cvt_pk_bf16(acc[2], acc[3]);
            *(LAS v2u*)(L + G3_IN + (16 * tr + r16) * 144 + (16 * sc + 4 * q4) * 2) = pk;
        }
        __syncthreads();
        bf16x8 vf[2][2];
#pragma unroll
        for (int rb = 0; rb < 2; ++rb)
#pragma unroll
            for (int ks = 0; ks < 2; ++ks) vf[rb][ks] = *(const LAS bf16x8*)(L + G_VT + (32 * w + 16 * rb + r16) * 144 + (32 * ks + 8 * q4) * 2);
        pg8::f32x4 o[2][4]; float ss[4];
#pragma unroll
        for (int cb = 0; cb < 4; ++cb) {
            bf16x8 qf[4], nf[2];
#pragma unroll
            for (int ks = 0; ks < 4; ++ks) qf[ks] = *(const LAS bf16x8*)(L + G3_QD + (16 * cb + r16) * 272 + (32 * ks + 8 * q4) * 2);
#pragma unroll
            for (int ks = 0; ks < 2; ++ks) nf[ks] = *(const LAS bf16x8*)(L + G3_IN + (16 * cb + r16) * 144 + (32 * ks + 8 * q4) * 2);
            float sq = 0.f;
#pragma unroll
            for (int rb = 0; rb < 2; ++rb) { pg8::f32x4 acc = {0.f, 0.f, 0.f, 0.f};
#pragma unroll
                for (int ks = 0; ks < 4; ++ks) acc = mma16(sf[rb][ks], qf[ks], acc);
#pragma unroll
                for (int ks = 0; ks < 2; ++ks) acc = mma16(vf[rb][ks], nf[ks], acc);
                o[rb][cb] = acc; sq += (acc[0] * acc[0] + acc[1] * acc[1]) + (acc[2] * acc[2] + acc[3] * acc[3]); }
            sq += __shfl_xor(sq, 16); sq += __shfl_xor(sq, 32);
            ss[cb] = sq;
        }
        LAS float* SS = (LAS float*)(L + G3_SS);
        if (q4 == 0) {
#pragma unroll
            for (int cb = 0; cb < 4; ++cb) SS[w * 64 + 16 * cb + r16] = ss[cb]; }
        __syncthreads();
#pragma unroll
        for (int cb = 0; cb < 4; ++cb) {
            float tot = 0.f;
#pragma unroll
            for (int ww = 0; ww < 8; ++ww) tot += SS[ww * 64 + 16 * cb + r16];
            const float rs = 1.0f / sqrtf(tot * (1.0f / 256.0f) + NORM_EPS);
            const size_t m = m0 + 16 * cb + r16;
#pragma unroll
            for (int rb = 0; rb < 2; ++rb) { const int dv = 32 * w + 16 * rb + 4 * q4;
                const f32x4 gv = *(const f32x4*)(F.gla_gain + (size_t)l * 256 + dv);
                const v2u rr = *(const v2u*)(F.MIX + m * MIXLD + C_RG + h * 256 + dv);
                const float r[4] = {bf_lo(rr.x), bf_hi(rr.x), bf_lo(rr.y), bf_hi(rr.y)};
                float y[4];
#pragma unroll
                for (int e = 0; e < 4; ++e) y[e] = ((o[rb][cb][e] * rs) * gv[e]) * (r[e] / (1.0f + expf(-r[e])));
                v2u wv; wv.x = pg8::cvt_pk_bf16(y[0], y[1]); wv.y = pg8::cvt_pk_bf16(y[2], y[3]);
                *(v2u*)(F.MO + m * D + 1024 + h * 256 + dv) = wv; }
        }
        __syncthreads();
    }
}


__device__ __forceinline__ void attn_mfma(Frame& F, int l) {
    RELAUNDER(F);
    LAS unsigned char* L = F.lds + RING_OFF;
    const int r16 = F.lane & 15, q4 = F.lane >> 4, w = F.wave, g = w >> 1, qh = w & 1;
    for (int u = F.vcu; u < 512; u += F.G) {
        const int h = u & 3, nb = u >> 2, n = nb & 63;
        const size_t mq0 = (size_t)nb * 128;
        { const int key = F.tid >> 1, hf = F.tid & 1; const bool ok = (n > 0) || key >= 128;
          const bf16* kp = F.MIX + (ok ? mq0 + key - 128 : mq0) * MIXLD + C_KA + h * 64 + hf * 32;
          v4u a[4];
#pragma unroll
          for (int j = 0; j < 4; ++j) a[j] = ok ? *(const v4u*)(kp + 8 * j) : (v4u){0u, 0u, 0u, 0u};
          LAS v4u* d = (LAS v4u*)(L + A_KS + key * 144 + hf * 64);
#pragma unroll
          for (int j = 0; j < 4; ++j) d[j] = a[j]; }
        { const int d = F.tid & 63, kg = F.tid >> 6; const bool ok = (n > 0) || kg >= 4;
          const bf16* vp = F.MIX + (ok ? mq0 + kg * 32 - 128 : mq0) * MIXLD + C_VA + h * 64 + d;
          unsigned pk[16];
#pragma unroll
          for (int i = 0; i < 16; ++i) pk[i] = ok ? ((unsigned)vp[(size_t)(2 * i) * MIXLD] | ((unsigned)vp[(size_t)(2 * i + 1) * MIXLD] << 16)) : 0u;
          LAS v4u* dst = (LAS v4u*)(L + A_VT + d * 528 + kg * 64);
#pragma unroll
          for (int j = 0; j < 4; ++j) dst[j] = (v4u){pk[4 * j], pk[4 * j + 1], pk[4 * j + 2], pk[4 * j + 3]}; }
        __syncthreads();
        const int hq = h * 4 + g;
        bf16x8 qf[4][2];
#pragma unroll
        for (int cb = 0; cb < 4; ++cb)
#pragma unroll
            for (int ks = 0; ks < 2; ++ks) qf[cb][ks] = *(const bf16x8*)(F.MIX + (mq0 + 64 * qh + 16 * cb + r16) * MIXLD + C_QA + hq * 64 + 32 * ks + 8 * q4);
        const float sink = F.sinks[l * 16 + hq];
#pragma unroll 1
        for (int cb = 0; cb < 4; ++cb) {
            pg8::f32x4 s[12];
#pragma unroll
            for (int kt = 0; kt < 12; ++kt) { pg8::f32x4 acc = {0.f, 0.f, 0.f, 0.f};
#pragma unroll
                for (int ks = 0; ks < 2; ++ks) acc = mma16(*(const LAS bf16x8*)(L + A_KS + (64 * qh + 16 * kt + r16) * 144 + (32 * ks + 8 * q4) * 2), cb == 0 ? qf[0][ks] : cb == 1 ? qf[1][ks] : cb == 2 ? qf[2][ks] : qf[3][ks], acc);
                s[kt] = acc; }
            const int qpos = 64 * qh + 16 * cb + r16;
            float mx = sink;
#pragma unroll
            for (int kt = 0; kt < 12; ++kt)
#pragma unroll
                for (int i = 0; i < 4; ++i) { const int kpos = 64 * qh - 128 + 16 * kt + 4 * q4 + i;
                    const bool valid = (kpos <= qpos) && (kpos > qpos - 128) && (n > 0 || kpos >= 0);
                    s[kt][i] = valid ? s[kt][i] : -INFINITY; mx = fmaxf(mx, s[kt][i]); }
            mx = fmaxf(mx, __shfl_xor(mx, 16)); mx = fmaxf(mx, __shfl_xor(mx, 32));
            float sum = 0.f;
#pragma unroll
            for (int kt = 0; kt < 12; ++kt)
#pragma unroll
                for (int i = 0; i < 4; ++i) { s[kt][i] = expf(s[kt][i] - mx); sum += s[kt][i]; }
            sum += __shfl_xor(sum, 16); sum += __shfl_xor(sum, 32);
            sum += expf(sink - mx);
            pg8::f32x4 o[4];
#pragma unroll
            for (int rb = 0; rb < 4; ++rb) o[rb] = (pg8::f32x4){0.f, 0.f, 0.f, 0.f};
#pragma unroll
            for (int kk = 0; kk < 6; ++kk) {
                v4u pw; pw.x = pg8::cvt_pk_bf16(s[2 * kk][0], s[2 * kk][1]); pw.y = pg8::cvt_pk_bf16(s[2 * kk][2], s[2 * kk][3]);
                pw.z = pg8::cvt_pk_bf16(s[2 * kk + 1][0], s[2 * kk + 1][1]); pw.w = pg8::cvt_pk_bf16(s[2 * kk + 1][2], s[2 * kk + 1][3]);
                const bf16x8 pf = __builtin_bit_cast(bf16x8, pw);
#pragma unroll
                for (int rb = 0; rb < 4; ++rb) {
                    const v2u lo = *(const LAS v2u*)(L + A_VT + (16 * rb + r16) * 528 + (64 * qh + 32 * kk + 4 * q4) * 2);
                    const v2u hi = *(const LAS v2u*)(L + A_VT + (16 * rb + r16) * 528 + (64 * qh + 32 * kk + 16 + 4 * q4) * 2);
                    const v4u vw = {lo.x, lo.y, hi.x, hi.y};
                    o[rb] = mma16(__builtin_bit_cast(bf16x8, vw), pf, o[rb]); }
            }
            const float inv = 1.0f / sum;
            bf16* op = F.MO + (mq0 + qpos) * D + hq * 64 + 4 * q4;
#pragma unroll
            for (int rb = 0; rb < 4; ++rb) { v2u wv; wv.x = pg8::cvt_pk_bf16(o[rb][0] * inv, o[rb][1] * inv); wv.y = pg8::cvt_pk_bf16(o[rb][2] * inv, o[rb][3] * inv);
                *(v2u*)(op + 16 * rb) = wv; }
        }
        __syncthreads();
    }
}

struct Args { const void* in[11]; float* out; unsigned char* ws; };
__global__ void __launch_bounds__(NWAVES * 64, 2) fwd(Args args) {
    extern __shared__ __attribute__((aligned(16))) unsigned char lds[];
    Frame F;
    F.lds = (LAS unsigned char*)lds;
    F.MISC = (volatile LAS unsigned*)(F.lds + MISC_OFF);
    F.tid = threadIdx.x; F.lane = F.tid & 63; F.wave = __builtin_amdgcn_readfirstlane(F.tid >> 6);
    F.G = gridDim.x; { const int bx = blockIdx.x; F.vcu = (F.G % 8 == 0) ? (bx % 8) * (F.G / 8) + bx / 8 : bx; }
    unsigned char* ws = args.ws;
    F.ctl = (gu32*)(ws + WS_CTL);
    RELAUNDER(F);
    for (int u = F.tid; u < (LDS_BYTES - LDSCTL_OFF) / 4; u += NWAVES * 64) ((LAS unsigned*)(F.lds + LDSCTL_OFF))[u] = 0u;
    __syncthreads();
    XcdBarrier bar = xcd_barrier_post((unsigned*)(F.ctl + CW_BAR), F.MISC + 8);

#define GRID_BAR() do { XcdBarrier b_ = bar; GAS unsigned* gb_ = (GAS unsigned*)bar.bar; asm volatile("" : "+s"(gb_), "+s"(b_.x)); b_.bar = (unsigned*)gb_; xcd_barrier(b_); } while (0)
    p0_prologue(F);
    GRID_BAR();

#pragma unroll 1
    for (int l = 0; l < DEPTH; ++l) {
        RELAUNDER(F);
        { pg8::Gemm gm{F.XN, F.WFI + (size_t)(2 * l) * NFF * D, M, NFF, D}; pg8::StaticOrder S; S.init(M, NFF, F.G, (int)blockIdx.x);
          pg8::EpiSwiGLU E{F.ACT, DFF};
          pg8::gemm_phase<pg8::EpiSwiGLU, pg8::StaticOrder, true, true>(F.lds + RING_OFF, gm, S, E); }
        GRID_BAR();
        RELAUNDER(F);
        { pg8::Gemm gm{F.ACT, F.WFO + (size_t)(2 * l) * D * DFF, M, D, DFF}; pg8::StaticOrder S; S.init(M, D, F.G, (int)blockIdx.x);
          pg8::EpiPlain E{F.H, D};
          pg8::gemm_phase<pg8::EpiPlain, pg8::StaticOrder, true, true>(F.lds + RING_OFF, gm, S, E); }
        GRID_BAR();
        norm_phase<false>(F, l == 0, l * 6 + 1, l * 6 + 2, 0.5f, true);
        GRID_BAR();
        RELAUNDER(F);
        { pg8::Gemm gm{F.XN, F.WMI + (size_t)l * NMIXP * D, M, NMIXP, D}; pg8::StaticOrder S; S.init(M, NMIXP, F.G, (int)blockIdx.x);
          pg8::EpiMix E{F.MIX, MIXLD, F.GLR, MIXLD / 256};
          pg8::gemm_phase<pg8::EpiMix, pg8::StaticOrder, true, true>(F.lds + RING_OFF, gm, S, E); }
        GRID_BAR();
        prep_phase(F, l);
        GRID_BAR();
        gla_g1(F);
        attn_mfma(F, l);
        GRID_BAR();
        gla_scan(F);
        GRID_BAR();
        gla_g3(F, l);
        GRID_BAR();
        RELAUNDER(F);
        { pg8::Gemm gm{F.MO, F.WMO + (size_t)l * D * D, M, D, D}; pg8::StaticOrder S; S.init(M, D, F.G, (int)blockIdx.x);
          pg8::EpiPlain E{F.H, D};
          pg8::gemm_phase<pg8::EpiPlain, pg8::StaticOrder, true, true>(F.lds + RING_OFF, gm, S, E); }
        GRID_BAR();
        norm_phase<false>(F, false, l * 6 + 3, l * 6 + 4, 1.0f, true);
        GRID_BAR();
        RELAUNDER(F);
        { pg8::Gemm gm{F.XN, F.WFI + (size_t)(2 * l + 1) * NFF * D, M, NFF, D}; pg8::StaticOrder S; S.init(M, NFF, F.G, (int)blockIdx.x);
          pg8::EpiSwiGLU E{F.ACT, DFF};
          pg8::gemm_phase<pg8::EpiSwiGLU, pg8::StaticOrder, true, true>(F.lds + RING_OFF, gm, S, E); }
        GRID_BAR();
        RELAUNDER(F);
        { pg8::Gemm gm{F.ACT, F.WFO + (size_t)(2 * l + 1) * D * DFF, M, D, DFF}; pg8::StaticOrder S; S.init(M, D, F.G, (int)blockIdx.x);
          pg8::EpiPlain E{F.H, D};
          pg8::gemm_phase<pg8::EpiPlain, pg8::StaticOrder, true, true>(F.lds + RING_OFF, gm, S, E); }
        GRID_BAR();
        norm_phase<false>(F, false, l * 6 + 5, l * 6 + 6  , 0.5f, l + 1 < DEPTH);
        if (l + 1 < DEPTH) GRID_BAR();
    }
}

extern "C" void kernel_launch(void* const* d_in, const int* in_sizes, int n_in, void* d_out, int out_size, void* d_ws, size_t ws_size, hipStream_t stream) {
    static int grid = 0;
    if (grid == 0) {
        if (n_in != 11 || in_sizes[0] != M * D || out_size != M * D || ws_size < WS_END) { fprintf(stderr, "kernel_launch: unexpected shapes (n_in %d, in0 %d, out %d, ws %zu < %zu); nothing launched\n", n_in, n_in > 0 ? in_sizes[0] : -1, out_size, ws_size, (size_t)WS_END); grid = -1; return; }
        int dev = 0, cus = 0, per_cu = 0;
        if (hipGetDevice(&dev) != hipSuccess || hipDeviceGetAttribute(&cus, hipDeviceAttributeMultiprocessorCount, dev) != hipSuccess) { fprintf(stderr, "kernel_launch: device query failed\n"); grid = -1; return; }
        if (hipFuncSetAttribute((const void*)fwd, hipFuncAttributeMaxDynamicSharedMemorySize, LDS_BYTES) != hipSuccess) { fprintf(stderr, "kernel_launch: hipFuncSetAttribute failed\n"); grid = -1; return; }
        if (hipOccupancyMaxActiveBlocksPerMultiprocessor(&per_cu, (const void*)fwd, NWAVES * 64, LDS_BYTES) != hipSuccess || per_cu < 1) { fprintf(stderr, "kernel_launch: occupancy query reports %d workgroups per CU\n", per_cu); }
        (void)hipGetLastError();
        grid = cus;
    }
    if (grid < 0) return;
    if (hipMemsetAsync((char*)d_ws + WS_CTL, 0, CTL_ZERO_BYTES, stream) != hipSuccess) { fprintf(stderr, "kernel_launch: memset failed\n"); return; }
    Args a{};
    for (int i = 0; i < 11; ++i) a.in[i] = d_in[i];
    a.out = (float*)d_out; a.ws = (unsigned char*)d_ws;
    hipLaunchKernelGGL(fwd, dim3(grid), dim3(NWAVES * 64), LDS_BYTES, stream, a);
    const hipError_t le = hipPeekAtLastError();
    if (le != hipSuccess) fprintf(stderr, "kernel_launch: launch failed: %s\n", hipGetErrorName(le));
}
```

```cpp
#include <hip/hip_runtime.h>
#include <cstdio>
#include <cstdint>
#include <cmath>
namespace pg8 {
#define PG8_LAS __attribute__((address_space(3)))
typedef unsigned short bf16_t;
typedef short bf16x8 __attribute__((ext_vector_type(8)));
typedef float f32x4 __attribute__((ext_vector_type(4)));
typedef unsigned u32x4 __attribute__((ext_vector_type(4)));
constexpr int BM = 256, BK = 64, HALF = 128, HTB = HALF * BK * 2  , STAGE_BYTES = 8 * HTB, NXCD = 8, WGM = 8;

__host__ __device__ __forceinline__ int lds_byte(int r, int c) { const int st = (r >> 4) * 2 + (c >> 5), rr = r & 15, cc = c & 31, ob = rr * 64 + cc * 2; return st * 1024 + (ob ^ (((ob >> 9) & 1) << 5)); }
__host__ __device__ __forceinline__ void stage_rc(int b, int& R, int& C) { const int st = b / 1024, sb = b % 1024, swz = sb ^ (((sb >> 9) & 1) << 5); R = (st >> 1) * 16 + swz / 64; C = (st & 1) * 32 + (swz % 64) / 2; }
__host__ __device__ __forceinline__ int perm32(int rho) { const int n = rho >> 4, i = rho & 15; return 8 * (i >> 2) + 4 * n + (i & 3); }

struct Unit { int pm, pn; };
struct Gemm { const bf16_t* A; const bf16_t* Bt; int M, N, K; };

struct StaticOrder {
    int nM, nN, nwg, G, c, nx;
    __host__ __device__ void init(int M, int N, int G_, int c_, int nx_ = NXCD) { nM = M / BM; nN = N / BM; nwg = nM * nN; G = G_; c = c_; nx = nx_; }
    __host__ __device__ bool next(int i, Unit& u) const {
        const long L = (long)i * G + c; if (L >= nwg) return false;
        int wgid = (int)L; { const int q = nwg / nx, r = nwg % nx, xcd = wgid % nx, off = wgid / nx; wgid = (xcd < r ? xcd * (q + 1) : r * (q + 1) + (xcd - r) * q) + off; }
        const int nig = WGM * nN, gid = wgid / nig, fm = gid * WGM, gsz = (nM - fm) < WGM ? (nM - fm) : WGM;
        u.pm = fm + ((wgid % nig) % gsz); u.pn = (wgid % nig) / gsz; return true;
    }
    __device__ __forceinline__ void a_ready(const Unit&) const {}
    __device__ __forceinline__ void done(const Unit&) const {}
};

__device__ __forceinline__ unsigned cvt_pk_bf16(float lo, float hi) { unsigned r; asm volatile("v_cvt_pk_bf16_f32 %0, %1, %2" : "=v"(r) : "v"(lo), "v"(hi)); return r; }
typedef float f32x2 __attribute__((ext_vector_type(2)));

__device__ __forceinline__ float silu_f(float g) { return g * __builtin_amdgcn_rcpf(1.0f + __builtin_amdgcn_exp2f(-1.4426950408889634f * g)); }
struct EpiSwiGLU {
    static constexpr bool PERM = true, AFTER_DRAIN = false;
    bf16_t* O; int ldc;
    __device__ __forceinline__ void operator()(const f32x4 (&acc)[2][2][4][2], const Unit& u, int wr, int wc, int fr, int fq) const {
        const int row0 = u.pm * BM + wr * 64 + fr, col0 = u.pn * HALF + wc * 32 + 8 * fq;
#pragma unroll
        for (int ai = 0; ai < 2; ++ai)
#pragma unroll
            for (int m = 0; m < 4; ++m) { bf16_t* rowp = O + (size_t)(row0 + ai * HALF + m * 16) * ldc + col0;
                const f32x4 g0 = acc[ai][0][m][0], g1 = acc[ai][0][m][1], u0 = acc[ai][1][m][0], u1 = acc[ai][1][m][1];
                u32x4 w; w.x = cvt_pk_bf16(silu_f(g0[0]) * u0[0], silu_f(g0[1]) * u0[1]); w.y = cvt_pk_bf16(silu_f(g0[2]) * u0[2], silu_f(g0[3]) * u0[3]);
                w.z = cvt_pk_bf16(silu_f(g1[0]) * u1[0], silu_f(g1[1]) * u1[1]); w.w = cvt_pk_bf16(silu_f(g1[2]) * u1[2], silu_f(g1[3]) * u1[3]);
                *(u32x4*)rowp = w; }
    }
};
struct EpiPlain {
    static constexpr bool PERM = true, AFTER_DRAIN = false;
    bf16_t* O; int ldc;
    __device__ __forceinline__ void operator()(const f32x4 (&acc)[2][2][4][2], const Unit& u, int wr, int wc, int fr, int fq) const {
        const int row0 = u.pm * BM + wr * 64 + fr, col0 = u.pn * BM + wc * 32 + 8 * fq;
#pragma unroll
        for (int ai = 0; ai < 2; ++ai)
#pragma unroll
            for (int m = 0; m < 4; ++m) { bf16_t* rowp = O + (size_t)(row0 + ai * HALF + m * 16) * ldc + col0;
#pragma unroll
                for (int bj = 0; bj < 2; ++bj) { const f32x4 v0 = acc[ai][bj][m][0], v1 = acc[ai][bj][m][1];
                    u32x4 w; w.x = cvt_pk_bf16(v0[0], v0[1]); w.y = cvt_pk_bf16(v0[2], v0[3]); w.z = cvt_pk_bf16(v1[0], v1[1]); w.w = cvt_pk_bf16(v1[2], v1[3]);
                    *(u32x4*)(rowp + bj * HALF) = w; } }
    }
};
struct EpiMix {
    static constexpr bool PERM = true, AFTER_DRAIN = false;
    bf16_t* O; int ldc; float* G; int npl;
    __device__ __forceinline__ void operator()(const f32x4 (&acc)[2][2][4][2], const Unit& u, int wr, int wc, int fr, int fq) const {
        const int row0 = u.pm * BM + wr * 64 + fr;
        if (u.pn < npl) {
            const int col0 = u.pn * BM + wc * 32 + 8 * fq;
#pragma unroll
            for (int ai = 0; ai < 2; ++ai)
#pragma unroll
                for (int m = 0; m < 4; ++m) { bf16_t* rowp = O + (size_t)(row0 + ai * HALF + m * 16) * ldc + col0;
#pragma unroll
                    for (int bj = 0; bj < 2; ++bj) { const f32x4 v0 = acc[ai][bj][m][0], v1 = acc[ai][bj][m][1];
                        u32x4 w; w.x = cvt_pk_bf16(v0[0], v0[1]); w.y = cvt_pk_bf16(v0[2], v0[3]); w.z = cvt_pk_bf16(v1[0], v1[1]); w.w = cvt_pk_bf16(v1[2], v1[3]);
                        *(u32x4*)(rowp + bj * HALF) = w; } }
        } else if (wc == 0 && fq < 2) {
#pragma unroll
            for (int ai = 0; ai < 2; ++ai)
#pragma unroll
                for (int m = 0; m < 4; ++m) { float* rowp = G + (size_t)(row0 + ai * HALF + m * 16) * 16 + 8 * fq;
                    *(f32x4*)rowp = acc[ai][0][m][0]; *(f32x4*)(rowp + 4) = acc[ai][0][m][1]; }
        }
    }
};
template <class Epi, class Sched, bool ALIGN_EPI = false, bool SP2 = false>
__device__ __forceinline__ void gemm_phase(PG8_LAS unsigned char* lds, const Gemm g, const Sched& S, const Epi& E) {
    int tid_ = threadIdx.x; asm volatile("" : "+v"(tid_));
    const int tid = tid_, wid = __builtin_amdgcn_readfirstlane(tid >> 6), lane = tid & 63, wr = wid >> 2, wc = wid & 3, fr = lane & 15, fq = lane >> 4;
    int K_ = g.K; asm volatile("" : "+s"(K_));
    const int K = K_, nt = K / BK;
    unsigned voffA[2], voffB[2];
#pragma unroll
    for (int i = 0; i < 2; ++i) { int R, C; stage_rc(tid * 16 + i * 8192, R, C); const int Rb = Epi::PERM ? ((R & ~31) + perm32(R & 31)) : R;
        voffA[i] = (unsigned)(R * K + C) * 2u; voffB[i] = (unsigned)(Rb * K + C) * 2u; }
    const size_t kstep = (size_t)(BK * 2);
    const size_t hstep = (size_t)HALF * K * 2;
    const size_t tstep = 2 * hstep;
    const unsigned ldsw = (unsigned)wid * 1024u;
    const int aoff = lds_byte(wr * 64 + fr, fq * 8), boff = lds_byte(wc * 32 + fr, fq * 8);
#define PG8_SA(b, h) (((b) * 2 + (h)) * HTB)
#define PG8_SB(b, h) ((4 + (b) * 2 + (h)) * HTB)
#define PG8_STAGE(bufoff, gbase, voff) do { _Pragma("unroll") for (int _i = 0; _i < 2; ++_i) \
        __builtin_amdgcn_global_load_lds((const unsigned*)((const char*)(gbase) + (voff)[_i]), (PG8_LAS unsigned*)(lds + (bufoff) + ldsw + _i * 8192), 16, 0, 0); } while (0)
#define PG8_LDA(dst, b, h) do { _Pragma("unroll") for (int m = 0; m < 4; ++m) _Pragma("unroll") for (int k = 0; k < 2; ++k) dst[m][k] = *(const PG8_LAS bf16x8*)(lds + PG8_SA(b, h) + aoff + m * 2048 + k * 1024); } while (0)
#define PG8_LDB(dst, b, h) do { _Pragma("unroll") for (int n = 0; n < 2; ++n) _Pragma("unroll") for (int k = 0; k < 2; ++k) dst[n][k] = *(const PG8_LAS bf16x8*)(lds + PG8_SB(b, h) + boff + n * 2048 + k * 1024); } while (0)
#define PG8_MMA(ai, bj, At, Bt) do { __builtin_amdgcn_s_setprio(1); _Pragma("unroll") for (int m = 0; m < 4; ++m) _Pragma("unroll") for (int n = 0; n < 2; ++n) _Pragma("unroll") for (int k = 0; k < 2; ++k) \
        acc[ai][bj][m][n] = __builtin_amdgcn_mfma_f32_16x16x32_bf16(Bt[n][k], At[m][k], acc[ai][bj][m][n], 0, 0, 0); __builtin_amdgcn_s_setprio(0); } while (0)
#define PG8_WAIT_V(n) asm volatile("s_waitcnt vmcnt(" #n ")" ::: "memory")
#define PG8_WAIT_L(n) asm volatile("s_waitcnt lgkmcnt(" #n ")" ::: "memory")
#define PG8_BAR __builtin_amdgcn_s_barrier()
#define PG8_SCHED __builtin_amdgcn_sched_barrier(0)
    Unit cur, nxt; int ui = 0;
    if (!S.next(0, cur)) return;
    f32x4 acc[2][2][4][2];
#pragma unroll
    for (int a = 0; a < 2; ++a)
#pragma unroll
        for (int b = 0; b < 2; ++b)
#pragma unroll
            for (int m = 0; m < 4; ++m)
#pragma unroll
                for (int n = 0; n < 2; ++n) acc[a][b][m][n] = (f32x4){0.f, 0.f, 0.f, 0.f};
    bf16x8 At[4][2], B0[2][2], B1[2][2];
    const char* cA = (const char*)g.A + (size_t)cur.pm * tstep; const char* cB = (const char*)g.Bt + (size_t)cur.pn * tstep;
    S.a_ready(cur);
    if constexpr (SP2) {
        PG8_STAGE(PG8_SB(0, 0), cB, voffB); PG8_STAGE(PG8_SB(0, 1), cB + hstep, voffB); PG8_STAGE(PG8_SA(0, 0), cA, voffA); PG8_STAGE(PG8_SA(0, 1), cA + hstep, voffA);
        if (wr == 1) PG8_BAR;
        PG8_WAIT_V(2); PG8_BAR;
        PG8_STAGE(PG8_SB(1, 0), cB + kstep, voffB); PG8_STAGE(PG8_SA(1, 0), cA + kstep, voffA); PG8_STAGE(PG8_SB(1, 1), cB + hstep + kstep, voffB);
        PG8_WAIT_V(6); PG8_BAR;
    } else {
        PG8_STAGE(PG8_SB(0, 0), cB, voffB); PG8_STAGE(PG8_SA(0, 0), cA, voffA); PG8_STAGE(PG8_SB(0, 1), cB + hstep, voffB); PG8_STAGE(PG8_SA(0, 1), cA + hstep, voffA);
        if (wr == 1) PG8_BAR;
        PG8_WAIT_V(4); PG8_BAR;
        PG8_STAGE(PG8_SB(1, 0), cB + kstep, voffB); PG8_STAGE(PG8_SA(1, 0), cA + kstep, voffA); PG8_STAGE(PG8_SB(1, 1), cB + hstep + kstep, voffB);
        PG8_WAIT_V(6); PG8_BAR;
    }
    for (;;) {
        const bool has_next = S.next(ui + 1, nxt);
        const char* nA = has_next ? (const char*)g.A + (size_t)nxt.pm * tstep : cA; const char* nB = has_next ? (const char*)g.Bt + (size_t)nxt.pn * tstep : cB;
        for (int t = 0; t < nt; t += 2) {
            const bool last = (t == nt - 2);
            const char* a1 = cA + (size_t)(t + 1) * kstep;
            const char* a2 = last ? nA : cA + (size_t)(t + 2) * kstep; const char* b2 = last ? nB : cB + (size_t)(t + 2) * kstep;
            const char* a3 = a2 + kstep; const char* b3 = b2 + kstep;
            if (last && has_next) S.a_ready(nxt);
            if constexpr (SP2) {
            PG8_LDB(B0, 0, 0); PG8_LDB(B1, 0, 1); PG8_SCHED; PG8_LDA(At, 0, 0); PG8_STAGE(PG8_SA(1, 1), a1 + hstep, voffA);
            PG8_WAIT_V(8); PG8_WAIT_L(0); PG8_BAR; PG8_MMA(0, 0, At, B0); PG8_MMA(0, 1, At, B1); PG8_BAR; PG8_SCHED;
            PG8_LDA(At, 0, 1); PG8_STAGE(PG8_SB(0, 0), b2, voffB); PG8_STAGE(PG8_SB(0, 1), b2 + hstep, voffB); PG8_STAGE(PG8_SA(0, 0), a2, voffA);
            PG8_WAIT_V(8); PG8_WAIT_L(0); PG8_BAR; PG8_MMA(1, 0, At, B0); PG8_MMA(1, 1, At, B1); PG8_BAR; PG8_SCHED;
            PG8_LDB(B0, 1, 0); PG8_LDB(B1, 1, 1); PG8_SCHED; PG8_LDA(At, 1, 0); PG8_STAGE(PG8_SA(0, 1), a2 + hstep, voffA);
            PG8_WAIT_V(8); PG8_WAIT_L(0); PG8_BAR; PG8_MMA(0, 0, At, B0); PG8_MMA(0, 1, At, B1); PG8_BAR; PG8_SCHED;
            PG8_LDA(At, 1, 1); PG8_STAGE(PG8_SB(1, 0), b3, voffB); PG8_STAGE(PG8_SB(1, 1), b3 + hstep, voffB); PG8_STAGE(PG8_SA(1, 0), a3, voffA);
            PG8_WAIT_V(8); PG8_WAIT_L(0); PG8_BAR; PG8_MMA(1, 0, At, B0); PG8_MMA(1, 1, At, B1); PG8_BAR; PG8_SCHED;
            } else {
            PG8_LDB(B0, 0, 0); PG8_SCHED; PG8_LDA(At, 0, 0); PG8_STAGE(PG8_SA(1, 1), a1 + hstep, voffA);
            PG8_WAIT_L(8); PG8_BAR; PG8_WAIT_L(0); PG8_MMA(0, 0, At, B0); PG8_BAR; PG8_SCHED;
            PG8_LDB(B1, 0, 1); PG8_STAGE(PG8_SB(0, 0), b2, voffB);
            PG8_BAR; PG8_WAIT_L(0); PG8_MMA(0, 1, At, B1); PG8_BAR;
            PG8_LDA(At, 0, 1); PG8_STAGE(PG8_SA(0, 0), a2, voffA);
            PG8_BAR; PG8_WAIT_L(0); PG8_MMA(1, 0, At, B0); PG8_BAR; PG8_SCHED;
            PG8_STAGE(PG8_SB(0, 1), b2 + hstep, voffB);
            PG8_WAIT_V(6); PG8_BAR; PG8_MMA(1, 1, At, B1); PG8_BAR;
            PG8_LDB(B0, 1, 0); PG8_SCHED; PG8_LDA(At, 1, 0); PG8_STAGE(PG8_SA(0, 1), a2 + hstep, voffA);
            PG8_WAIT_L(8); PG8_BAR; PG8_WAIT_L(0); PG8_MMA(0, 0, At, B0); PG8_BAR; PG8_SCHED;
            PG8_LDB(B1, 1, 1); PG8_STAGE(PG8_SB(1, 0), b3, voffB);
            PG8_BAR; PG8_WAIT_L(0); PG8_MMA(0, 1, At, B1); PG8_BAR;
            PG8_LDA(At, 1, 1); PG8_STAGE(PG8_SA(1, 0), a3, voffA);
            PG8_BAR; PG8_WAIT_L(0); PG8_MMA(1, 0, At, B0); PG8_BAR; PG8_SCHED;
            PG8_STAGE(PG8_SB(1, 1), b3 + hstep, voffB);
            PG8_WAIT_V(6); PG8_BAR; PG8_MMA(1, 1, At, B1); PG8_BAR;
            }
        }
        if constexpr (ALIGN_EPI) { if (wr == 0) PG8_BAR; }
        if constexpr (!Epi::AFTER_DRAIN) { E(acc, cur, wr, wc, fr, fq); S.done(cur); }
        if (!has_next) break;
#pragma unroll
        for (int a = 0; a < 2; ++a)
#pragma unroll
            for (int b = 0; b < 2; ++b)
#pragma unroll
                for (int m = 0; m < 4; ++m)
#pragma unroll
                    for (int n = 0; n < 2; ++n) acc[a][b][m][n] = (f32x4){0.f, 0.f, 0.f, 0.f};
        cur = nxt; cA = nA; cB = nB; ++ui;
        if constexpr (ALIGN_EPI) { if (wr == 1) PG8_BAR; }
    }
    PG8_WAIT_V(0);
    if constexpr (!ALIGN_EPI) { if (wr == 0) PG8_BAR; }
    PG8_BAR;
    if constexpr (Epi::AFTER_DRAIN) { E.fused(acc, cur, wr, wc, fr, fq, lds, wid, lane); S.done(cur); }
#undef PG8_SA
#undef PG8_SB
#undef PG8_STAGE
#undef PG8_LDA
#undef PG8_LDB
#undef PG8_MMA
#undef PG8_WAIT_V
#undef PG8_WAIT_L
#undef PG8_BAR
#undef PG8_SCHED
}
}

constexpr int NWAVES = 8;
constexpr int BATCH = 2, SEQ = 8192, M = BATCH * SEQ, D = 2048, DEPTH = 4;
constexpr int DFF = 5504, NFF = 2 * DFF;
constexpr int NMIX = 4624, NMIXP = 4864, MIXLD = 4608;
constexpr int C_QA = 0, C_KA = 1024, C_VA = 1280, C_QG = 1536, C_KG = 2048, C_VG = 2560, C_RG = 3584;
constexpr float NORM_EPS = 1e-6f;

constexpr size_t MiB = 1u << 20;
constexpr size_t WS_CTL = 0, CTL_ZERO_BYTES = 1 * MiB;
constexpr size_t SZ_WFI = (size_t)8 * NFF * D * 2, SZ_WFO = (size_t)8 * D * DFF * 2, SZ_WMI = (size_t)4 * NMIXP * D * 2, SZ_WMO = (size_t)4 * D * D * 2;
constexpr size_t WS_WFI = 2 * MiB;
constexpr size_t WS_WFO = WS_WFI + SZ_WFI;
constexpr size_t WS_WMI = WS_WFO + SZ_WFO;
constexpr size_t WS_WMO = WS_WMI + SZ_WMI;
constexpr size_t WS_XN  = WS_WMO + SZ_WMO;
constexpr size_t WS_ACT = WS_XN + (size_t)M * D * 2;
constexpr size_t WS_H   = WS_ACT + (size_t)M * DFF * 2;
constexpr size_t WS_MIX = WS_H + (size_t)M * D * 2;
constexpr size_t WS_GLR = WS_MIX + (size_t)M * MIXLD * 2;
constexpr size_t WS_LOGA = WS_GLR + (size_t)M * 16 * 4;
constexpr size_t WS_ROPE = WS_LOGA + (size_t)M * 512 * 4;
constexpr size_t WS_MO  = WS_ROPE + (size_t)M * 64 * 4;
constexpr size_t WS_OG  = WS_MO + (size_t)M * D * 2;
constexpr size_t WS_BC  = WS_OG + (size_t)M * D * 4;
constexpr size_t WS_DEC = WS_BC + (size_t)M * 512 * 4;
constexpr size_t WS_DS  = WS_DEC + (size_t)1024 * 128 * 4;
constexpr size_t WS_ST  = WS_DS + (size_t)1024 * 32768 * 4;
constexpr size_t WS_END = WS_ST + (size_t)1024 * 32768 * 2;
static_assert(WS_WFI % 256 == 0 && WS_WFO % 256 == 0 && WS_WMI % 256 == 0 && WS_WMO % 256 == 0 && WS_XN % 256 == 0 && WS_ACT % 256 == 0 && WS_H % 256 == 0 && WS_MIX % 256 == 0 && WS_GLR % 256 == 0 && WS_LOGA % 256 == 0 && WS_ROPE % 256 == 0 && WS_MO % 256 == 0 && WS_OG % 256 == 0 && WS_BC % 256 == 0 && WS_DEC % 256 == 0 && WS_DS % 256 == 0 && WS_ST % 256 == 0, "alignment");
constexpr int CW_BAR = 4096;
constexpr int CW_WFLAG = 16384;

constexpr int RING_OFF = 0, RING_BYTES = 131072;
constexpr int LDSCTL_OFF = RING_BYTES, MISC_OFF = LDSCTL_OFF + 320;
constexpr int LDS_BYTES = 147456;
static_assert(MISC_OFF + 128 <= LDS_BYTES, "LDS map");
constexpr int G_KT = 0;
constexpr int G3_B = 0;
constexpr int G_VT = 32768;
constexpr int G_SEG = 69632;
constexpr int G3_QD = 71680;
constexpr int G3_KD = 89088;
constexpr int G3_IN = 106496;
constexpr int G3_SS = 115712;
static_assert(G_KT + 128 * 144 <= G_VT && G3_B + 32768 <= G_VT && G_VT + 256 * 144 <= G_SEG && G_SEG + 2048 <= G3_QD && G3_QD + 64 * 272 <= G3_KD && G3_KD + 64 * 272 <= G3_IN && G3_IN + 64 * 144 <= G3_SS && G3_SS + 2048 <= RING_BYTES, "GLA LDS map");
constexpr int A_KS = 0;
constexpr int A_VT = 36864;
static_assert(A_VT + 64 * 528 <= RING_BYTES, "attention LDS map");
#define GAS __attribute__((address_space(1)))
#define LAS __attribute__((address_space(3)))
typedef unsigned short bf16;
typedef unsigned v4u __attribute__((ext_vector_type(4)));
typedef float f32x4 __attribute__((ext_vector_type(4)));
typedef short bf16x8 __attribute__((ext_vector_type(8)));
typedef GAS unsigned gu32;
typedef GAS unsigned long long gu64;
#define RLX_AGENT __ATOMIC_RELAXED, __HIP_MEMORY_SCOPE_AGENT
#define LDS_WAIT() asm volatile("s_waitcnt lgkmcnt(0)" ::: "memory")
#define VM_WAIT() asm volatile("s_waitcnt vmcnt(0)" ::: "memory")
__device__ __forceinline__ unsigned long long rt() { return __builtin_amdgcn_s_memrealtime(); }
__device__ __forceinline__ unsigned f2bf(float f) { unsigned u = __builtin_bit_cast(unsigned, f); return (u + 0x7fffu + ((u >> 16) & 1u)) >> 16; }
__device__ __forceinline__ unsigned pk2(float lo, float hi) { return f2bf(lo) | (f2bf(hi) << 16); }
#define XB_TMO      128
#define XB_XCNT(j)  (256  + 64 * (j))
#define XB_XSUB(j)  (1280 + 64 * (j))
#define XB_XGEN(j)  (2304 + 64 * (j))
#define XB_TOP      3328
#define XB_TOPGEN   3392
#define XCD_BAR_WORDS 3456
#define XB_SPIN_CAP (1u << 18)

__device__ __forceinline__ unsigned xb_ld(unsigned* p)              { return __hip_atomic_load(p, __ATOMIC_RELAXED, __HIP_MEMORY_SCOPE_AGENT); }
__device__ __forceinline__ unsigned xb_add(unsigned* p, unsigned v) { return __hip_atomic_fetch_add(p, v, __ATOMIC_RELAXED, __HIP_MEMORY_SCOPE_AGENT); }
__device__ __forceinline__ unsigned xb_xcc_id() { return (unsigned)__builtin_amdgcn_s_getreg((3 << 11) | 20) & 0xFu; }
#define XB_SPIN(cond, bar) do { unsigned _sp = 0; while (cond) { __builtin_amdgcn_s_sleep(1); \
    if ((++_sp & 255u) == 0u) { if (xb_ld(&(bar)[XB_TMO])) break; if (_sp > XB_SPIN_CAP) { atomicAdd(&(bar)[XB_TMO], 1u); break; } } } } while (0)

struct XcdBarrier {
    unsigned* bar; unsigned x; unsigned ng;
    volatile LAS unsigned* st;
};

__device__ __forceinline__ XcdBarrier xcd_barrier_post(unsigned* bar, volatile LAS unsigned* st, unsigned ng) {
    XcdBarrier b; b.bar = bar; b.x = xb_xcc_id(); b.st = st; b.ng = ng;
    if (threadIdx.x == 0) (void)xb_add(&bar[XB_XCNT(b.x)], 1u);
    return b;
}
__device__ __forceinline__ void xcd_barrier_complete(unsigned* bar, unsigned x, unsigned G, unsigned& nloc, unsigned& nx) {
    unsigned sum, cnt, mine, sp = 0u;
    for (;;) {
        sum = 0u; cnt = 0u; mine = 0u;
#pragma unroll
        for (unsigned j = 0; j < 16; ++j) { const unsigned c = xb_ld(&bar[XB_XCNT(j)]); sum += c; cnt += (c > 0u) ? 1u : 0u; mine = (j == x) ? c : mine; }
        if (sum == G) break;
        __builtin_amdgcn_s_sleep(1);
        if ((++sp & 255u) == 0u) { if (xb_ld(&bar[XB_TMO])) break; if (sp > XB_SPIN_CAP) { atomicAdd(&bar[XB_TMO], 1u); break; } }
    }
    nloc = mine > 0u ? mine : 1u; nx = cnt > 0u ? cnt : 1u;
}

__device__ __forceinline__ void xcd_barrier(const XcdBarrier& b) {
    asm volatile("s_waitcnt vmcnt(0)" ::: "memory");
    __syncthreads();
    if (threadIdx.x == 0) {
        unsigned* bar = b.bar;
        __builtin_amdgcn_s_waitcnt(0);
        unsigned nloc = b.st[0], nx = b.st[1];
        if (nloc == 0u) { xcd_barrier_complete(bar, b.x, b.ng, nloc, nx); b.st[0] = nloc; b.st[1] = nx; }
        const unsigned old = xb_add(&bar[XB_XSUB(b.x)], 1u);
        const unsigned gen = old / nloc;
        if (old + 1u == (gen + 1u) * nloc) {
            __builtin_amdgcn_fence(__ATOMIC_RELEASE, "agent");
            asm volatile("s_waitcnt vmcnt(0)" ::: "memory");
            const unsigned og = xb_add(&bar[XB_TOP], 1u);
            const unsigned tg = og / nx;
            if (og + 1u == (tg + 1u) * nx) xb_add(&bar[XB_TOPGEN], 1u);
            else XB_SPIN(xb_ld(&bar[XB_TOPGEN]) == tg, bar);
            __builtin_amdgcn_fence(__ATOMIC_ACQUIRE, "agent");
            xb_add(&bar[XB_XGEN(b.x)], 1u);
            asm volatile("s_waitcnt vmcnt(0)" ::: "memory");
        } else {
            XB_SPIN(xb_ld(&bar[XB_XGEN(b.x)]) == gen, bar);
            __builtin_amdgcn_fence(__ATOMIC_ACQUIRE, "agent");
            asm volatile("s_waitcnt vmcnt(0)" ::: "memory");
        }
    }
    __syncthreads();
}

typedef unsigned v2u __attribute__((ext_vector_type(2)));
typedef float v2f __attribute__((ext_vector_type(2)));
struct Frame {
    LAS unsigned char* lds;
    volatile LAS unsigned* MISC;
    gu32* ctl;
    int tid, lane, wave;
    int vcu, G;
    int wcu, WG, row0, nrows, gc, nxl;
    const float* x; const int* pos; const float* gains; const float* w_fi; const float* w_fo; const float* w_mi; const float* sinks; const float* gate_w2; const float* gate_b; const float* gla_gain; const float* w_mo;
    float* out;
    bf16 *WFI, *WFO, *WMI, *WMO, *XN, *ACT, *H, *MIX, *MO;
    float *GLR, *LOGA, *ROPE, *OG, *BC, *DEC, *DS, *XB; bf16* ST;
};
#define RELAUNDER(F) do { int t_ = threadIdx.x; asm volatile("" : "+v"(t_)); (F).tid = t_; (F).lane = t_ & 63; (F).wave = __builtin_amdgcn_readfirstlane(t_ >> 6); \
    const __attribute__((address_space(4))) char* kb_ = (const __attribute__((address_space(4))) char*)__builtin_amdgcn_kernarg_segment_ptr(); asm volatile("" : "+s"(kb_)); \
    GAS void* const __attribute__((address_space(4)))* ka_ = (GAS void* const __attribute__((address_space(4)))*)kb_;     \
    (F).x = (const float*)ka_[0]; (F).pos = (const int*)ka_[1]; (F).gains = (const float*)ka_[2]; (F).w_fi = (const float*)ka_[3]; (F).w_fo = (const float*)ka_[4]; (F).w_mi = (const float*)ka_[5]; \
    (F).sinks = (const float*)ka_[6]; (F).gate_w2 = (const float*)ka_[7]; (F).gate_b = (const float*)ka_[8]; (F).gla_gain = (const float*)ka_[9]; (F).w_mo = (const float*)ka_[10]; (F).out = (float*)ka_[11]; \
    unsigned char* ws_ = (unsigned char*)ka_[12]; \
    (F).WFI = (bf16*)(ws_ + WS_WFI); (F).WFO = (bf16*)(ws_ + WS_WFO); (F).WMI = (bf16*)(ws_ + WS_WMI); (F).WMO = (bf16*)(ws_ + WS_WMO); \
    (F).XN = (bf16*)(ws_ + WS_XN); (F).ACT = (bf16*)(ws_ + WS_ACT); (F).H = (bf16*)(ws_ + WS_H); (F).MIX = (bf16*)(ws_ + WS_MIX); (F).MO = (bf16*)(ws_ + WS_MO); \
    (F).GLR = (float*)(ws_ + WS_GLR); (F).LOGA = (float*)(ws_ + WS_LOGA); (F).ROPE = (float*)(ws_ + WS_ROPE); (F).OG = (float*)(ws_ + WS_OG); (F).XB = (float*)(ws_ + WS_OG);     (F).BC = (float*)(ws_ + WS_BC); (F).DEC = (float*)(ws_ + WS_DEC); (F).DS = (float*)(ws_ + WS_DS); (F).ST = (bf16*)(ws_ + WS_ST); } while (0)
__device__ __forceinline__ float wave_sum(float v) {
#pragma unroll
    for (int o = 1; o < 64; o <<= 1) v += __shfl_xor(v, o);
    return v;
}
__device__ __forceinline__ float wave_max(float v) {
#pragma unroll
    for (int o = 1; o < 64; o <<= 1) v = fmaxf(v, __shfl_xor(v, o));
    return v;
}
__device__ __forceinline__ float bf_lo(unsigned w) { return __builtin_bit_cast(float, w << 16); }
__device__ __forceinline__ float bf_hi(unsigned w) { return __builtin_bit_cast(float, w & 0xffff0000u); }
__device__ __forceinline__ float bf1(bf16 h) { return __builtin_bit_cast(float, ((unsigned)h) << 16); }

template <bool FIRST>
__device__ __forceinline__ void norm_phase(Frame& F, int k, int ia, int ib, float cres, bool write_xn) {
    RELAUNDER(F);
    const float* xsrc = (FIRST || k == 0) ? F.x : ((k & 1) ? F.XB : F.out); float* xdst = (k & 1) ? F.out : F.XB;
    const float* ga = F.gains + (size_t)ia * D + 4 * F.lane; const float* gb = F.gains + (size_t)ib * D + 4 * F.lane;
    const int gw = F.wcu * NWAVES + F.wave, NGW = F.WG * NWAVES;
    f32x4 GA[8], GB[8];
#pragma unroll
    for (int j = 0; j < 8; ++j) {
        GA[j] = FIRST ? (f32x4){0.f, 0.f, 0.f, 0.f} : *(const f32x4*)(ga + 256 * j);
        GB[j] = write_xn ? *(const f32x4*)(gb + 256 * j) : (f32x4){0.f, 0.f, 0.f, 0.f}; }
    for (int mm = gw; mm < F.nrows; mm += NGW) {
        const int m = F.row0 + mm;
        const float* xr = xsrc + (size_t)m * D + 4 * F.lane;
        f32x4 xv[8];
#pragma unroll
        for (int j = 0; j < 8; ++j) xv[j] = *(const f32x4*)(xr + 256 * j);
        if (!FIRST) {
            const bf16* hr = F.H + (size_t)m * D + 4 * F.lane;
            v2u hv[8];
#pragma unroll
            for (int j = 0; j < 8; ++j) hv[j] = *(const v2u*)(hr + 256 * j);
            f32x4 hf[8]; float ss = 0.f;
#pragma unroll
            for (int j = 0; j < 8; ++j) { hf[j] = (f32x4){bf_lo(hv[j].x), bf_hi(hv[j].x), bf_lo(hv[j].y), bf_hi(hv[j].y)};
                ss += (hf[j].x * hf[j].x + hf[j].y * hf[j].y) + (hf[j].z * hf[j].z + hf[j].w * hf[j].w); }
            const float rs = 1.0f / sqrtf(wave_sum(ss) * (1.0f / D) + NORM_EPS);
            float* xw = xdst + (size_t)m * D + 4 * F.lane;
#pragma unroll
            for (int j = 0; j < 8; ++j) { xv[j] = xv[j] + cres * ((hf[j] * rs) * GA[j]); *(f32x4*)(xw + 256 * j) = xv[j]; }
        }
        if (write_xn) {
            float s2 = 0.f;
#pragma unroll
            for (int j = 0; j < 8; ++j) s2 += (xv[j].x * xv[j].x + xv[j].y * xv[j].y) + (xv[j].z * xv[j].z + xv[j].w * xv[j].w);
            const float r2 = 1.0f / sqrtf(wave_sum(s2) * (1.0f / D) + NORM_EPS);
            bf16* xo = F.XN + (size_t)m * D + 4 * F.lane;
#pragma unroll
            for (int j = 0; j < 8; ++j) { const f32x4 a = (xv[j] * r2) * GB[j];
                v2u o; o.x = pg8::cvt_pk_bf16(a.x, a.y); o.y = pg8::cvt_pk_bf16(a.z, a.w);
                *(v2u*)(xo + 256 * j) = o; }
        }
    }
}
struct CvtItem { const float* W; bf16* WT; int K, N, nt, kt, mode; };
__device__ __forceinline__ CvtItem cvt_decode(Frame& F, int it, int l0, int nl) {
    constexpr int PER_FI = (NFF / 64) * (D / 64), PER_FO = (D / 64) * (DFF / 64), PER_MI = (NMIXP / 64) * (D / 64), PER_MO = (D / 64) * (D / 64);
    const int IT_FI = 2 * nl * PER_FI, IT_FO = 2 * nl * PER_FO, IT_MI = nl * PER_MI;
    CvtItem c; int r = it;
    if (r < IT_FI) { const int mat = 2 * l0 + r / PER_FI, q = r % PER_FI; c.W = F.w_fi + (size_t)mat * D * NFF; c.WT = F.WFI + (size_t)mat * NFF * D; c.K = D; c.N = NFF; c.kt = q / (NFF / 64); c.nt = q % (NFF / 64); c.mode = 1; return c; } r -= IT_FI;
    if (r < IT_FO) { const int mat = 2 * l0 + r / PER_FO, q = r % PER_FO; c.W = F.w_fo + (size_t)mat * DFF * D; c.WT = F.WFO + (size_t)mat * D * DFF; c.K = DFF; c.N = D; c.kt = q / (D / 64); c.nt = q % (D / 64); c.mode = 0; return c; } r -= IT_FO;
    if (r < IT_MI) { const int mat = l0 + r / PER_MI, q = r % PER_MI; c.W = F.w_mi + (size_t)mat * D * NMIX; c.WT = F.WMI + (size_t)mat * NMIXP * D; c.K = D; c.N = NMIX; c.kt = q / (NMIXP / 64); c.nt = q % (NMIXP / 64); c.mode = 2; return c; } r -= IT_MI;
    { const int mat = l0 + r / PER_MO, q = r % PER_MO; c.W = F.w_mo + (size_t)mat * D * D; c.WT = F.WMO + (size_t)mat * D * D; c.K = D; c.N = D; c.kt = q / (D / 64); c.nt = q % (D / 64); c.mode = 0; return c; }
}
__device__ __forceinline__ void cvt_load(const CvtItem& c, int lane, f32x4 (&v)[16]) {
    const int a = lane & 15, kr = lane >> 4, nd = c.nt * 64 + 4 * a;
    int src = nd; bool valid = true;
    if (c.mode == 1) { const int w = nd & 255; src = ((w >> 7) ? DFF : 0) + (nd >> 8) * 128 + (w & 127); }
    if (c.mode == 2) valid = nd < NMIX;
    const float* wp = c.W + (size_t)(c.kt * 64 + 2 * kr) * c.N + src;
#pragma unroll
    for (int i = 0; i < 16; ++i) v[i] = valid ? *(const f32x4*)(wp + (size_t)(8 * (i >> 1) + (i & 1)) * c.N) : (f32x4){0.f, 0.f, 0.f, 0.f};
}
__device__ __forceinline__ void cvt_store(const CvtItem& c, int lane, const f32x4 (&v)[16], LAS unsigned char* T) {
    const int a = lane & 15, kr = lane >> 4;
#pragma unroll
    for (int p = 0; p < 8; ++p)
#pragma unroll
        for (int j = 0; j < 4; ++j) *(LAS unsigned*)(T + (4 * a + j) * 132 + 4 * (4 * p + kr)) = pg8::cvt_pk_bf16(v[2 * p][j], v[2 * p + 1][j]);
    const int nn = lane >> 3, ch = lane & 7;
    bf16* op = c.WT + (size_t)(c.nt * 64 + nn) * c.K + c.kt * 64 + 8 * ch;
#pragma unroll
    for (int r = 0; r < 8; ++r) { const LAS unsigned* tp = (const LAS unsigned*)(T + (nn + 8 * r) * 132 + 16 * ch);
        const v4u o = {tp[0], tp[1], tp[2], tp[3]};
        *(v4u*)(op + (size_t)(8 * r) * c.K) = o; }
}
__device__ __forceinline__ void p0_convert(Frame& F, int l0, int l1) {
    RELAUNDER(F);
    const int gw = F.wcu * NWAVES + F.wave, NGW = F.WG * NWAVES, nl = l1 - l0;
    const int total = nl * (2 * (NFF / 64) * (D / 64) + 2 * (D / 64) * (DFF / 64) + (NMIXP / 64) * (D / 64) + (D / 64) * (D / 64));
    LAS unsigned char* T = F.lds + RING_OFF + F.wave * 8448;
    f32x4 va[16], vb[16];
    int it = gw;
    if (it < total) { const CvtItem c = cvt_decode(F, it, l0, nl); cvt_load(c, F.lane, va); }
    while (it < total) {
        { const int nx = it + NGW; if (nx < total) { const CvtItem cn = cvt_decode(F, nx, l0, nl); cvt_load(cn, F.lane, vb); }
          const CvtItem c = cvt_decode(F, it, l0, nl); cvt_store(c, F.lane, va, T); it = nx; }
        if (it >= total) break;
        { const int nx = it + NGW; if (nx < total) { const CvtItem cn = cvt_decode(F, nx, l0, nl); cvt_load(cn, F.lane, va); }
          const CvtItem c = cvt_decode(F, it, l0, nl); cvt_store(c, F.lane, vb, T); it = nx; }
    }
}
__device__ __forceinline__ void p0_rope(Frame& F) {
    RELAUNDER(F);
    for (int e = (F.wcu * NWAVES + F.wave) * 64 + F.lane; e < F.nrows * 32; e += F.WG * NWAVES * 64) {
        const int m = F.row0 + (e >> 5), i = e & 31;
        double pw = 1.0; for (int k = 0; k < i; ++k) pw *= 0.7498942093324559;
        const float a = (float)F.pos[m] * (float)pw;
        const double ad = (double)a, k = rint(ad * 0.15915494309189535), r = fma(-k, 6.283185307179586, ad);
        const float rf = (float)r;
        F.ROPE[(size_t)m * 64 + i] = cosf(rf); F.ROPE[(size_t)m * 64 + 32 + i] = sinf(rf);
    }
}

__device__ __forceinline__ pg8::f32x4 mma16(bf16x8 x, bf16x8 y, pg8::f32x4 c) { return __builtin_amdgcn_mfma_f32_16x16x32_bf16(x, y, c, 0, 0, 0); }

__device__ __forceinline__ void gla_cumsum(Frame& F, LAS unsigned char* L, int l, size_t m0, int h, float (&bb)[16], float& off, float& tot) {
    const int dk = F.tid & 127, tq = F.wave >> 1;
    const float* w2 = F.gate_w2 + (size_t)l * 16 * 512 + h * 128 + dk;
    float wv[16];
#pragma unroll
    for (int r = 0; r < 16; ++r) wv[r] = w2[r * 512];
    const float bias = F.gate_b[(size_t)l * 512 + h * 128 + dk];
    const float* gr = F.GLR + (m0 + tq * 16) * 16;
    float run = 0.f;
#pragma unroll
    for (int i = 0; i < 16; ++i) {
        float z = bias;
#pragma unroll
        for (int r = 0; r < 16; ++r) z += gr[i * 16 + r] * wv[r];
        const float ls = fminf(z, 0.f) - __logf(1.0f + __expf(-fabsf(z)));
        run += ls * 0.0625f; bb[i] = run; }
    LAS float* seg = (LAS float*)(L + G_SEG);
    seg[tq * 128 + dk] = bb[15];
    __syncthreads();
    off = 0.f; tot = 0.f;
#pragma unroll
    for (int q = 0; q < 4; ++q) { const float sg = seg[q * 128 + dk]; tot += sg; if (q < tq) off += sg; }
}
__device__ __forceinline__ void gla_stage_vt(Frame& F, LAS unsigned char* L, size_t m0, int h) {
    const int dv = F.tid & 255, th = F.tid >> 8; const bf16* vp = F.MIX + (m0 + th * 32) * MIXLD + C_VG + h * 256 + dv;
    unsigned pk[16];
#pragma unroll
    for (int i = 0; i < 16; ++i) pk[i] = (unsigned)vp[(size_t)(2 * i) * MIXLD] | ((unsigned)vp[(size_t)(2 * i + 1) * MIXLD] << 16);
    LAS v4u* dst = (LAS v4u*)(L + G_VT + dv * 144 + th * 64);
#pragma unroll
    for (int j = 0; j < 4; ++j) dst[j] = (v4u){pk[4 * j], pk[4 * j + 1], pk[4 * j + 2], pk[4 * j + 3]};
}
__device__ __forceinline__ void gla_g1(Frame& F, int l) {
    RELAUNDER(F);
    LAS unsigned char* L = F.lds + RING_OFF;
    const int r16 = F.lane & 15, q4 = F.lane >> 4, w = F.wave;
    for (int uu = F.wcu; uu < (F.nrows >> 6) * 4; uu += F.WG) {
        const int u = (F.row0 >> 6) * 4 + uu;
        const int c = u >> 2, h = u & 3; const size_t m0 = (size_t)c * 64;
        const int dk = F.tid & 127, tq = F.wave >> 1;
        gla_stage_vt(F, L, m0, h);
        float bb[16], off, tot;
        gla_cumsum(F, L, l, m0, h, bb, off, tot);
        { const bf16* kp = F.MIX + (m0 + tq * 16) * MIXLD + C_KG + h * 128 + dk;
          unsigned pk[8];
#pragma unroll
          for (int i = 0; i < 8; ++i) { const float b0 = bb[2 * i] + off, b1 = bb[2 * i + 1] + off;
              pk[i] = pg8::cvt_pk_bf16(bf1(kp[(size_t)(2 * i) * MIXLD]) * __expf(tot - b0), bf1(kp[(size_t)(2 * i + 1) * MIXLD]) * __expf(tot - b1)); }
          LAS v4u* dst = (LAS v4u*)(L + G_KT + dk * 144 + tq * 32);
          dst[0] = (v4u){pk[0], pk[1], pk[2], pk[3]}; dst[1] = (v4u){pk[4], pk[5], pk[6], pk[7]}; }
        if (tq == 0) F.DEC[(size_t)u * 128 + dk] = __expf(tot);
        __syncthreads();
        bf16x8 av[2][2];
#pragma unroll
        for (int rb = 0; rb < 2; ++rb)
#pragma unroll
            for (int ks = 0; ks < 2; ++ks) av[rb][ks] = *(const LAS bf16x8*)(L + G_VT + (32 * w + 16 * rb + r16) * 144 + (32 * ks + 8 * q4) * 2);
        float* dsb = F.DS + (size_t)u * 32768;
#pragma unroll
        for (int cb = 0; cb < 8; ++cb) {
            bf16x8 kv[2];
#pragma unroll
            for (int ks = 0; ks < 2; ++ks) kv[ks] = *(const LAS bf16x8*)(L + G_KT + (16 * cb + r16) * 144 + (32 * ks + 8 * q4) * 2);
#pragma unroll
            for (int rb = 0; rb < 2; ++rb) { pg8::f32x4 acc = {0.f, 0.f, 0.f, 0.f};
#pragma unroll
                for (int ks = 0; ks < 2; ++ks) acc = mma16(kv[ks], av[rb][ks], acc);
                *(pg8::f32x4*)(dsb + (size_t)(32 * w + 16 * rb + r16) * 128 + 16 * cb + 4 * q4) = acc; }
        }
        __syncthreads();
    }
}
__device__ __forceinline__ void gla_scan(Frame& F) {
    RELAUNDER(F);
    for (int g0 = (F.wcu * NWAVES + F.wave) * 64 + F.lane; g0 < (F.nrows / SEQ) * 65536; g0 += F.WG * NWAVES * 64) {
        const int g = (F.row0 / SEQ) * 65536 + g0;
        const int dk2 = g & 63, dv = (g >> 6) & 255, h = (g >> 14) & 3, b = g >> 16;
        const size_t base = (((size_t)b * 128 * 4 + h) * 256 + dv) * 128 + 2 * dk2, nstr = (size_t)4 * 32768;
        const size_t dbase = ((size_t)b * 128 * 4 + h) * 128 + 2 * dk2, dstr = 4 * 128;
        float s0 = 0.f, s1 = 0.f;
#pragma unroll 1
        for (int n = 0; n < 128; n += 8) {
            v2f d[8], dc[8];
#pragma unroll
            for (int i = 0; i < 8; ++i) { d[i] = *(const v2f*)(F.DS + base + (size_t)(n + i) * nstr); dc[i] = *(const v2f*)(F.DEC + dbase + (size_t)(n + i) * dstr); }
#pragma unroll
            for (int i = 0; i < 8; ++i) { *(unsigned*)(F.ST + base + (size_t)(n + i) * nstr) = pg8::cvt_pk_bf16(s0, s1);
                s0 = dc[i].x * s0 + d[i].x; s1 = dc[i].y * s1 + d[i].y; }
        }
    }
}
__device__ __forceinline__ void gla_g3(Frame& F, int l) {
    RELAUNDER(F);
    LAS unsigned char* L = F.lds + RING_OFF;
    const int r16 = F.lane & 15, q4 = F.lane >> 4, w = F.wave;
    for (int uu = F.wcu; uu < (F.nrows >> 6) * 4; uu += F.WG) {
        const int u = (F.row0 >> 6) * 4 + uu;
        const int c = u >> 2, h = u & 3; const size_t m0 = (size_t)c * 64;
        const bf16* stb = F.ST + (size_t)u * 32768;
        bf16x8 sf[2][4];
#pragma unroll
        for (int rb = 0; rb < 2; ++rb)
#pragma unroll
            for (int ks = 0; ks < 4; ++ks) sf[rb][ks] = *(const bf16x8*)(stb + (size_t)(32 * w + 16 * rb + r16) * 128 + 32 * ks + 8 * q4);
        gla_stage_vt(F, L, m0, h);
        { float bb[16], off, tot;
          gla_cumsum(F, L, l, m0, h, bb, off, tot);
          const int dk = F.tid & 127, tq = F.wave >> 1; (void)tot;
          LAS float* B = (LAS float*)(L + G3_B);
#pragma unroll
          for (int i = 0; i < 16; ++i) B[(tq * 16 + i) * 128 + dk] = bb[i] + off; }
        __syncthreads();
        { const int t = F.tid >> 3, d0 = (F.tid & 7) * 16; const size_t m = m0 + t;
          const LAS float* bp = (const LAS float*)(L + G3_B) + t * 128 + d0;
          const v4u q0 = *(const v4u*)(F.MIX + m * MIXLD + C_QG + h * 128 + d0), q1 = *(const v4u*)(F.MIX + m * MIXLD + C_QG + h * 128 + d0 + 8);
          const v4u k0 = *(const v4u*)(F.MIX + m * MIXLD + C_KG + h * 128 + d0), k1 = *(const v4u*)(F.MIX + m * MIXLD + C_KG + h * 128 + d0 + 8);
          const unsigned qw[8] = {q0.x, q0.y, q0.z, q0.w, q1.x, q1.y, q1.z, q1.w}, kw[8] = {k0.x, k0.y, k0.z, k0.w, k1.x, k1.y, k1.z, k1.w};
          unsigned qo[8], ko[8];
#pragma unroll
          for (int j = 0; j < 4; ++j) { const f32x4 bv = *(const LAS f32x4*)(bp + 4 * j);
              const float e0 = __expf(bv.x), e1 = __expf(bv.y), e2 = __expf(bv.z), e3 = __expf(bv.w), n0 = __expf(-bv.x), n1 = __expf(-bv.y), n2 = __expf(-bv.z), n3 = __expf(-bv.w);
              qo[2 * j] = pg8::cvt_pk_bf16(bf_lo(qw[2 * j]) * 0.08838834764831845f * e0, bf_hi(qw[2 * j]) * 0.08838834764831845f * e1);
              qo[2 * j + 1] = pg8::cvt_pk_bf16(bf_lo(qw[2 * j + 1]) * 0.08838834764831845f * e2, bf_hi(qw[2 * j + 1]) * 0.08838834764831845f * e3);
              ko[2 * j] = pg8::cvt_pk_bf16(bf_lo(kw[2 * j]) * n0, bf_hi(kw[2 * j]) * n1);
              ko[2 * j + 1] = pg8::cvt_pk_bf16(bf_lo(kw[2 * j + 1]) * n2, bf_hi(kw[2 * j + 1]) * n3); }
          LAS v4u* qd = (LAS v4u*)(L + G3_QD + t * 272 + d0 * 2); LAS v4u* kd = (LAS v4u*)(L + G3_KD + t * 272 + d0 * 2);
          qd[0] = (v4u){qo[0], qo[1], qo[2], qo[3]}; qd[1] = (v4u){qo[4], qo[5], qo[6], qo[7]};
          kd[0] = (v4u){ko[0], ko[1], ko[2], ko[3]}; kd[1] = (v4u){ko[4], ko[5], ko[6], ko[7]}; }
        __syncthreads();
#pragma unroll
        for (int j = 0; j < 2; ++j) {
            const int id = 2 * w + j, tr = id >> 2, sc = id & 3;
            pg8::f32x4 acc = {0.f, 0.f, 0.f, 0.f};
            if (sc <= tr) {
#pragma unroll
                for (int ks = 0; ks < 4; ++ks) acc = mma16(*(const LAS bf16x8*)(L + G3_KD + (16 * sc + r16) * 272 + (32 * ks + 8 * q4) * 2),
                                                           *(const LAS bf16x8*)(L + G3_QD + (16 * tr + r16) * 272 + (32 * ks + 8 * q4) * 2), acc);
                const int t = 16 * tr + r16, s0 = 16 * sc + 4 * q4;
#pragma unroll
                for (int i = 0; i < 4; ++i) if (s0 + i > t) acc[i] = 0.f;
            }
            v2u pk; pk.x = pg8::cvt_pk_bf16(acc[0], acc[1]); pk.y = pg8::cvt_pk_bf16(acc[2], acc[3]);
            *(LAS v2u*)(L + G3_IN + (16 * tr + r16) * 144 + (16 * sc + 4 * q4) * 2) = pk;
        }
        __syncthreads();
        bf16x8 vf[2][2];
#pragma unroll
        for (int rb = 0; rb < 2; ++rb)
#pragma unroll
            for (int ks = 0; ks < 2; ++ks) vf[rb][ks] = *(const LAS bf16x8*)(L + G_VT + (32 * w + 16 * rb + r16) * 144 + (32 * ks + 8 * q4) * 2);
        pg8::f32x4 o[2][4]; float ss[4];
#pragma unroll
        for (int cb = 0; cb < 4; ++cb) {
            bf16x8 qf[4], nf[2];
#pragma unroll
            for (int ks = 0; ks < 4; ++ks) qf[ks] = *(const LAS bf16x8*)(L + G3_QD + (16 * cb + r16) * 272 + (32 * ks + 8 * q4) * 2);
#pragma unroll
            for (int ks = 0; ks < 2; ++ks) nf[ks] = *(const LAS bf16x8*)(L + G3_IN + (16 * cb + r16) * 144 + (32 * ks + 8 * q4) * 2);
            float sq = 0.f;
#pragma unroll
            for (int rb = 0; rb < 2; ++rb) { pg8::f32x4 acc = {0.f, 0.f, 0.f, 0.f};
#pragma unroll
                for (int ks = 0; ks < 4; ++ks) acc = mma16(sf[rb][ks], qf[ks], acc);
#pragma unroll
                for (int ks = 0; ks < 2; ++ks) acc = mma16(vf[rb][ks], nf[ks], acc);
                o[rb][cb] = acc; sq += (acc[0] * acc[0] + acc[1] * acc[1]) + (acc[2] * acc[2] + acc[3] * acc[3]); }
            sq += __shfl_xor(sq, 16); sq += __shfl_xor(sq, 32);
            ss[cb] = sq;
        }
        LAS float* SS = (LAS float*)(L + G3_SS);
        if (q4 == 0) {
#pragma unroll
            for (int cb = 0; cb < 4; ++cb) SS[w * 64 + 16 * cb + r16] = ss[cb]; }
        __syncthreads();
#pragma unroll
        for (int cb = 0; cb < 4; ++cb) {
            float tot = 0.f;
#pragma unroll
            for (int ww = 0; ww < 8; ++ww) tot += SS[ww * 64 + 16 * cb + r16];
            const float rs = 1.0f / sqrtf(tot * (1.0f / 256.0f) + NORM_EPS);
            const size_t m = m0 + 16 * cb + r16;
#pragma unroll
            for (int rb = 0; rb < 2; ++rb) { const int dv = 32 * w + 16 * rb + 4 * q4;
                const f32x4 gv = *(const f32x4*)(F.gla_gain + (size_t)l * 256 + dv);
                const v2u rr = *(const v2u*)(F.MIX + m * MIXLD + C_RG + h * 256 + dv);
                const float r[4] = {bf_lo(rr.x), bf_hi(rr.x), bf_lo(rr.y), bf_hi(rr.y)};
                float y[4];
#pragma unroll
                for (int e = 0; e < 4; ++e) y[e] = ((o[rb][cb][e] * rs) * gv[e]) * (r[e] / (1.0f + expf(-r[e])));
                v2u wv; wv.x = pg8::cvt_pk_bf16(y[0], y[1]); wv.y = pg8::cvt_pk_bf16(y[2], y[3]);
                *(v2u*)(F.MO + m * D + 1024 + h * 256 + dv) = wv; }
        }
        __syncthreads();
    }
}


__device__ __forceinline__ void attn_mfma(Frame& F, int l) {
    RELAUNDER(F);
    LAS unsigned char* L = F.lds + RING_OFF;
    const int r16 = F.lane & 15, q4 = F.lane >> 4, w = F.wave, g = w >> 1, qh = w & 1;
    for (int uu = F.wcu; uu < (F.nrows >> 7) * 4; uu += F.WG) {
        const int u = (F.row0 >> 7) * 4 + uu;
        const int h = u & 3, nb = u >> 2, n = nb & 63;
        const size_t mq0 = (size_t)nb * 128;
        { const int key = F.tid >> 1, hf = F.tid & 1; const bool ok = (n > 0) || key >= 128;
          const size_t mk = ok ? mq0 + key - 128 : mq0;
          const bf16* kp = F.MIX + mk * MIXLD + C_KA + h * 64 + hf * 16; const float* cs = F.ROPE + mk * 64 + hf * 16;
          v4u lo[2], hi[2]; f32x4 cc[4], sn[4];
#pragma unroll
          for (int j = 0; j < 2; ++j) { lo[j] = *(const v4u*)(kp + 8 * j); hi[j] = *(const v4u*)(kp + 32 + 8 * j); }
#pragma unroll
          for (int j = 0; j < 4; ++j) { cc[j] = *(const f32x4*)(cs + 4 * j); sn[j] = *(const f32x4*)(cs + 32 + 4 * j); }
          v4u o1[2], o2[2];
#pragma unroll
          for (int j = 0; j < 2; ++j) {
              const unsigned lw[4] = {lo[j].x, lo[j].y, lo[j].z, lo[j].w}, hw[4] = {hi[j].x, hi[j].y, hi[j].z, hi[j].w}; unsigned a1[4], a2[4];
#pragma unroll
              for (int e = 0; e < 4; ++e) { const f32x4 c4 = cc[2 * j + (e >> 1)], s4 = sn[2 * j + (e >> 1)];
                  const float ca = (e & 1) ? c4.z : c4.x, cb2 = (e & 1) ? c4.w : c4.y, sa = (e & 1) ? s4.z : s4.x, sb = (e & 1) ? s4.w : s4.y;
                  const float x1a = bf_lo(lw[e]), x1b = bf_hi(lw[e]), x2a = bf_lo(hw[e]), x2b = bf_hi(hw[e]);
                  a1[e] = pg8::cvt_pk_bf16(x1a * ca - x2a * sa, x1b * cb2 - x2b * sb); a2[e] = pg8::cvt_pk_bf16(x2a * ca + x1a * sa, x2b * cb2 + x1b * sb); }
              o1[j] = ok ? (v4u){a1[0], a1[1], a1[2], a1[3]} : (v4u){0u, 0u, 0u, 0u}; o2[j] = ok ? (v4u){a2[0], a2[1], a2[2], a2[3]} : (v4u){0u, 0u, 0u, 0u}; }
          LAS v4u* d1 = (LAS v4u*)(L + A_KS + key * 144 + hf * 32); LAS v4u* d2 = (LAS v4u*)(L + A_KS + key * 144 + 64 + hf * 32);
          d1[0] = o1[0]; d1[1] = o1[1]; d2[0] = o2[0]; d2[1] = o2[1]; }
        { const int d = F.tid & 63, kg = F.tid >> 6; const bool ok = (n > 0) || kg >= 4;
          const bf16* vp = F.MIX + (ok ? mq0 + kg * 32 - 128 : mq0) * MIXLD + C_VA + h * 64 + d;
          unsigned pk[16];
#pragma unroll
          for (int i = 0; i < 16; ++i) pk[i] = ok ? ((unsigned)vp[(size_t)(2 * i) * MIXLD] | ((unsigned)vp[(size_t)(2 * i + 1) * MIXLD] << 16)) : 0u;
          LAS v4u* dst = (LAS v4u*)(L + A_VT + d * 528 + kg * 64);
#pragma unroll
          for (int j = 0; j < 4; ++j) dst[j] = (v4u){pk[4 * j], pk[4 * j + 1], pk[4 * j + 2], pk[4 * j + 3]}; }
        __syncthreads();
        const int hq = h * 4 + g;
        bf16x8 qf[4][2];
#pragma unroll
        for (int cb = 0; cb < 4; ++cb) {
            const size_t mq = mq0 + 64 * qh + 16 * cb + r16;
            const bf16* qp = F.MIX + mq * MIXLD + C_QA + hq * 64 + 8 * q4; const float* cs = F.ROPE + mq * 64 + 8 * q4;
            const v4u lo = *(const v4u*)qp, hi = *(const v4u*)(qp + 32);
            const f32x4 c0 = *(const f32x4*)cs, c1 = *(const f32x4*)(cs + 4), s0 = *(const f32x4*)(cs + 32), s1 = *(const f32x4*)(cs + 36);
            const unsigned lw[4] = {lo.x, lo.y, lo.z, lo.w}, hw[4] = {hi.x, hi.y, hi.z, hi.w};
            const float cc[8] = {c0.x, c0.y, c0.z, c0.w, c1.x, c1.y, c1.z, c1.w}, sn[8] = {s0.x, s0.y, s0.z, s0.w, s1.x, s1.y, s1.z, s1.w};
            unsigned a1[4], a2[4];
#pragma unroll
            for (int e = 0; e < 4; ++e) { const float x1a = bf_lo(lw[e]), x1b = bf_hi(lw[e]), x2a = bf_lo(hw[e]), x2b = bf_hi(hw[e]);
                a1[e] = pg8::cvt_pk_bf16((x1a * cc[2 * e] - x2a * sn[2 * e]) * 0.125f, (x1b * cc[2 * e + 1] - x2b * sn[2 * e + 1]) * 0.125f);
                a2[e] = pg8::cvt_pk_bf16((x2a * cc[2 * e] + x1a * sn[2 * e]) * 0.125f, (x2b * cc[2 * e + 1] + x1b * sn[2 * e + 1]) * 0.125f); }
            const v4u w1 = {a1[0], a1[1], a1[2], a1[3]}, w2 = {a2[0], a2[1], a2[2], a2[3]};
            qf[cb][0] = __builtin_bit_cast(bf16x8, w1); qf[cb][1] = __builtin_bit_cast(bf16x8, w2); }
        const float sink = F.sinks[l * 16 + hq];
#pragma unroll 1
        for (int cb = 0; cb < 4; ++cb) {
            pg8::f32x4 s[12];
#pragma unroll
            for (int kt = 0; kt < 12; ++kt) { pg8::f32x4 acc = {0.f, 0.f, 0.f, 0.f};
#pragma unroll
                for (int ks = 0; ks < 2; ++ks) acc = mma16(*(const LAS bf16x8*)(L + A_KS + (64 * qh + 16 * kt + r16) * 144 + (32 * ks + 8 * q4) * 2), cb == 0 ? qf[0][ks] : cb == 1 ? qf[1][ks] : cb == 2 ? qf[2][ks] : qf[3][ks], acc);
                s[kt] = acc; }
            const int qpos = 64 * qh + 16 * cb + r16;
            float mx = sink;
#pragma unroll
            for (int kt = 0; kt < 12; ++kt)
#pragma unroll
                for (int i = 0; i < 4; ++i) { const int kpos = 64 * qh - 128 + 16 * kt + 4 * q4 + i;
                    const bool valid = (kpos <= qpos) && (kpos > qpos - 128) && (n > 0 || kpos >= 0);
                    s[kt][i] = valid ? s[kt][i] : -INFINITY; mx = fmaxf(mx, s[kt][i]); }
            mx = fmaxf(mx, __shfl_xor(mx, 16)); mx = fmaxf(mx, __shfl_xor(mx, 32));
            float sum = 0.f;
#pragma unroll
            for (int kt = 0; kt < 12; ++kt)
#pragma unroll
                for (int i = 0; i < 4; ++i) { s[kt][i] = expf(s[kt][i] - mx); sum += s[kt][i]; }
            sum += __shfl_xor(sum, 16); sum += __shfl_xor(sum, 32);
            sum += expf(sink - mx);
            pg8::f32x4 o[4];
#pragma unroll
            for (int rb = 0; rb < 4; ++rb) o[rb] = (pg8::f32x4){0.f, 0.f, 0.f, 0.f};
#pragma unroll
            for (int kk = 0; kk < 6; ++kk) {
                v4u pw; pw.x = pg8::cvt_pk_bf16(s[2 * kk][0], s[2 * kk][1]); pw.y = pg8::cvt_pk_bf16(s[2 * kk][2], s[2 * kk][3]);
                pw.z = pg8::cvt_pk_bf16(s[2 * kk + 1][0], s[2 * kk + 1][1]); pw.w = pg8::cvt_pk_bf16(s[2 * kk + 1][2], s[2 * kk + 1][3]);
                const bf16x8 pf = __builtin_bit_cast(bf16x8, pw);
#pragma unroll
                for (int rb = 0; rb < 4; ++rb) {
                    const v2u lo = *(const LAS v2u*)(L + A_VT + (16 * rb + r16) * 528 + (64 * qh + 32 * kk + 4 * q4) * 2);
                    const v2u hi = *(const LAS v2u*)(L + A_VT + (16 * rb + r16) * 528 + (64 * qh + 32 * kk + 16 + 4 * q4) * 2);
                    const v4u vw = {lo.x, lo.y, hi.x, hi.y};
                    o[rb] = mma16(__builtin_bit_cast(bf16x8, vw), pf, o[rb]); }
            }
            const float inv = 1.0f / sum;
            bf16* op = F.MO + (mq0 + qpos) * D + hq * 64 + 4 * q4;
#pragma unroll
            for (int rb = 0; rb < 4; ++rb) { v2u wv; wv.x = pg8::cvt_pk_bf16(o[rb][0] * inv, o[rb][1] * inv); wv.y = pg8::cvt_pk_bf16(o[rb][2] * inv, o[rb][3] * inv);
                *(v2u*)(op + 16 * rb) = wv; }
        }
        __syncthreads();
    }
}

struct Args { const void* in[11]; float* out; unsigned char* ws; };
__global__ void __launch_bounds__(NWAVES * 64, 2) fwd(Args args) {
    extern __shared__ __attribute__((aligned(16))) unsigned char lds[];
    Frame F;
    F.lds = (LAS unsigned char*)lds;
    F.MISC = (volatile LAS unsigned*)(F.lds + MISC_OFF);
    F.tid = threadIdx.x; F.lane = F.tid & 63; F.wave = __builtin_amdgcn_readfirstlane(F.tid >> 6);
    F.G = gridDim.x; const int bx = blockIdx.x; F.vcu = (F.G % 8 == 0) ? (bx % 8) * (F.G / 8) + bx / 8 : bx;
    constexpr bool kDual = false;
    const bool dual = kDual && (F.G % 16 == 0);
    const int grp = dual ? ((bx >> 3) & 1) : 0;
    unsigned char* ws = args.ws;
    F.ctl = (gu32*)(ws + WS_CTL);
    RELAUNDER(F);
    for (int u = F.tid; u < (LDS_BYTES - LDSCTL_OFF) / 4; u += NWAVES * 64) ((LAS unsigned*)(F.lds + LDSCTL_OFF))[u] = 0u;
    __syncthreads();
    XcdBarrier bar_all = xcd_barrier_post((unsigned*)(F.ctl + CW_BAR), F.MISC + 8, (unsigned)F.G);
    XcdBarrier bar = xcd_barrier_post((unsigned*)(F.ctl + CW_BAR + (1 + grp) * XCD_BAR_WORDS), F.MISC + 10, (unsigned)(dual ? F.G / 2 : F.G));
#define GRID_BAR_OF(B) do { XcdBarrier b_ = (B); GAS unsigned* gb_ = (GAS unsigned*)(B).bar; asm volatile("" : "+s"(gb_), "+s"(b_.x)); b_.bar = (unsigned*)gb_; xcd_barrier(b_); } while (0)
#define GRID_BAR() GRID_BAR_OF(bar)

    F.wcu = F.vcu; F.WG = F.G; F.row0 = 0; F.nrows = M; F.gc = bx; F.nxl = 8;
    p0_convert(F, 0, 1);
    p0_rope(F);
    norm_phase<true>(F, 0, 0, 0, 0.f, true);
    GRID_BAR_OF(bar_all);
    if (dual) { const int xl = bx & 7, q = bx >> 4; F.wcu = xl * (F.G / 16) + q; F.WG = F.G / 2; F.row0 = grp * SEQ; F.nrows = SEQ; F.gc = q * 8 + xl; F.nxl = 8; }
    gu32* wflag = F.ctl + CW_WFLAG;
    if (!dual || grp == 1) {
        p0_convert(F, 1, DEPTH);
        GRID_BAR();
        if (F.wcu == 0 && F.tid == 0) __hip_atomic_store(wflag, 1u, RLX_AGENT);
    }

#pragma unroll 1
    for (int l = 0; l < DEPTH; ++l) {
        const size_t r0 = (size_t)F.row0;
        RELAUNDER(F);
        { pg8::Gemm gm{F.XN + r0 * D, F.WFI + (size_t)(2 * l) * NFF * D, F.nrows, NFF, D}; pg8::StaticOrder S; S.init(F.nrows, NFF, F.WG, F.gc, F.nxl);
          pg8::EpiSwiGLU E{F.ACT + r0 * DFF, DFF};
          pg8::gemm_phase<pg8::EpiSwiGLU, pg8::StaticOrder, true, true>(F.lds + RING_OFF, gm, S, E); }
        GRID_BAR();
        RELAUNDER(F);
        { pg8::Gemm gm{F.ACT + r0 * DFF, F.WFO + (size_t)(2 * l) * D * DFF, F.nrows, D, DFF}; pg8::StaticOrder S; S.init(F.nrows, D, F.WG, F.gc, F.nxl);
          pg8::EpiPlain E{F.H + r0 * D, D};
          pg8::gemm_phase<pg8::EpiPlain, pg8::StaticOrder, true, true>(F.lds + RING_OFF, gm, S, E); }
        GRID_BAR();
        norm_phase<false>(F, 3 * l + 0, l * 6 + 1, l * 6 + 2, 0.5f, true);
        GRID_BAR();
        RELAUNDER(F);
        { pg8::Gemm gm{F.XN + r0 * D, F.WMI + (size_t)l * NMIXP * D, F.nrows, NMIXP, D}; pg8::StaticOrder S; S.init(F.nrows, NMIXP, F.WG, F.gc, F.nxl);
          pg8::EpiMix E{F.MIX + r0 * MIXLD, MIXLD, F.GLR + r0 * 16, MIXLD / 256};
          pg8::gemm_phase<pg8::EpiMix, pg8::StaticOrder, true, true>(F.lds + RING_OFF, gm, S, E); }
        GRID_BAR();
        gla_g1(F, l);
        attn_mfma(F, l);
        GRID_BAR();
        gla_scan(F);
        GRID_BAR();
        gla_g3(F, l);
        GRID_BAR();
        RELAUNDER(F);
        { pg8::Gemm gm{F.MO + r0 * D, F.WMO + (size_t)l * D * D, F.nrows, D, D}; pg8::StaticOrder S; S.init(F.nrows, D, F.WG, F.gc, F.nxl);
          pg8::EpiPlain E{F.H + r0 * D, D};
          pg8::gemm_phase<pg8::EpiPlain, pg8::StaticOrder, true, true>(F.lds + RING_OFF, gm, S, E); }
        GRID_BAR();
        norm_phase<false>(F, 3 * l + 1, l * 6 + 3, l * 6 + 4, 1.0f, true);
        GRID_BAR();
        RELAUNDER(F);
        { pg8::Gemm gm{F.XN + r0 * D, F.WFI + (size_t)(2 * l + 1) * NFF * D, F.nrows, NFF, D}; pg8::StaticOrder S; S.init(F.nrows, NFF, F.WG, F.gc, F.nxl);
          pg8::EpiSwiGLU E{F.ACT + r0 * DFF, DFF};
          pg8::gemm_phase<pg8::EpiSwiGLU, pg8::StaticOrder, true, true>(F.lds + RING_OFF, gm, S, E); }
        GRID_BAR();
        RELAUNDER(F);
        { pg8::Gemm gm{F.ACT + r0 * DFF, F.WFO + (size_t)(2 * l + 1) * D * DFF, F.nrows, D, DFF}; pg8::StaticOrder S; S.init(F.nrows, D, F.WG, F.gc, F.nxl);
          pg8::EpiPlain E{F.H + r0 * D, D};
          pg8::gemm_phase<pg8::EpiPlain, pg8::StaticOrder, true, true>(F.lds + RING_OFF, gm, S, E); }
        GRID_BAR();
        norm_phase<false>(F, 3 * l + 2, l * 6 + 5, l * 6 + 6  , 0.5f, l + 1 < DEPTH);
        if (l + 1 < DEPTH) {
            if (l == 0 && dual && grp == 0 && F.tid == 0) {
                unsigned sp = 0; while (__hip_atomic_load(wflag, RLX_AGENT) == 0u) { __builtin_amdgcn_s_sleep(8); if (++sp > (1u << 22)) break; } }
            GRID_BAR();
        }
    }
}

extern "C" void kernel_launch(void* const* d_in, const int* in_sizes, int n_in, void* d_out, int out_size, void* d_ws, size_t ws_size, hipStream_t stream) {
    static int grid = 0;
    if (grid == 0) {
        if (n_in != 11 || in_sizes[0] != M * D || out_size != M * D || ws_size < WS_END) { fprintf(stderr, "kernel_launch: unexpected shapes (n_in %d, in0 %d, out %d, ws %zu < %zu); nothing launched\n", n_in, n_in > 0 ? in_sizes[0] : -1, out_size, ws_size, (size_t)WS_END); grid = -1; return; }
        int dev = 0, cus = 0, per_cu = 0;
        if (hipGetDevice(&dev) != hipSuccess || hipDeviceGetAttribute(&cus, hipDeviceAttributeMultiprocessorCount, dev) != hipSuccess) { fprintf(stderr, "kernel_launch: device query failed\n"); grid = -1; return; }
        if (hipFuncSetAttribute((const void*)fwd, hipFuncAttributeMaxDynamicSharedMemorySize, LDS_BYTES) != hipSuccess) { fprintf(stderr, "kernel_launch: hipFuncSetAttribute failed\n"); grid = -1; return; }
        if (hipOccupancyMaxActiveBlocksPerMultiprocessor(&per_cu, (const void*)fwd, NWAVES * 64, LDS_BYTES) != hipSuccess || per_cu < 1) { fprintf(stderr, "kernel_launch: occupancy query reports %d workgroups per CU\n", per_cu); }
        (void)hipGetLastError();
        grid = cus;
    }
    if (grid < 0) return;
    if (hipMemsetAsync((char*)d_ws + WS_CTL, 0, CTL_ZERO_BYTES, stream) != hipSuccess) { fprintf(stderr, "kernel_launch: memset failed\n"); return; }
    Args a{};
    for (int i = 0; i < 11; ++i) a.in[i] = d_in[i];
    a.out = (float*)d_out; a.ws = (unsigned char*)d_ws;
    hipLaunchKernelGGL(fwd, dim3(grid), dim3(NWAVES * 64), LDS_BYTES, stream, a);
    const hipError_t le = hipPeekAtLastError();
    if (le != hipSuccess) fprintf(stderr, "kernel_launch: launch failed: %s\n", hipGetErrorName(le));
}
```

```cpp
#include <hip/hip_runtime.h>
#include <cstdio>
#include <cstdint>
#include <cmath>
namespace pg8 {
#define PG8_LAS __attribute__((address_space(3)))
typedef unsigned short bf16_t;
typedef short bf16x8 __attribute__((ext_vector_type(8)));
typedef float f32x4 __attribute__((ext_vector_type(4)));
typedef unsigned u32x4 __attribute__((ext_vector_type(4)));
constexpr int BM = 256, BK = 64, HALF = 128, HTB = HALF * BK * 2  , STAGE_BYTES = 8 * HTB, NXCD = 8, WGM = 8;

__host__ __device__ __forceinline__ int lds_byte(int r, int c) { const int st = (r >> 4) * 2 + (c >> 5), rr = r & 15, cc = c & 31, ob = rr * 64 + cc * 2; return st * 1024 + (ob ^ (((ob >> 9) & 1) << 5)); }
__host__ __device__ __forceinline__ void stage_rc(int b, int& R, int& C) { const int st = b / 1024, sb = b % 1024, swz = sb ^ (((sb >> 9) & 1) << 5); R = (st >> 1) * 16 + swz / 64; C = (st & 1) * 32 + (swz % 64) / 2; }
__host__ __device__ __forceinline__ int perm32(int rho) { const int n = rho >> 4, i = rho & 15; return 8 * (i >> 2) + 4 * n + (i & 3); }

struct Unit { int pm, pn; };
struct Gemm { const bf16_t* A; const bf16_t* Bt; int M, N, K; };

struct StaticOrder {
    int nM, nN, nwg, G, c, nx;
    __host__ __device__ void init(int M, int N, int G_, int c_, int nx_ = NXCD) { nM = M / BM; nN = N / BM; nwg = nM * nN; G = G_; c = c_; nx = nx_; }
    __host__ __device__ bool next(int i, Unit& u) const {
        const long L = (long)i * G + c; if (L >= nwg) return false;
        int wgid = (int)L; { const int q = nwg / nx, r = nwg % nx, xcd = wgid % nx, off = wgid / nx; wgid = (xcd < r ? xcd * (q + 1) : r * (q + 1) + (xcd - r) * q) + off; }
        const int nig = WGM * nN, gid = wgid / nig, fm = gid * WGM, gsz = (nM - fm) < WGM ? (nM - fm) : WGM;
        u.pm = fm + ((wgid % nig) % gsz); u.pn = (wgid % nig) / gsz; return true;
    }
    __device__ __forceinline__ void a_ready(const Unit&) const {}
    __device__ __forceinline__ void done(const Unit&) const {}
};

__device__ __forceinline__ unsigned cvt_pk_bf16(float lo, float hi) { unsigned r; asm volatile("v_cvt_pk_bf16_f32 %0, %1, %2" : "=v"(r) : "v"(lo), "v"(hi)); return r; }
typedef float cvt_f32x2 __attribute__((ext_vector_type(2)));
typedef __bf16 cvt_bf16x2 __attribute__((ext_vector_type(2)));
__device__ __forceinline__ unsigned cvt_pk_bf16_c(float lo, float hi) { const cvt_f32x2 v = {lo, hi}; return __builtin_bit_cast(unsigned, __builtin_convertvector(v, cvt_bf16x2)); }
typedef float f32x2 __attribute__((ext_vector_type(2)));

__device__ __forceinline__ float silu_f(float g) { return g * __builtin_amdgcn_rcpf(1.0f + __builtin_amdgcn_exp2f(-1.4426950408889634f * g)); }
struct EpiSwiGLU {
    static constexpr bool PERM = true, AFTER_DRAIN = false;
    bf16_t* O; int ldc;
    __device__ __forceinline__ void operator()(const f32x4 (&acc)[2][2][4][2], const Unit& u, int wr, int wc, int fr, int fq) const {
        const int row0 = u.pm * BM + wr * 64 + fr, col0 = u.pn * HALF + wc * 32 + 8 * fq;
#pragma unroll
        for (int ai = 0; ai < 2; ++ai)
#pragma unroll
            for (int m = 0; m < 4; ++m) { bf16_t* rowp = O + (size_t)(row0 + ai * HALF + m * 16) * ldc + col0;
                const f32x4 g0 = acc[ai][0][m][0], g1 = acc[ai][0][m][1], u0 = acc[ai][1][m][0], u1 = acc[ai][1][m][1];
                u32x4 w; w.x = cvt_pk_bf16(silu_f(g0[0]) * u0[0], silu_f(g0[1]) * u0[1]); w.y = cvt_pk_bf16(silu_f(g0[2]) * u0[2], silu_f(g0[3]) * u0[3]);
                w.z = cvt_pk_bf16(silu_f(g1[0]) * u1[0], silu_f(g1[1]) * u1[1]); w.w = cvt_pk_bf16(silu_f(g1[2]) * u1[2], silu_f(g1[3]) * u1[3]);
                *(u32x4*)rowp = w; }
    }
};
struct EpiPlain {
    static constexpr bool PERM = true, AFTER_DRAIN = false;
    bf16_t* O; int ldc;
    __device__ __forceinline__ void operator()(const f32x4 (&acc)[2][2][4][2], const Unit& u, int wr, int wc, int fr, int fq) const {
        const int row0 = u.pm * BM + wr * 64 + fr, col0 = u.pn * BM + wc * 32 + 8 * fq;
#pragma unroll
        for (int ai = 0; ai < 2; ++ai)
#pragma unroll
            for (int m = 0; m < 4; ++m) { bf16_t* rowp = O + (size_t)(row0 + ai * HALF + m * 16) * ldc + col0;
#pragma unroll
                for (int bj = 0; bj < 2; ++bj) { const f32x4 v0 = acc[ai][bj][m][0], v1 = acc[ai][bj][m][1];
                    u32x4 w; w.x = cvt_pk_bf16(v0[0], v0[1]); w.y = cvt_pk_bf16(v0[2], v0[3]); w.z = cvt_pk_bf16(v1[0], v1[1]); w.w = cvt_pk_bf16(v1[2], v1[3]);
                    *(u32x4*)(rowp + bj * HALF) = w; } }
    }
};
struct EpiMix {
    static constexpr bool PERM = true, AFTER_DRAIN = false;
    bf16_t* O; int ldc; float* G; int npl;
    __device__ __forceinline__ void operator()(const f32x4 (&acc)[2][2][4][2], const Unit& u, int wr, int wc, int fr, int fq) const {
        const int row0 = u.pm * BM + wr * 64 + fr;
        if (u.pn < npl) {
            const int col0 = u.pn * BM + wc * 32 + 8 * fq;
#pragma unroll
            for (int ai = 0; ai < 2; ++ai)
#pragma unroll
                for (int m = 0; m < 4; ++m) { bf16_t* rowp = O + (size_t)(row0 + ai * HALF + m * 16) * ldc + col0;
#pragma unroll
                    for (int bj = 0; bj < 2; ++bj) { const f32x4 v0 = acc[ai][bj][m][0], v1 = acc[ai][bj][m][1];
                        u32x4 w; w.x = cvt_pk_bf16(v0[0], v0[1]); w.y = cvt_pk_bf16(v0[2], v0[3]); w.z = cvt_pk_bf16(v1[0], v1[1]); w.w = cvt_pk_bf16(v1[2], v1[3]);
                        *(u32x4*)(rowp + bj * HALF) = w; } }
        } else if (wc == 0 && fq < 2) {
#pragma unroll
            for (int ai = 0; ai < 2; ++ai)
#pragma unroll
                for (int m = 0; m < 4; ++m) { float* rowp = G + (size_t)(row0 + ai * HALF + m * 16) * 16 + 8 * fq;
                    *(f32x4*)rowp = acc[ai][0][m][0]; *(f32x4*)(rowp + 4) = acc[ai][0][m][1]; }
        }
    }
};
template <class Epi, class Sched, bool ALIGN_EPI = false, bool SP2 = false>
__device__ __forceinline__ void gemm_phase(PG8_LAS unsigned char* lds, const Gemm g, const Sched& S, const Epi& E) {
    int tid_ = threadIdx.x; asm volatile("" : "+v"(tid_));
    const int tid = tid_, wid = __builtin_amdgcn_readfirstlane(tid >> 6), lane = tid & 63, wr = wid >> 2, wc = wid & 3, fr = lane & 15, fq = lane >> 4;
    int K_ = g.K; asm volatile("" : "+s"(K_));
    const int K = K_, nt = K / BK;
    unsigned voffA[2], voffB[2];
#pragma unroll
    for (int i = 0; i < 2; ++i) { int R, C; stage_rc(tid * 16 + i * 8192, R, C); const int Rb = Epi::PERM ? ((R & ~31) + perm32(R & 31)) : R;
        voffA[i] = (unsigned)(R * K + C) * 2u; voffB[i] = (unsigned)(Rb * K + C) * 2u; }
    const size_t kstep = (size_t)(BK * 2);
    const size_t hstep = (size_t)HALF * K * 2;
    const size_t tstep = 2 * hstep;
    const unsigned ldsw = (unsigned)wid * 1024u;
    const int aoff = lds_byte(wr * 64 + fr, fq * 8), boff = lds_byte(wc * 32 + fr, fq * 8);
#define PG8_SA(b, h) (((b) * 2 + (h)) * HTB)
#define PG8_SB(b, h) ((4 + (b) * 2 + (h)) * HTB)
#define PG8_STAGE(bufoff, gbase, voff) do { _Pragma("unroll") for (int _i = 0; _i < 2; ++_i) \
        __builtin_amdgcn_global_load_lds((const unsigned*)((const char*)(gbase) + (voff)[_i]), (PG8_LAS unsigned*)(lds + (bufoff) + ldsw + _i * 8192), 16, 0, 0); } while (0)
#define PG8_LDA(dst, b, h) do { _Pragma("unroll") for (int m = 0; m < 4; ++m) _Pragma("unroll") for (int k = 0; k < 2; ++k) dst[m][k] = *(const PG8_LAS bf16x8*)(lds + PG8_SA(b, h) + aoff + m * 2048 + k * 1024); } while (0)
#define PG8_LDB(dst, b, h) do { _Pragma("unroll") for (int n = 0; n < 2; ++n) _Pragma("unroll") for (int k = 0; k < 2; ++k) dst[n][k] = *(const PG8_LAS bf16x8*)(lds + PG8_SB(b, h) + boff + n * 2048 + k * 1024); } while (0)
#define PG8_MMA(ai, bj, At, Bt) do { __builtin_amdgcn_s_setprio(1); _Pragma("unroll") for (int m = 0; m < 4; ++m) _Pragma("unroll") for (int n = 0; n < 2; ++n) _Pragma("unroll") for (int k = 0; k < 2; ++k) \
        acc[ai][bj][m][n] = __builtin_amdgcn_mfma_f32_16x16x32_bf16(Bt[n][k], At[m][k], acc[ai][bj][m][n], 0, 0, 0); __builtin_amdgcn_s_setprio(0); } while (0)
#define PG8_WAIT_V(n) asm volatile("s_waitcnt vmcnt(" #n ")" ::: "memory")
#define PG8_WAIT_L(n) asm volatile("s_waitcnt lgkmcnt(" #n ")" ::: "memory")
#define PG8_BAR __builtin_amdgcn_s_barrier()
#define PG8_SCHED __builtin_amdgcn_sched_barrier(0)
    Unit cur, nxt; int ui = 0;
    if (!S.next(0, cur)) return;
    f32x4 acc[2][2][4][2];
#pragma unroll
    for (int a = 0; a < 2; ++a)
#pragma unroll
        for (int b = 0; b < 2; ++b)
#pragma unroll
            for (int m = 0; m < 4; ++m)
#pragma unroll
                for (int n = 0; n < 2; ++n) acc[a][b][m][n] = (f32x4){0.f, 0.f, 0.f, 0.f};
    bf16x8 At[4][2], B0[2][2], B1[2][2];
    const char* cA = (const char*)g.A + (size_t)cur.pm * tstep; const char* cB = (const char*)g.Bt + (size_t)cur.pn * tstep;
    S.a_ready(cur);
    if constexpr (SP2) {
        PG8_STAGE(PG8_SB(0, 0), cB, voffB); PG8_STAGE(PG8_SB(0, 1), cB + hstep, voffB); PG8_STAGE(PG8_SA(0, 0), cA, voffA); PG8_STAGE(PG8_SA(0, 1), cA + hstep, voffA);
        if (wr == 1) PG8_BAR;
        PG8_WAIT_V(2); PG8_BAR;
        PG8_STAGE(PG8_SB(1, 0), cB + kstep, voffB); PG8_STAGE(PG8_SA(1, 0), cA + kstep, voffA); PG8_STAGE(PG8_SB(1, 1), cB + hstep + kstep, voffB);
        PG8_WAIT_V(6); PG8_BAR;
    } else {
        PG8_STAGE(PG8_SB(0, 0), cB, voffB); PG8_STAGE(PG8_SA(0, 0), cA, voffA); PG8_STAGE(PG8_SB(0, 1), cB + hstep, voffB); PG8_STAGE(PG8_SA(0, 1), cA + hstep, voffA);
        if (wr == 1) PG8_BAR;
        PG8_WAIT_V(4); PG8_BAR;
        PG8_STAGE(PG8_SB(1, 0), cB + kstep, voffB); PG8_STAGE(PG8_SA(1, 0), cA + kstep, voffA); PG8_STAGE(PG8_SB(1, 1), cB + hstep + kstep, voffB);
        PG8_WAIT_V(6); PG8_BAR;
    }
    for (;;) {
        const bool has_next = S.next(ui + 1, nxt);
        const char* nA = has_next ? (const char*)g.A + (size_t)nxt.pm * tstep : cA; const char* nB = has_next ? (const char*)g.Bt + (size_t)nxt.pn * tstep : cB;
        for (int t = 0; t < nt; t += 2) {
            const bool last = (t == nt - 2);
            const char* a1 = cA + (size_t)(t + 1) * kstep;
            const char* a2 = last ? nA : cA + (size_t)(t + 2) * kstep; const char* b2 = last ? nB : cB + (size_t)(t + 2) * kstep;
            const char* a3 = a2 + kstep; const char* b3 = b2 + kstep;
            if (last && has_next) S.a_ready(nxt);
            if constexpr (SP2) {
            PG8_LDB(B0, 0, 0); PG8_LDB(B1, 0, 1); PG8_SCHED; PG8_LDA(At, 0, 0); PG8_STAGE(PG8_SA(1, 1), a1 + hstep, voffA);
            PG8_WAIT_V(8); PG8_WAIT_L(0); PG8_BAR; PG8_MMA(0, 0, At, B0); PG8_MMA(0, 1, At, B1); PG8_BAR; PG8_SCHED;
            PG8_LDA(At, 0, 1); PG8_STAGE(PG8_SB(0, 0), b2, voffB); PG8_STAGE(PG8_SB(0, 1), b2 + hstep, voffB); PG8_STAGE(PG8_SA(0, 0), a2, voffA);
            PG8_WAIT_V(8); PG8_WAIT_L(0); PG8_BAR; PG8_MMA(1, 0, At, B0); PG8_MMA(1, 1, At, B1); PG8_BAR; PG8_SCHED;
            PG8_LDB(B0, 1, 0); PG8_LDB(B1, 1, 1); PG8_SCHED; PG8_LDA(At, 1, 0); PG8_STAGE(PG8_SA(0, 1), a2 + hstep, voffA);
            PG8_WAIT_V(8); PG8_WAIT_L(0); PG8_BAR; PG8_MMA(0, 0, At, B0); PG8_MMA(0, 1, At, B1); PG8_BAR; PG8_SCHED;
            PG8_LDA(At, 1, 1); PG8_STAGE(PG8_SB(1, 0), b3, voffB); PG8_STAGE(PG8_SB(1, 1), b3 + hstep, voffB); PG8_STAGE(PG8_SA(1, 0), a3, voffA);
            PG8_WAIT_V(8); PG8_WAIT_L(0); PG8_BAR; PG8_MMA(1, 0, At, B0); PG8_MMA(1, 1, At, B1); PG8_BAR; PG8_SCHED;
            } else {
            PG8_LDB(B0, 0, 0); PG8_SCHED; PG8_LDA(At, 0, 0); PG8_STAGE(PG8_SA(1, 1), a1 + hstep, voffA);
            PG8_WAIT_L(8); PG8_BAR; PG8_WAIT_L(0); PG8_MMA(0, 0, At, B0); PG8_BAR; PG8_SCHED;
            PG8_LDB(B1, 0, 1); PG8_STAGE(PG8_SB(0, 0), b2, voffB);
            PG8_BAR; PG8_WAIT_L(0); PG8_MMA(0, 1, At, B1); PG8_BAR;
            PG8_LDA(At, 0, 1); PG8_STAGE(PG8_SA(0, 0), a2, voffA);
            PG8_BAR; PG8_WAIT_L(0); PG8_MMA(1, 0, At, B0); PG8_BAR; PG8_SCHED;
            PG8_STAGE(PG8_SB(0, 1), b2 + hstep, voffB);
            PG8_WAIT_V(6); PG8_BAR; PG8_MMA(1, 1, At, B1); PG8_BAR;
            PG8_LDB(B0, 1, 0); PG8_SCHED; PG8_LDA(At, 1, 0); PG8_STAGE(PG8_SA(0, 1), a2 + hstep, voffA);
            PG8_WAIT_L(8); PG8_BAR; PG8_WAIT_L(0); PG8_MMA(0, 0, At, B0); PG8_BAR; PG8_SCHED;
            PG8_LDB(B1, 1, 1); PG8_STAGE(PG8_SB(1, 0), b3, voffB);
            PG8_BAR; PG8_WAIT_L(0); PG8_MMA(0, 1, At, B1); PG8_BAR;
            PG8_LDA(At, 1, 1); PG8_STAGE(PG8_SA(1, 0), a3, voffA);
            PG8_BAR; PG8_WAIT_L(0); PG8_MMA(1, 0, At, B0); PG8_BAR; PG8_SCHED;
            PG8_STAGE(PG8_SB(1, 1), b3 + hstep, voffB);
            PG8_WAIT_V(6); PG8_BAR; PG8_MMA(1, 1, At, B1); PG8_BAR;
            }
        }
        if constexpr (ALIGN_EPI) { if (wr == 0) PG8_BAR; }
        if constexpr (!Epi::AFTER_DRAIN) { E(acc, cur, wr, wc, fr, fq); S.done(cur); }
        if (!has_next) break;
#pragma unroll
        for (int a = 0; a < 2; ++a)
#pragma unroll
            for (int b = 0; b < 2; ++b)
#pragma unroll
                for (int m = 0; m < 4; ++m)
#pragma unroll
                    for (int n = 0; n < 2; ++n) acc[a][b][m][n] = (f32x4){0.f, 0.f, 0.f, 0.f};
        cur = nxt; cA = nA; cB = nB; ++ui;
        if constexpr (ALIGN_EPI) { if (wr == 1) PG8_BAR; }
    }
    PG8_WAIT_V(0);
    if constexpr (!ALIGN_EPI) { if (wr == 0) PG8_BAR; }
    PG8_BAR;
    if constexpr (Epi::AFTER_DRAIN) { E.fused(acc, cur, wr, wc, fr, fq, lds, wid, lane); S.done(cur); }
#undef PG8_SA
#undef PG8_SB
#undef PG8_STAGE
#undef PG8_LDA
#undef PG8_LDB
#undef PG8_MMA
#undef PG8_WAIT_V
#undef PG8_WAIT_L
#undef PG8_BAR
#undef PG8_SCHED
}
}

constexpr int NWAVES = 8;
constexpr int BATCH = 2, SEQ = 8192, M = BATCH * SEQ, D = 2048, DEPTH = 4;
constexpr int DFF = 5504, NFF = 2 * DFF;
constexpr int NMIX = 4624, NMIXP = 4864, MIXLD = 4608;
constexpr int C_QA = 0, C_KA = 1024, C_VA = 1280, C_QG = 1536, C_KG = 2048, C_VG = 2560, C_RG = 3584;
constexpr float NORM_EPS = 1e-6f;

constexpr size_t MiB = 1u << 20;
constexpr size_t WS_CTL = 0, CTL_ZERO_BYTES = 1 * MiB;
constexpr size_t SZ_WFI = (size_t)8 * NFF * D * 2, SZ_WFO = (size_t)8 * D * DFF * 2, SZ_WMI = (size_t)4 * NMIXP * D * 2, SZ_WMO = (size_t)4 * D * D * 2;
constexpr size_t WS_WFI = 2 * MiB;
constexpr size_t WS_WFO = WS_WFI + SZ_WFI;
constexpr size_t WS_WMI = WS_WFO + SZ_WFO;
constexpr size_t WS_WMO = WS_WMI + SZ_WMI;
constexpr size_t WS_XN  = WS_WMO + SZ_WMO;
constexpr size_t WS_ACT = WS_XN + (size_t)M * D * 2;
constexpr size_t WS_H   = WS_ACT + (size_t)M * DFF * 2;
constexpr size_t WS_MIX = WS_H + (size_t)M * D * 2;
constexpr size_t WS_GLR = WS_MIX + (size_t)M * MIXLD * 2;
constexpr size_t WS_ROPE = WS_GLR + (size_t)M * 16 * 4;
constexpr size_t WS_MO  = WS_ROPE + (size_t)M * 64 * 4;
constexpr size_t WS_XB  = WS_MO + (size_t)M * D * 2;
constexpr size_t WS_DEC = WS_XB + (size_t)M * D * 4;
constexpr size_t WS_DS  = WS_DEC + (size_t)1024 * 128 * 4;
constexpr size_t WS_ST  = WS_DS + (size_t)1024 * 32768 * 2;
constexpr size_t WS_END = WS_ST + (size_t)1024 * 32768 * 2;
static_assert(WS_WFI % 256 == 0 && WS_WFO % 256 == 0 && WS_WMI % 256 == 0 && WS_WMO % 256 == 0 && WS_XN % 256 == 0 && WS_ACT % 256 == 0 && WS_H % 256 == 0 && WS_MIX % 256 == 0 && WS_GLR % 256 == 0 && WS_ROPE % 256 == 0 && WS_MO % 256 == 0 && WS_XB % 256 == 0 && WS_DEC % 256 == 0 && WS_DS % 256 == 0 && WS_ST % 256 == 0, "alignment");
constexpr int CW_BAR = 4096;
constexpr int CW_WFLAG = 16384;

constexpr int RING_OFF = 0, RING_BYTES = 131072;
constexpr int LDSCTL_OFF = RING_BYTES, MISC_OFF = LDSCTL_OFF + 320;
constexpr int LDS_BYTES = 147456;
static_assert(MISC_OFF + 128 <= LDS_BYTES, "LDS map");
constexpr int G_KT = 0;
constexpr int G3_B = 0;
constexpr int G_VT = 32768;
constexpr int G_SEG = 69632;
constexpr int G3_QD = 71680;
constexpr int G3_KD = 89088;
constexpr int G3_IN = 106496;
constexpr int G3_SS = 115712;
constexpr int G_GLR = 117760;
static_assert(G_KT + 128 * 144 <= G_VT && G3_B + 32768 <= G_VT && G_VT + 256 * 144 <= G_SEG && G_SEG + 2048 <= G3_QD && G3_QD + 64 * 272 <= G3_KD && G3_KD + 64 * 272 <= G3_IN && G3_IN + 64 * 144 <= G3_SS && G3_SS + 2048 <= G_GLR && G_GLR + 4096 <= RING_BYTES, "GLA LDS map");
constexpr int A_KS = 0;
constexpr int A_VT = 36864;
static_assert(A_VT + 64 * 528 <= RING_BYTES, "attention LDS map");
#define GAS __attribute__((address_space(1)))
#define LAS __attribute__((address_space(3)))
typedef unsigned short bf16;
typedef unsigned v4u __attribute__((ext_vector_type(4)));
typedef float f32x4 __attribute__((ext_vector_type(4)));
typedef short bf16x8 __attribute__((ext_vector_type(8)));
typedef GAS unsigned gu32;
typedef GAS unsigned long long gu64;
#define RLX_AGENT __ATOMIC_RELAXED, __HIP_MEMORY_SCOPE_AGENT
#define LDS_WAIT() asm volatile("s_waitcnt lgkmcnt(0)" ::: "memory")
#define VM_WAIT() asm volatile("s_waitcnt vmcnt(0)" ::: "memory")
__device__ __forceinline__ unsigned long long rt() { return __builtin_amdgcn_s_memrealtime(); }
__device__ __forceinline__ unsigned f2bf(float f) { unsigned u = __builtin_bit_cast(unsigned, f); return (u + 0x7fffu + ((u >> 16) & 1u)) >> 16; }
__device__ __forceinline__ unsigned pk2(float lo, float hi) { return f2bf(lo) | (f2bf(hi) << 16); }
#define XB_TMO      128
#define XB_XCNT(j)  (256  + 64 * (j))
#define XB_XSUB(j)  (1280 + 64 * (j))
#define XB_XGEN(j)  (2304 + 64 * (j))
#define XB_TOP      3328
#define XB_TOPGEN   3392
#define XCD_BAR_WORDS 3456
#define XB_SPIN_CAP (1u << 18)

__device__ __forceinline__ unsigned xb_ld(unsigned* p)              { return __hip_atomic_load(p, __ATOMIC_RELAXED, __HIP_MEMORY_SCOPE_AGENT); }
__device__ __forceinline__ unsigned xb_add(unsigned* p, unsigned v) { return __hip_atomic_fetch_add(p, v, __ATOMIC_RELAXED, __HIP_MEMORY_SCOPE_AGENT); }
__device__ __forceinline__ unsigned xb_xcc_id() { return (unsigned)__builtin_amdgcn_s_getreg((3 << 11) | 20) & 0xFu; }
#define XB_SPIN(cond, bar) do { unsigned _sp = 0; while (cond) { __builtin_amdgcn_s_sleep(1); \
    if ((++_sp & 255u) == 0u) { if (xb_ld(&(bar)[XB_TMO])) break; if (_sp > XB_SPIN_CAP) { atomicAdd(&(bar)[XB_TMO], 1u); break; } } } } while (0)

struct XcdBarrier {
    unsigned* bar; unsigned x; unsigned ng;
    volatile LAS unsigned* st;
};

__device__ __forceinline__ XcdBarrier xcd_barrier_post(unsigned* bar, volatile LAS unsigned* st, unsigned ng) {
    XcdBarrier b; b.bar = bar; b.x = xb_xcc_id(); b.st = st; b.ng = ng;
    if (threadIdx.x == 0) (void)xb_add(&bar[XB_XCNT(b.x)], 1u);
    return b;
}
__device__ __forceinline__ void xcd_barrier_complete(unsigned* bar, unsigned x, unsigned G, unsigned& nloc, unsigned& nx) {
    unsigned sum, cnt, mine, sp = 0u;
    for (;;) {
        sum = 0u; cnt = 0u; mine = 0u;
#pragma unroll
        for (unsigned j = 0; j < 16; ++j) { const unsigned c = xb_ld(&bar[XB_XCNT(j)]); sum += c; cnt += (c > 0u) ? 1u : 0u; mine = (j == x) ? c : mine; }
        if (sum == G) break;
        __builtin_amdgcn_s_sleep(1);
        if ((++sp & 255u) == 0u) { if (xb_ld(&bar[XB_TMO])) break; if (sp > XB_SPIN_CAP) { atomicAdd(&bar[XB_TMO], 1u); break; } }
    }
    nloc = mine > 0u ? mine : 1u; nx = cnt > 0u ? cnt : 1u;
}

__device__ __forceinline__ void xcd_barrier(const XcdBarrier& b) {
    asm volatile("s_waitcnt vmcnt(0)" ::: "memory");
    __syncthreads();
    if (threadIdx.x == 0) {
        unsigned* bar = b.bar;
        __builtin_amdgcn_s_waitcnt(0);
        unsigned nloc = b.st[0], nx = b.st[1];
        if (nloc == 0u) { xcd_barrier_complete(bar, b.x, b.ng, nloc, nx); b.st[0] = nloc; b.st[1] = nx; }
        const unsigned old = xb_add(&bar[XB_XSUB(b.x)], 1u);
        const unsigned gen = old / nloc;
        if (old + 1u == (gen + 1u) * nloc) {
            __builtin_amdgcn_fence(__ATOMIC_RELEASE, "agent");
            asm volatile("s_waitcnt vmcnt(0)" ::: "memory");
            const unsigned og = xb_add(&bar[XB_TOP], 1u);
            const unsigned tg = og / nx;
            if (og + 1u == (tg + 1u) * nx) xb_add(&bar[XB_TOPGEN], 1u);
            else XB_SPIN(xb_ld(&bar[XB_TOPGEN]) == tg, bar);
            __builtin_amdgcn_fence(__ATOMIC_ACQUIRE, "agent");
            xb_add(&bar[XB_XGEN(b.x)], 1u);
            asm volatile("s_waitcnt vmcnt(0)" ::: "memory");
        } else {
            XB_SPIN(xb_ld(&bar[XB_XGEN(b.x)]) == gen, bar);
            __builtin_amdgcn_fence(__ATOMIC_ACQUIRE, "agent");
            asm volatile("s_waitcnt vmcnt(0)" ::: "memory");
        }
    }
    __syncthreads();
}

typedef unsigned v2u __attribute__((ext_vector_type(2)));
typedef float v2f __attribute__((ext_vector_type(2)));
struct Frame {
    LAS unsigned char* lds;
    volatile LAS unsigned* MISC;
    gu32* ctl;
    int tid, lane, wave;
    int vcu, G;
    int wcu, WG, row0, nrows, gc, nxl;
    const float* x; const int* pos; const float* gains; const float* w_fi; const float* w_fo; const float* w_mi; const float* sinks; const float* gate_w2; const float* gate_b; const float* gla_gain; const float* w_mo;
    float* out;
    bf16 *WFI, *WFO, *WMI, *WMO, *XN, *ACT, *H, *MIX, *MO;
    float *GLR, *ROPE, *DEC, *XB; bf16 *ST, *DS;
};
#define RELAUNDER(F) do { int t_ = threadIdx.x; asm volatile("" : "+v"(t_)); (F).tid = t_; (F).lane = t_ & 63; (F).wave = __builtin_amdgcn_readfirstlane(t_ >> 6); \
    const __attribute__((address_space(4))) char* kb_ = (const __attribute__((address_space(4))) char*)__builtin_amdgcn_kernarg_segment_ptr(); asm volatile("" : "+s"(kb_)); \
    GAS void* const __attribute__((address_space(4)))* ka_ = (GAS void* const __attribute__((address_space(4)))*)kb_;     \
    (F).x = (const float*)ka_[0]; (F).pos = (const int*)ka_[1]; (F).gains = (const float*)ka_[2]; (F).w_fi = (const float*)ka_[3]; (F).w_fo = (const float*)ka_[4]; (F).w_mi = (const float*)ka_[5]; \
    (F).sinks = (const float*)ka_[6]; (F).gate_w2 = (const float*)ka_[7]; (F).gate_b = (const float*)ka_[8]; (F).gla_gain = (const float*)ka_[9]; (F).w_mo = (const float*)ka_[10]; (F).out = (float*)ka_[11]; \
    unsigned char* ws_ = (unsigned char*)ka_[12]; \
    (F).WFI = (bf16*)(ws_ + WS_WFI); (F).WFO = (bf16*)(ws_ + WS_WFO); (F).WMI = (bf16*)(ws_ + WS_WMI); (F).WMO = (bf16*)(ws_ + WS_WMO); \
    (F).XN = (bf16*)(ws_ + WS_XN); (F).ACT = (bf16*)(ws_ + WS_ACT); (F).H = (bf16*)(ws_ + WS_H); (F).MIX = (bf16*)(ws_ + WS_MIX); (F).MO = (bf16*)(ws_ + WS_MO); \
    (F).GLR = (float*)(ws_ + WS_GLR); (F).ROPE = (float*)(ws_ + WS_ROPE); (F).XB = (float*)(ws_ + WS_XB); (F).DEC = (float*)(ws_ + WS_DEC); (F).DS = (bf16*)(ws_ + WS_DS); (F).ST = (bf16*)(ws_ + WS_ST); } while (0)
__device__ __forceinline__ float wave_sum(float v) {
#pragma unroll
    for (int o = 1; o < 64; o <<= 1) v += __shfl_xor(v, o);
    return v;
}
__device__ __forceinline__ float wave_max(float v) {
#pragma unroll
    for (int o = 1; o < 64; o <<= 1) v = fmaxf(v, __shfl_xor(v, o));
    return v;
}
__device__ __forceinline__ float bf_lo(unsigned w) { return __builtin_bit_cast(float, w << 16); }
__device__ __forceinline__ float bf_hi(unsigned w) { return __builtin_bit_cast(float, w & 0xffff0000u); }
__device__ __forceinline__ float bf1(bf16 h) { return __builtin_bit_cast(float, ((unsigned)h) << 16); }

template <bool FIRST>
__device__ __forceinline__ void norm_phase(Frame& F, int k, int ia, int ib, float cres, bool write_xn) {
    RELAUNDER(F);
    const float* xsrc = (FIRST || k == 0) ? F.x : ((k & 1) ? F.XB : F.out); float* xdst = (k & 1) ? F.out : F.XB;
    const float* ga = F.gains + (size_t)ia * D + 4 * F.lane; const float* gb = F.gains + (size_t)ib * D + 4 * F.lane;
    const int gw = F.wcu * NWAVES + F.wave, NGW = F.WG * NWAVES;
    f32x4 GA[8], GB[8];
#pragma unroll
    for (int j = 0; j < 8; ++j) {
        GA[j] = FIRST ? (f32x4){0.f, 0.f, 0.f, 0.f} : *(const f32x4*)(ga + 256 * j);
        GB[j] = write_xn ? *(const f32x4*)(gb + 256 * j) : (f32x4){0.f, 0.f, 0.f, 0.f}; }
    for (int mm = gw; mm < F.nrows; mm += NGW) {
        const int m = F.row0 + mm;
        const float* xr = xsrc + (size_t)m * D + 4 * F.lane;
        f32x4 xv[8];
#pragma unroll
        for (int j = 0; j < 8; ++j) xv[j] = *(const f32x4*)(xr + 256 * j);
        if (!FIRST) {
            const bf16* hr = F.H + (size_t)m * D + 4 * F.lane;
            v2u hv[8];
#pragma unroll
            for (int j = 0; j < 8; ++j) hv[j] = *(const v2u*)(hr + 256 * j);
            f32x4 hf[8]; float ss = 0.f;
#pragma unroll
            for (int j = 0; j < 8; ++j) { hf[j] = (f32x4){bf_lo(hv[j].x), bf_hi(hv[j].x), bf_lo(hv[j].y), bf_hi(hv[j].y)};
                ss += (hf[j].x * hf[j].x + hf[j].y * hf[j].y) + (hf[j].z * hf[j].z + hf[j].w * hf[j].w); }
            const float rs = 1.0f / sqrtf(wave_sum(ss) * (1.0f / D) + NORM_EPS);
            float* xw = xdst + (size_t)m * D + 4 * F.lane;
#pragma unroll
            for (int j = 0; j < 8; ++j) { xv[j] = xv[j] + cres * ((hf[j] * rs) * GA[j]); *(f32x4*)(xw + 256 * j) = xv[j]; }
        }
        if (write_xn) {
            float s2 = 0.f;
#pragma unroll
            for (int j = 0; j < 8; ++j) s2 += (xv[j].x * xv[j].x + xv[j].y * xv[j].y) + (xv[j].z * xv[j].z + xv[j].w * xv[j].w);
            const float r2 = 1.0f / sqrtf(wave_sum(s2) * (1.0f / D) + NORM_EPS);
            bf16* xo = F.XN + (size_t)m * D + 4 * F.lane;
#pragma unroll
            for (int j = 0; j < 8; ++j) { const f32x4 a = (xv[j] * r2) * GB[j];
                v2u o; o.x = pg8::cvt_pk_bf16(a.x, a.y); o.y = pg8::cvt_pk_bf16(a.z, a.w);
                *(v2u*)(xo + 256 * j) = o; }
        }
    }
}
struct CvtItem { const float* W; bf16* WT; int K, N, nt, kt, mode; };
__device__ __forceinline__ CvtItem cvt_decode(Frame& F, int it, int l0, int nl) {
    constexpr int PER_FI = (NFF / 64) * (D / 64), PER_FO = (D / 64) * (DFF / 64), PER_MI = (NMIXP / 64) * (D / 64), PER_MO = (D / 64) * (D / 64);
    const int IT_FI = 2 * nl * PER_FI, IT_FO = 2 * nl * PER_FO, IT_MI = nl * PER_MI;
    CvtItem c; int r = it;
    if (r < IT_FI) { const int mat = 2 * l0 + r / PER_FI, q = r % PER_FI; c.W = F.w_fi + (size_t)mat * D * NFF; c.WT = F.WFI + (size_t)mat * NFF * D; c.K = D; c.N = NFF; c.kt = q / (NFF / 64); c.nt = q % (NFF / 64); c.mode = 1; return c; } r -= IT_FI;
    if (r < IT_FO) { const int mat = 2 * l0 + r / PER_FO, q = r % PER_FO; c.W = F.w_fo + (size_t)mat * DFF * D; c.WT = F.WFO + (size_t)mat * D * DFF; c.K = DFF; c.N = D; c.kt = q / (D / 64); c.nt = q % (D / 64); c.mode = 0; return c; } r -= IT_FO;
    if (r < IT_MI) { const int mat = l0 + r / PER_MI, q = r % PER_MI; c.W = F.w_mi + (size_t)mat * D * NMIX; c.WT = F.WMI + (size_t)mat * NMIXP * D; c.K = D; c.N = NMIX; c.kt = q / (NMIXP / 64); c.nt = q % (NMIXP / 64); c.mode = 2; return c; } r -= IT_MI;
    { const int mat = l0 + r / PER_MO, q = r % PER_MO; c.W = F.w_mo + (size_t)mat * D * D; c.WT = F.WMO + (size_t)mat * D * D; c.K = D; c.N = D; c.kt = q / (D / 64); c.nt = q % (D / 64); c.mode = 0; return c; }
}
__device__ __forceinline__ void cvt_load(const CvtItem& c, int lane, f32x4 (&v)[16]) {
    const int a = lane & 15, kr = lane >> 4, nd = c.nt * 64 + 4 * a;
    int src = nd; bool valid = true;
    if (c.mode == 1) { const int w = nd & 255; src = ((w >> 7) ? DFF : 0) + (nd >> 8) * 128 + (w & 127); }
    if (c.mode == 2) valid = nd < NMIX;
    const float* wp = c.W + (size_t)(c.kt * 64 + 2 * kr) * c.N + src;
#pragma unroll
    for (int i = 0; i < 16; ++i) v[i] = valid ? *(const f32x4*)(wp + (size_t)(8 * (i >> 1) + (i & 1)) * c.N) : (f32x4){0.f, 0.f, 0.f, 0.f};
}
__device__ __forceinline__ void cvt_store(const CvtItem& c, int lane, const f32x4 (&v)[16], LAS unsigned char* T) {
    const int a = lane & 15, kr = lane >> 4;
#pragma unroll
    for (int p = 0; p < 8; ++p)
#pragma unroll
        for (int j = 0; j < 4; ++j) *(LAS unsigned*)(T + (4 * a + j) * 132 + 4 * (4 * p + kr)) = pg8::cvt_pk_bf16(v[2 * p][j], v[2 * p + 1][j]);
    const int nn = lane >> 3, ch = lane & 7;
    bf16* op = c.WT + (size_t)(c.nt * 64 + nn) * c.K + c.kt * 64 + 8 * ch;
#pragma unroll
    for (int r = 0; r < 8; ++r) { const LAS unsigned* tp = (const LAS unsigned*)(T + (nn + 8 * r) * 132 + 16 * ch);
        const v4u o = {tp[0], tp[1], tp[2], tp[3]};
        *(v4u*)(op + (size_t)(8 * r) * c.K) = o; }
}
__device__ __forceinline__ void p0_convert(Frame& F, int l0, int l1) {
    RELAUNDER(F);
    const int gw = F.wcu * NWAVES + F.wave, NGW = F.WG * NWAVES, nl = l1 - l0;
    const int total = nl * (2 * (NFF / 64) * (D / 64) + 2 * (D / 64) * (DFF / 64) + (NMIXP / 64) * (D / 64) + (D / 64) * (D / 64));
    LAS unsigned char* T = F.lds + RING_OFF + F.wave * 8448;
    f32x4 va[16], vb[16];
    int it = gw;
    if (it < total) { const CvtItem c = cvt_decode(F, it, l0, nl); cvt_load(c, F.lane, va); }
    while (it < total) {
        { const int nx = it + NGW; if (nx < total) { const CvtItem cn = cvt_decode(F, nx, l0, nl); cvt_load(cn, F.lane, vb); }
          const CvtItem c = cvt_decode(F, it, l0, nl); cvt_store(c, F.lane, va, T); it = nx; }
        if (it >= total) break;
        { const int nx = it + NGW; if (nx < total) { const CvtItem cn = cvt_decode(F, nx, l0, nl); cvt_load(cn, F.lane, va); }
          const CvtItem c = cvt_decode(F, it, l0, nl); cvt_store(c, F.lane, vb, T); it = nx; }
    }
}
__device__ __forceinline__ void p0_rope(Frame& F) {
    RELAUNDER(F);
    for (int e = (F.wcu * NWAVES + F.wave) * 64 + F.lane; e < F.nrows * 32; e += F.WG * NWAVES * 64) {
        const int m = F.row0 + (e >> 5), i = e & 31;
        double pw = 1.0; for (int k = 0; k < i; ++k) pw *= 0.7498942093324559;
        const float a = (float)F.pos[m] * (float)pw;
        const double ad = (double)a, k = rint(ad * 0.15915494309189535), r = fma(-k, 6.283185307179586, ad);
        const float rf = (float)r;
        F.ROPE[(size_t)m * 64 + i] = cosf(rf); F.ROPE[(size_t)m * 64 + 32 + i] = sinf(rf);
    }
}

__device__ __forceinline__ pg8::f32x4 mma16(bf16x8 x, bf16x8 y, pg8::f32x4 c) { return __builtin_amdgcn_mfma_f32_16x16x32_bf16(x, y, c, 0, 0, 0); }

__device__ __forceinline__ void gla_cumsum(Frame& F, LAS unsigned char* L, int l, size_t m0, int h, float (&bb)[16], float& off, float& tot) {
    const int dk = F.tid & 127, tq = F.wave >> 1;
    const float* w2 = F.gate_w2 + (size_t)l * 16 * 512 + h * 128 + dk;
    float wv[16];
#pragma unroll
    for (int r = 0; r < 16; ++r) wv[r] = w2[r * 512];
    const float bias = F.gate_b[(size_t)l * 512 + h * 128 + dk];
    LAS float* gl = (LAS float*)(L + G_GLR);
    if (F.tid < 256) *(LAS f32x4*)(gl + 4 * F.tid) = *(const f32x4*)(F.GLR + m0 * 16 + 4 * F.tid);
    __syncthreads();
    const LAS float* gr = gl + tq * 256;
    float run = 0.f;
#pragma unroll
    for (int i = 0; i < 16; ++i) {
        const f32x4 g0 = *(const LAS f32x4*)(gr + i * 16), g1 = *(const LAS f32x4*)(gr + i * 16 + 4), g2 = *(const LAS f32x4*)(gr + i * 16 + 8), g3 = *(const LAS f32x4*)(gr + i * 16 + 12);
        const float gg[16] = {g0.x, g0.y, g0.z, g0.w, g1.x, g1.y, g1.z, g1.w, g2.x, g2.y, g2.z, g2.w, g3.x, g3.y, g3.z, g3.w};
        float z = bias;
#pragma unroll
        for (int r = 0; r < 16; ++r) z += gg[r] * wv[r];
        const float ls = fminf(z, 0.f) - __logf(1.0f + __expf(-fabsf(z)));
        run += ls * 0.0625f; bb[i] = run; }
    LAS float* seg = (LAS float*)(L + G_SEG);
    seg[tq * 128 + dk] = bb[15];
    __syncthreads();
    off = 0.f; tot = 0.f;
#pragma unroll
    for (int q = 0; q < 4; ++q) { const float sg = seg[q * 128 + dk]; tot += sg; if (q < tq) off += sg; }
}
__device__ __forceinline__ void gla_stage_vt(Frame& F, LAS unsigned char* L, size_t m0, int h) {
    const int dv = F.tid & 255, th = F.tid >> 8; const bf16* vp = F.MIX + (m0 + th * 32) * MIXLD + C_VG + h * 256 + dv;
    unsigned pk[16];
#pragma unroll
    for (int i = 0; i < 16; ++i) pk[i] = (unsigned)vp[(size_t)(2 * i) * MIXLD] | ((unsigned)vp[(size_t)(2 * i + 1) * MIXLD] << 16);
    LAS v4u* dst = (LAS v4u*)(L + G_VT + dv * 144 + th * 64);
#pragma unroll
    for (int j = 0; j < 4; ++j) dst[j] = (v4u){pk[4 * j], pk[4 * j + 1], pk[4 * j + 2], pk[4 * j + 3]};
}
__device__ __forceinline__ void gla_g1(Frame& F, int l) {
    RELAUNDER(F);
    LAS unsigned char* L = F.lds + RING_OFF;
    const int r16 = F.lane & 15, q4 = F.lane >> 4, w = F.wave;
    for (int uu = F.wcu; uu < (F.nrows >> 6) * 4; uu += F.WG) {
        const int u = (F.row0 >> 6) * 4 + uu;
        const int c = u >> 2, h = u & 3; const size_t m0 = (size_t)c * 64;
        const int dk = F.tid & 127, tq = F.wave >> 1;
        gla_stage_vt(F, L, m0, h);
        float bb[16], off, tot;
        gla_cumsum(F, L, l, m0, h, bb, off, tot);
        { const bf16* kp = F.MIX + (m0 + tq * 16) * MIXLD + C_KG + h * 128 + dk;
          unsigned pk[8];
#pragma unroll
          for (int i = 0; i < 8; ++i) { const float b0 = bb[2 * i] + off, b1 = bb[2 * i + 1] + off;
              pk[i] = pg8::cvt_pk_bf16(bf1(kp[(size_t)(2 * i) * MIXLD]) * __expf(tot - b0), bf1(kp[(size_t)(2 * i + 1) * MIXLD]) * __expf(tot - b1)); }
          LAS v4u* dst = (LAS v4u*)(L + G_KT + dk * 144 + tq * 32);
          dst[0] = (v4u){pk[0], pk[1], pk[2], pk[3]}; dst[1] = (v4u){pk[4], pk[5], pk[6], pk[7]}; }
        if (tq == 0) F.DEC[(size_t)u * 128 + dk] = __expf(tot);
        __syncthreads();
        bf16x8 av[2][2];
#pragma unroll
        for (int rb = 0; rb < 2; ++rb)
#pragma unroll
            for (int ks = 0; ks < 2; ++ks) av[rb][ks] = *(const LAS bf16x8*)(L + G_VT + (32 * w + 16 * rb + r16) * 144 + (32 * ks + 8 * q4) * 2);
        bf16* dsb = F.DS + (size_t)u * 32768;
#pragma unroll
        for (int cb = 0; cb < 8; ++cb) {
            bf16x8 kv[2];
#pragma unroll
            for (int ks = 0; ks < 2; ++ks) kv[ks] = *(const LAS bf16x8*)(L + G_KT + (16 * cb + r16) * 144 + (32 * ks + 8 * q4) * 2);
#pragma unroll
            for (int rb = 0; rb < 2; ++rb) { pg8::f32x4 acc = {0.f, 0.f, 0.f, 0.f};
#pragma unroll
                for (int ks = 0; ks < 2; ++ks) acc = mma16(kv[ks], av[rb][ks], acc);
                v2u pkd; pkd.x = pg8::cvt_pk_bf16_c(acc[0], acc[1]); pkd.y = pg8::cvt_pk_bf16_c(acc[2], acc[3]);
                *(v2u*)(dsb + (size_t)(32 * w + 16 * rb + r16) * 128 + 16 * cb + 4 * q4) = pkd; }
        }
        __syncthreads();
    }
}
__device__ __forceinline__ void gla_scan(Frame& F) {
    RELAUNDER(F);
    for (int g0 = (F.wcu * NWAVES + F.wave) * 64 + F.lane; g0 < (F.nrows / SEQ) * 65536; g0 += F.WG * NWAVES * 64) {
        const int g = (F.row0 / SEQ) * 65536 + g0;
        const int dk2 = g & 63, dv = (g >> 6) & 255, h = (g >> 14) & 3, b = g >> 16;
        const size_t base = (((size_t)b * 128 * 4 + h) * 256 + dv) * 128 + 2 * dk2, nstr = (size_t)4 * 32768;
        const size_t dbase = ((size_t)b * 128 * 4 + h) * 128 + 2 * dk2, dstr = 4 * 128;
        float s0 = 0.f, s1 = 0.f;
#pragma unroll 1
        for (int n = 0; n < 128; n += 8) {
            v2f d[8], dc[8];
#pragma unroll
            for (int i = 0; i < 8; ++i) { const unsigned dw = *(const unsigned*)(F.DS + base + (size_t)(n + i) * nstr); d[i] = (v2f){bf_lo(dw), bf_hi(dw)}; dc[i] = *(const v2f*)(F.DEC + dbase + (size_t)(n + i) * dstr); }
#pragma unroll
            for (int i = 0; i < 8; ++i) { *(unsigned*)(F.ST + base + (size_t)(n + i) * nstr) = pg8::cvt_pk_bf16(s0, s1);
                s0 = dc[i].x * s0 + d[i].x; s1 = dc[i].y * s1 + d[i].y; }
        }
    }
}
__device__ __forceinline__ void gla_g3(Frame& F, int l) {
    RELAUNDER(F);
    LAS unsigned char* L = F.lds + RING_OFF;
    const int r16 = F.lane & 15, q4 = F.lane >> 4, w = F.wave;
    for (int uu = F.wcu; uu < (F.nrows >> 6) * 4; uu += F.WG) {
        const int u = (F.row0 >> 6) * 4 + uu;
        const int c = u >> 2, h = u & 3; const size_t m0 = (size_t)c * 64;
        const bf16* stb = F.ST + (size_t)u * 32768;
        bf16x8 sf[2][4];
#pragma unroll
        for (int rb = 0; rb < 2; ++rb)
#pragma unroll
            for (int ks = 0; ks < 4; ++ks) sf[rb][ks] = *(const bf16x8*)(stb + (size_t)(32 * w + 16 * rb + r16) * 128 + 32 * ks + 8 * q4);
        gla_stage_vt(F, L, m0, h);
        { float bb[16], off, tot;
          gla_cumsum(F, L, l, m0, h, bb, off, tot);
          const int dk = F.tid & 127, tq = F.wave >> 1; (void)tot;
          LAS float* B = (LAS float*)(L + G3_B);
#pragma unroll
          for (int i = 0; i < 16; ++i) B[(tq * 16 + i) * 128 + dk] = bb[i] + off; }
        __syncthreads();
        { const int t = F.tid >> 3, d0 = (F.tid & 7) * 16; const size_t m = m0 + t;
          const LAS float* bp = (const LAS float*)(L + G3_B) + t * 128 + d0;
          const v4u q0 = *(const v4u*)(F.MIX + m * MIXLD + C_QG + h * 128 + d0), q1 = *(const v4u*)(F.MIX + m * MIXLD + C_QG + h * 128 + d0 + 8);
          const v4u k0 = *(const v4u*)(F.MIX + m * MIXLD + C_KG + h * 128 + d0), k1 = *(const v4u*)(F.MIX + m * MIXLD + C_KG + h * 128 + d0 + 8);
          const unsigned qw[8] = {q0.x, q0.y, q0.z, q0.w, q1.x, q1.y, q1.z, q1.w}, kw[8] = {k0.x, k0.y, k0.z, k0.w, k1.x, k1.y, k1.z, k1.w};
          unsigned qo[8], ko[8];
#pragma unroll
          for (int j = 0; j < 4; ++j) { const f32x4 bv = *(const LAS f32x4*)(bp + 4 * j);
              const float e0 = __expf(bv.x), e1 = __expf(bv.y), e2 = __expf(bv.z), e3 = __expf(bv.w), n0 = __expf(-bv.x), n1 = __expf(-bv.y), n2 = __expf(-bv.z), n3 = __expf(-bv.w);
              qo[2 * j] = pg8::cvt_pk_bf16(bf_lo(qw[2 * j]) * 0.08838834764831845f * e0, bf_hi(qw[2 * j]) * 0.08838834764831845f * e1);
              qo[2 * j + 1] = pg8::cvt_pk_bf16(bf_lo(qw[2 * j + 1]) * 0.08838834764831845f * e2, bf_hi(qw[2 * j + 1]) * 0.08838834764831845f * e3);
              ko[2 * j] = pg8::cvt_pk_bf16(bf_lo(kw[2 * j]) * n0, bf_hi(kw[2 * j]) * n1);
              ko[2 * j + 1] = pg8::cvt_pk_bf16(bf_lo(kw[2 * j + 1]) * n2, bf_hi(kw[2 * j + 1]) * n3); }
          LAS v4u* qd = (LAS v4u*)(L + G3_QD + t * 272 + d0 * 2); LAS v4u* kd = (LAS v4u*)(L + G3_KD + t * 272 + d0 * 2);
          qd[0] = (v4u){qo[0], qo[1], qo[2], qo[3]}; qd[1] = (v4u){qo[4], qo[5], qo[6], qo[7]};
          kd[0] = (v4u){ko[0], ko[1], ko[2], ko[3]}; kd[1] = (v4u){ko[4], ko[5], ko[6], ko[7]}; }
        __syncthreads();
#pragma unroll
        for (int j = 0; j < 2; ++j) {
            const int id = 2 * w + j, tr = id >> 2, sc = id & 3;
            pg8::f32x4 acc = {0.f, 0.f, 0.f, 0.f};
            if (sc <= tr) {
#pragma unroll
                for (int ks = 0; ks < 4; ++ks) acc = mma16(*(const LAS bf16x8*)(L + G3_KD + (16 * sc + r16) * 272 + (32 * ks + 8 * q4) * 2),
                                                           *(const LAS bf16x8*)(L + G3_QD + (16 * tr + r16) * 272 + (32 * ks + 8 * q4) * 2), acc);
                const int t = 16 * tr + r16, s0 = 16 * sc + 4 * q4;
#pragma unroll
                for (int i = 0; i < 4; ++i) if (s0 + i > t) acc[i] = 0.f;
            }
            v2u pk; pk.x = pg8::cvt_pk_bf16(acc[0], acc[1]); pk.y = pg8::cvt_pk_bf16(acc[2], acc[3]);
            *(LAS v2u*)(L + G3_IN + (16 * tr + r16) * 144 + (16 * sc + 4 * q4) * 2) = pk;
        }
        __syncthreads();
        bf16x8 vf[2][2];
#pragma unroll
        for (int rb = 0; rb < 2; ++rb)
#pragma unroll
            for (int ks = 0; ks < 2; ++ks) vf[rb][ks] = *(const LAS bf16x8*)(L + G_VT + (32 * w + 16 * rb + r16) * 144 + (32 * ks + 8 * q4) * 2);
        pg8::f32x4 o[2][4]; float ss[4];
#pragma unroll
        for (int cb = 0; cb < 4; ++cb) {
            bf16x8 qf[4], nf[2];
#pragma unroll
            for (int ks = 0; ks < 4; ++ks) qf[ks] = *(const LAS bf16x8*)(L + G3_QD + (16 * cb + r16) * 272 + (32 * ks + 8 * q4) * 2);
#pragma unroll
            for (int ks = 0; ks < 2; ++ks) nf[ks] = *(const LAS bf16x8*)(L + G3_IN + (16 * cb + r16) * 144 + (32 * ks + 8 * q4) * 2);
            float sq = 0.f;
#pragma unroll
            for (int rb = 0; rb < 2; ++rb) { pg8::f32x4 acc = {0.f, 0.f, 0.f, 0.f};
#pragma unroll
                for (int ks = 0; ks < 4; ++ks) acc = mma16(sf[rb][ks], qf[ks], acc);
#pragma unroll
                for (int ks = 0; ks < 2; ++ks) acc = mma16(vf[rb][ks], nf[ks], acc);
                o[rb][cb] = acc; sq += (acc[0] * acc[0] + acc[1] * acc[1]) + (acc[2] * acc[2] + acc[3] * acc[3]); }
            sq += __shfl_xor(sq, 16); sq += __shfl_xor(sq, 32);
            ss[cb] = sq;
        }
        LAS float* SS = (LAS float*)(L + G3_SS);
        if (q4 == 0) {
#pragma unroll
            for (int cb = 0; cb < 4; ++cb) SS[w * 64 + 16 * cb + r16] = ss[cb]; }
        __syncthreads();
#pragma unroll
        for (int cb = 0; cb < 4; ++cb) {
            float tot = 0.f;
#pragma unroll
            for (int ww = 0; ww < 8; ++ww) tot += SS[ww * 64 + 16 * cb + r16];
            const float rs = 1.0f / sqrtf(tot * (1.0f / 256.0f) + NORM_EPS);
            const size_t m = m0 + 16 * cb + r16;
#pragma unroll
            for (int rb = 0; rb < 2; ++rb) { const int dv = 32 * w + 16 * rb + 4 * q4;
                const f32x4 gv = *(const f32x4*)(F.gla_gain + (size_t)l * 256 + dv);
                const v2u rr = *(const v2u*)(F.MIX + m * MIXLD + C_RG + h * 256 + dv);
                const float r[4] = {bf_lo(rr.x), bf_hi(rr.x), bf_lo(rr.y), bf_hi(rr.y)};
                float y[4];
#pragma unroll
                for (int e = 0; e < 4; ++e) y[e] = ((o[rb][cb][e] * rs) * gv[e]) * (r[e] / (1.0f + expf(-r[e])));
                v2u wv; wv.x = pg8::cvt_pk_bf16(y[0], y[1]); wv.y = pg8::cvt_pk_bf16(y[2], y[3]);
                *(v2u*)(F.MO + m * D + 1024 + h * 256 + dv) = wv; }
        }
        __syncthreads();
    }
}


__device__ __forceinline__ void attn_mfma(Frame& F, int l) {
    RELAUNDER(F);
    LAS unsigned char* L = F.lds + RING_OFF;
    const int r16 = F.lane & 15, q4 = F.lane >> 4, w = F.wave, g = w >> 1, qh = w & 1;
    for (int uu = F.wcu; uu < (F.nrows >> 7) * 4; uu += F.WG) {
        const int u = (F.row0 >> 7) * 4 + uu;
        const int h = u & 3, nb = u >> 2, n = nb & 63;
        const size_t mq0 = (size_t)nb * 128;
        { const int key = F.tid >> 1, hf = F.tid & 1; const bool ok = (n > 0) || key >= 128;
          const size_t mk = ok ? mq0 + key - 128 : mq0;
          const bf16* kp = F.MIX + mk * MIXLD + C_KA + h * 64 + hf * 16; const float* cs = F.ROPE + mk * 64 + hf * 16;
          v4u lo[2], hi[2]; f32x4 cc[4], sn[4];
#pragma unroll
          for (int j = 0; j < 2; ++j) { lo[j] = *(const v4u*)(kp + 8 * j); hi[j] = *(const v4u*)(kp + 32 + 8 * j); }
#pragma unroll
          for (int j = 0; j < 4; ++j) { cc[j] = *(const f32x4*)(cs + 4 * j); sn[j] = *(const f32x4*)(cs + 32 + 4 * j); }
          v4u o1[2], o2[2];
#pragma unroll
          for (int j = 0; j < 2; ++j) {
              const unsigned lw[4] = {lo[j].x, lo[j].y, lo[j].z, lo[j].w}, hw[4] = {hi[j].x, hi[j].y, hi[j].z, hi[j].w}; unsigned a1[4], a2[4];
#pragma unroll
              for (int e = 0; e < 4; ++e) { const f32x4 c4 = cc[2 * j + (e >> 1)], s4 = sn[2 * j + (e >> 1)];
                  const float ca = (e & 1) ? c4.z : c4.x, cb2 = (e & 1) ? c4.w : c4.y, sa = (e & 1) ? s4.z : s4.x, sb = (e & 1) ? s4.w : s4.y;
                  const float x1a = bf_lo(lw[e]), x1b = bf_hi(lw[e]), x2a = bf_lo(hw[e]), x2b = bf_hi(hw[e]);
                  a1[e] = pg8::cvt_pk_bf16(x1a * ca - x2a * sa, x1b * cb2 - x2b * sb); a2[e] = pg8::cvt_pk_bf16(x2a * ca + x1a * sa, x2b * cb2 + x1b * sb); }
              o1[j] = ok ? (v4u){a1[0], a1[1], a1[2], a1[3]} : (v4u){0u, 0u, 0u, 0u}; o2[j] = ok ? (v4u){a2[0], a2[1], a2[2], a2[3]} : (v4u){0u, 0u, 0u, 0u}; }
          LAS v4u* d1 = (LAS v4u*)(L + A_KS + key * 144 + hf * 32); LAS v4u* d2 = (LAS v4u*)(L + A_KS + key * 144 + 64 + hf * 32);
          d1[0] = o1[0]; d1[1] = o1[1]; d2[0] = o2[0]; d2[1] = o2[1]; }
        { const int d = F.tid & 63, kg = F.tid >> 6; const bool ok = (n > 0) || kg >= 4;
          const bf16* vp = F.MIX + (ok ? mq0 + kg * 32 - 128 : mq0) * MIXLD + C_VA + h * 64 + d;
          unsigned pk[16];
#pragma unroll
          for (int i = 0; i < 16; ++i) pk[i] = ok ? ((unsigned)vp[(size_t)(2 * i) * MIXLD] | ((unsigned)vp[(size_t)(2 * i + 1) * MIXLD] << 16)) : 0u;
          LAS v4u* dst = (LAS v4u*)(L + A_VT + d * 528 + kg * 64);
#pragma unroll
          for (int j = 0; j < 4; ++j) dst[j] = (v4u){pk[4 * j], pk[4 * j + 1], pk[4 * j + 2], pk[4 * j + 3]}; }
        __syncthreads();
        const int hq = h * 4 + g;
        bf16x8 qf[4][2];
#pragma unroll
        for (int cb = 0; cb < 4; ++cb) {
            const size_t mq = mq0 + 64 * qh + 16 * cb + r16;
            const bf16* qp = F.MIX + mq * MIXLD + C_QA + hq * 64 + 8 * q4; const float* cs = F.ROPE + mq * 64 + 8 * q4;
            const v4u lo = *(const v4u*)qp, hi = *(const v4u*)(qp + 32);
            const f32x4 c0 = *(const f32x4*)cs, c1 = *(const f32x4*)(cs + 4), s0 = *(const f32x4*)(cs + 32), s1 = *(const f32x4*)(cs + 36);
            const unsigned lw[4] = {lo.x, lo.y, lo.z, lo.w}, hw[4] = {hi.x, hi.y, hi.z, hi.w};
            const float cc[8] = {c0.x, c0.y, c0.z, c0.w, c1.x, c1.y, c1.z, c1.w}, sn[8] = {s0.x, s0.y, s0.z, s0.w, s1.x, s1.y, s1.z, s1.w};
            unsigned a1[4], a2[4];
#pragma unroll
            for (int e = 0; e < 4; ++e) { const float x1a = bf_lo(lw[e]), x1b = bf_hi(lw[e]), x2a = bf_lo(hw[e]), x2b = bf_hi(hw[e]);
                a1[e] = pg8::cvt_pk_bf16((x1a * cc[2 * e] - x2a * sn[2 * e]) * 0.125f, (x1b * cc[2 * e + 1] - x2b * sn[2 * e + 1]) * 0.125f);
                a2[e] = pg8::cvt_pk_bf16((x2a * cc[2 * e] + x1a * sn[2 * e]) * 0.125f, (x2b * cc[2 * e + 1] + x1b * sn[2 * e + 1]) * 0.125f); }
            const v4u w1 = {a1[0], a1[1], a1[2], a1[3]}, w2 = {a2[0], a2[1], a2[2], a2[3]};
            qf[cb][0] = __builtin_bit_cast(bf16x8, w1); qf[cb][1] = __builtin_bit_cast(bf16x8, w2); }
        const float sink = F.sinks[l * 16 + hq];
#pragma unroll 1
        for (int cb = 0; cb < 4; ++cb) {
            pg8::f32x4 s[12];
#pragma unroll
            for (int kt = 0; kt < 12; ++kt) { pg8::f32x4 acc = {0.f, 0.f, 0.f, 0.f};
#pragma unroll
                for (int ks = 0; ks < 2; ++ks) acc = mma16(*(const LAS bf16x8*)(L + A_KS + (64 * qh + 16 * kt + r16) * 144 + (32 * ks + 8 * q4) * 2), cb == 0 ? qf[0][ks] : cb == 1 ? qf[1][ks] : cb == 2 ? qf[2][ks] : qf[3][ks], acc);
                s[kt] = acc; }
            const int qpos = 64 * qh + 16 * cb + r16;
            float mx = sink;
#pragma unroll
            for (int kt = 0; kt < 12; ++kt)
#pragma unroll
                for (int i = 0; i < 4; ++i) { const int kpos = 64 * qh - 128 + 16 * kt + 4 * q4 + i;
                    const bool valid = (kpos <= qpos) && (kpos > qpos - 128) && (n > 0 || kpos >= 0);
                    s[kt][i] = valid ? s[kt][i] : -INFINITY; mx = fmaxf(mx, s[kt][i]); }
            mx = fmaxf(mx, __shfl_xor(mx, 16)); mx = fmaxf(mx, __shfl_xor(mx, 32));
            float sum = 0.f;
#pragma unroll
            for (int kt = 0; kt < 12; ++kt)
#pragma unroll
                for (int i = 0; i < 4; ++i) { s[kt][i] = expf(s[kt][i] - mx); sum += s[kt][i]; }
            sum += __shfl_xor(sum, 16); sum += __shfl_xor(sum, 32);
            sum += expf(sink - mx);
            pg8::f32x4 o[4];
#pragma unroll
            for (int rb = 0; rb < 4; ++rb) o[rb] = (pg8::f32x4){0.f, 0.f, 0.f, 0.f};
#pragma unroll
            for (int kk = 0; kk < 6; ++kk) {
                v4u pw; pw.x = pg8::cvt_pk_bf16(s[2 * kk][0], s[2 * kk][1]); pw.y = pg8::cvt_pk_bf16(s[2 * kk][2], s[2 * kk][3]);
                pw.z = pg8::cvt_pk_bf16(s[2 * kk + 1][0], s[2 * kk + 1][1]); pw.w = pg8::cvt_pk_bf16(s[2 * kk + 1][2], s[2 * kk + 1][3]);
                const bf16x8 pf = __builtin_bit_cast(bf16x8, pw);
#pragma unroll
                for (int rb = 0; rb < 4; ++rb) {
                    const v2u lo = *(const LAS v2u*)(L + A_VT + (16 * rb + r16) * 528 + (64 * qh + 32 * kk + 4 * q4) * 2);
                    const v2u hi = *(const LAS v2u*)(L + A_VT + (16 * rb + r16) * 528 + (64 * qh + 32 * kk + 16 + 4 * q4) * 2);
                    const v4u vw = {lo.x, lo.y, hi.x, hi.y};
                    o[rb] = mma16(__builtin_bit_cast(bf16x8, vw), pf, o[rb]); }
            }
            const float inv = 1.0f / sum;
            bf16* op = F.MO + (mq0 + qpos) * D + hq * 64 + 4 * q4;
#pragma unroll
            for (int rb = 0; rb < 4; ++rb) { v2u wv; wv.x = pg8::cvt_pk_bf16(o[rb][0] * inv, o[rb][1] * inv); wv.y = pg8::cvt_pk_bf16(o[rb][2] * inv, o[rb][3] * inv);
                *(v2u*)(op + 16 * rb) = wv; }
        }
        __syncthreads();
    }
}

struct Args { const void* in[11]; float* out; unsigned char* ws; };
__global__ void __launch_bounds__(NWAVES * 64, 2) fwd(Args args) {
    extern __shared__ __attribute__((aligned(16))) unsigned char lds[];
    Frame F;
    F.lds = (LAS unsigned char*)lds;
    F.MISC = (volatile LAS unsigned*)(F.lds + MISC_OFF);
    F.tid = threadIdx.x; F.lane = F.tid & 63; F.wave = __builtin_amdgcn_readfirstlane(F.tid >> 6);
    F.G = gridDim.x; const int bx = blockIdx.x; F.vcu = (F.G % 8 == 0) ? (bx % 8) * (F.G / 8) + bx / 8 : bx;
    constexpr bool kDual = false;
    const bool dual = kDual && (F.G % 16 == 0);
    const int grp = dual ? ((bx >> 3) & 1) : 0;
    unsigned char* ws = args.ws;
    F.ctl = (gu32*)(ws + WS_CTL);
    RELAUNDER(F);
    for (int u = F.tid; u < (LDS_BYTES - LDSCTL_OFF) / 4; u += NWAVES * 64) ((LAS unsigned*)(F.lds + LDSCTL_OFF))[u] = 0u;
    __syncthreads();
    XcdBarrier bar_all = xcd_barrier_post((unsigned*)(F.ctl + CW_BAR), F.MISC + 8, (unsigned)F.G);
    XcdBarrier bar = xcd_barrier_post((unsigned*)(F.ctl + CW_BAR + (1 + grp) * XCD_BAR_WORDS), F.MISC + 10, (unsigned)(dual ? F.G / 2 : F.G));
#define GRID_BAR_OF(B) do { XcdBarrier b_ = (B); GAS unsigned* gb_ = (GAS unsigned*)(B).bar; asm volatile("" : "+s"(gb_), "+s"(b_.x)); b_.bar = (unsigned*)gb_; xcd_barrier(b_); } while (0)
#define GRID_BAR() GRID_BAR_OF(bar)

    F.wcu = F.vcu; F.WG = F.G; F.row0 = 0; F.nrows = M; F.gc = bx; F.nxl = 8;
    p0_convert(F, 0, 1);
    p0_rope(F);
    norm_phase<true>(F, 0, 0, 0, 0.f, true);
    GRID_BAR_OF(bar_all);
    if (dual) { const int xl = bx & 7, q = bx >> 4; F.wcu = xl * (F.G / 16) + q; F.WG = F.G / 2; F.row0 = grp * SEQ; F.nrows = SEQ; F.gc = q * 8 + xl; F.nxl = 8; }
    gu32* wflag = F.ctl + CW_WFLAG;
    if (!dual || grp == 1) {
        p0_convert(F, 1, DEPTH);
        GRID_BAR();
        if (F.wcu == 0 && F.tid == 0) __hip_atomic_store(wflag, 1u, RLX_AGENT);
    }

#pragma unroll 1
    for (int l = 0; l < DEPTH; ++l) {
        const size_t r0 = (size_t)F.row0;
        RELAUNDER(F);
        { pg8::Gemm gm{F.XN + r0 * D, F.WFI + (size_t)(2 * l) * NFF * D, F.nrows, NFF, D}; pg8::StaticOrder S; S.init(F.nrows, NFF, F.WG, F.gc, F.nxl);
          pg8::EpiSwiGLU E{F.ACT + r0 * DFF, DFF};
          pg8::gemm_phase<pg8::EpiSwiGLU, pg8::StaticOrder, true, true>(F.lds + RING_OFF, gm, S, E); }
        GRID_BAR();
        RELAUNDER(F);
        { pg8::Gemm gm{F.ACT + r0 * DFF, F.WFO + (size_t)(2 * l) * D * DFF, F.nrows, D, DFF}; pg8::StaticOrder S; S.init(F.nrows, D, F.WG, F.gc, F.nxl);
          pg8::EpiPlain E{F.H + r0 * D, D};
          pg8::gemm_phase<pg8::EpiPlain, pg8::StaticOrder, true, true>(F.lds + RING_OFF, gm, S, E); }
        GRID_BAR();
        norm_phase<false>(F, 3 * l + 0, l * 6 + 1, l * 6 + 2, 0.5f, true);
        GRID_BAR();
        RELAUNDER(F);
        { pg8::Gemm gm{F.XN + r0 * D, F.WMI + (size_t)l * NMIXP * D, F.nrows, NMIXP, D}; pg8::StaticOrder S; S.init(F.nrows, NMIXP, F.WG, F.gc, F.nxl);
          pg8::EpiMix E{F.MIX + r0 * MIXLD, MIXLD, F.GLR + r0 * 16, MIXLD / 256};
          pg8::gemm_phase<pg8::EpiMix, pg8::StaticOrder, true, true>(F.lds + RING_OFF, gm, S, E); }
        GRID_BAR();
        gla_g1(F, l);
        attn_mfma(F, l);
        GRID_BAR();
        gla_scan(F);
        GRID_BAR();
        gla_g3(F, l);
        GRID_BAR();
        RELAUNDER(F);
        { pg8::Gemm gm{F.MO + r0 * D, F.WMO + (size_t)l * D * D, F.nrows, D, D}; pg8::StaticOrder S; S.init(F.nrows, D, F.WG, F.gc, F.nxl);
          pg8::EpiPlain E{F.H + r0 * D, D};
          pg8::gemm_phase<pg8::EpiPlain, pg8::StaticOrder, true, true>(F.lds + RING_OFF, gm, S, E); }
        GRID_BAR();
        norm_phase<false>(F, 3 * l + 1, l * 6 + 3, l * 6 + 4, 1.0f, true);
        GRID_BAR();
        RELAUNDER(F);
        { pg8::Gemm gm{F.XN + r0 * D, F.WFI + (size_t)(2 * l + 1) * NFF * D, F.nrows, NFF, D}; pg8::StaticOrder S; S.init(F.nrows, NFF, F.WG, F.gc, F.nxl);
          pg8::EpiSwiGLU E{F.ACT + r0 * DFF, DFF};
          pg8::gemm_phase<pg8::EpiSwiGLU, pg8::StaticOrder, true, true>(F.lds + RING_OFF, gm, S, E); }
        GRID_BAR();
        RELAUNDER(F);
        { pg8::Gemm gm{F.ACT + r0 * DFF, F.WFO + (size_t)(2 * l + 1) * D * DFF, F.nrows, D, DFF}; pg8::StaticOrder S; S.init(F.nrows, D, F.WG, F.gc, F.nxl);
          pg8::EpiPlain E{F.H + r0 * D, D};
          pg8::gemm_phase<pg8::EpiPlain, pg8::StaticOrder, true, true>(F.lds + RING_OFF, gm, S, E); }
        GRID_BAR();
        norm_phase<false>(F, 3 * l + 2, l * 6 + 5, l * 6 + 6  , 0.5f, l + 1 < DEPTH);
        if (l + 1 < DEPTH) {
            if (l == 0 && dual && grp == 0 && F.tid == 0) {
                unsigned sp = 0; while (__hip_atomic_load(wflag, RLX_AGENT) == 0u) { __builtin_amdgcn_s_sleep(8); if (++sp > (1u << 22)) break; } }
            GRID_BAR();
        }
    }
}

extern "C" void kernel_launch(void* const* d_in, const int* in_sizes, int n_in, void* d_out, int out_size, void* d_ws, size_t ws_size, hipStream_t stream) {
    static int grid = 0;
    if (grid == 0) {
        if (n_in != 11 || in_sizes[0] != M * D || out_size != M * D || ws_size < WS_END) { fprintf(stderr, "kernel_launch: unexpected shapes (n_in %d, in0 %d, out %d, ws %zu < %zu); nothing launched\n", n_in, n_in > 0 ? in_sizes[0] : -1, out_size, ws_size, (size_t)WS_END); grid = -1; return; }
        int dev = 0, cus = 0, per_cu = 0;
        if (hipGetDevice(&dev) != hipSuccess || hipDeviceGetAttribute(&cus, hipDeviceAttributeMultiprocessorCount, dev) != hipSuccess) { fprintf(stderr, "kernel_launch: device query failed\n"); grid = -1; return; }
        if (hipFuncSetAttribute((const void*)fwd, hipFuncAttributeMaxDynamicSharedMemorySize, LDS_BYTES) != hipSuccess) { fprintf(stderr, "kernel_launch: hipFuncSetAttribute failed\n"); grid = -1; return; }
        if (hipOccupancyMaxActiveBlocksPerMultiprocessor(&per_cu, (const void*)fwd, NWAVES * 64, LDS_BYTES) != hipSuccess || per_cu < 1) { fprintf(stderr, "kernel_launch: occupancy query reports %d workgroups per CU\n", per_cu); }
        (void)hipGetLastError();
        grid = cus;
    }
    if (grid < 0) return;
    if (hipMemsetAsync((char*)d_ws + WS_CTL, 0, CTL_ZERO_BYTES, stream) != hipSuccess) { fprintf(stderr, "kernel_launch: memset failed\n"); return; }
    Args a{};
    for (int i = 0; i < 11; ++i) a.in[i] = d_in[i];
    a.out = (float*)d_out; a.ws = (unsigned char*)d_ws;
    hipLaunchKernelGGL(fwd, dim3(grid), dim3(NWAVES * 64), LDS_BYTES, stream, a);
    const hipError_t le = hipPeekAtLastError();
    if (le != hipSuccess) fprintf(stderr, "kernel_launch: launch failed: %s\n", hipGetErrorName(le));
}
```

```cpp
#include <hip/hip_runtime.h>
#include <cstdio>
#include <cstdint>
#include <cmath>
namespace pg8 {
#define PG8_LAS __attribute__((address_space(3)))
typedef unsigned short bf16_t;
typedef short bf16x8 __attribute__((ext_vector_type(8)));
typedef float f32x4 __attribute__((ext_vector_type(4)));
typedef unsigned u32x4 __attribute__((ext_vector_type(4)));
constexpr int BM = 256, BK = 64, HALF = 128, HTB = HALF * BK * 2  , STAGE_BYTES = 8 * HTB, NXCD = 8, WGM = 8;

__host__ __device__ __forceinline__ int lds_byte(int r, int c) { const int st = (r >> 4) * 2 + (c >> 5), rr = r & 15, cc = c & 31, ob = rr * 64 + cc * 2; return st * 1024 + (ob ^ (((ob >> 9) & 1) << 5)); }
__host__ __device__ __forceinline__ void stage_rc(int b, int& R, int& C) { const int st = b / 1024, sb = b % 1024, swz = sb ^ (((sb >> 9) & 1) << 5); R = (st >> 1) * 16 + swz / 64; C = (st & 1) * 32 + (swz % 64) / 2; }
__host__ __device__ __forceinline__ int perm32(int rho) { const int n = rho >> 4, i = rho & 15; return 8 * (i >> 2) + 4 * n + (i & 3); }

struct Unit { int pm, pn; };
struct Gemm { const bf16_t* A; const bf16_t* Bt; int M, N, K; };

struct StaticOrder {
    int nM, nN, nwg, G, c, nx;
    __host__ __device__ void init(int M, int N, int G_, int c_, int nx_ = NXCD) { nM = M / BM; nN = N / BM; nwg = nM * nN; G = G_; c = c_; nx = nx_; }
    __host__ __device__ bool next(int i, Unit& u) const {
        const long L = (long)i * G + c; if (L >= nwg) return false;
        int wgid = (int)L; { const int q = nwg / nx, r = nwg % nx, xcd = wgid % nx, off = wgid / nx; wgid = (xcd < r ? xcd * (q + 1) : r * (q + 1) + (xcd - r) * q) + off; }
        const int nig = WGM * nN, gid = wgid / nig, fm = gid * WGM, gsz = (nM - fm) < WGM ? (nM - fm) : WGM;
        u.pm = fm + ((wgid % nig) % gsz); u.pn = (wgid % nig) / gsz; return true;
    }
    __device__ __forceinline__ void a_ready(const Unit&) const {}
    __device__ __forceinline__ void done(const Unit&) const {}
};

__device__ __forceinline__ unsigned cvt_pk_bf16(float lo, float hi) { unsigned r; asm volatile("v_cvt_pk_bf16_f32 %0, %1, %2" : "=v"(r) : "v"(lo), "v"(hi)); return r; }
typedef float cvt_f32x2 __attribute__((ext_vector_type(2)));
typedef __bf16 cvt_bf16x2 __attribute__((ext_vector_type(2)));
__device__ __forceinline__ unsigned cvt_pk_bf16_c(float lo, float hi) { const cvt_f32x2 v = {lo, hi}; return __builtin_bit_cast(unsigned, __builtin_convertvector(v, cvt_bf16x2)); }
typedef float f32x2 __attribute__((ext_vector_type(2)));

__device__ __forceinline__ float silu_f(float g) { return g * __builtin_amdgcn_rcpf(1.0f + __builtin_amdgcn_exp2f(-1.4426950408889634f * g)); }
struct EpiSwiGLU {
    static constexpr bool PERM = true, AFTER_DRAIN = false;
    bf16_t* O; int ldc;
    __device__ __forceinline__ void operator()(const f32x4 (&acc)[2][2][4][2], const Unit& u, int wr, int wc, int fr, int fq) const {
        const int row0 = u.pm * BM + wr * 64 + fr, col0 = u.pn * HALF + wc * 32 + 8 * fq;
#pragma unroll
        for (int ai = 0; ai < 2; ++ai)
#pragma unroll
            for (int m = 0; m < 4; ++m) { bf16_t* rowp = O + (size_t)(row0 + ai * HALF + m * 16) * ldc + col0;
                const f32x4 g0 = acc[ai][0][m][0], g1 = acc[ai][0][m][1], u0 = acc[ai][1][m][0], u1 = acc[ai][1][m][1];
                u32x4 w; w.x = cvt_pk_bf16(silu_f(g0[0]) * u0[0], silu_f(g0[1]) * u0[1]); w.y = cvt_pk_bf16(silu_f(g0[2]) * u0[2], silu_f(g0[3]) * u0[3]);
                w.z = cvt_pk_bf16(silu_f(g1[0]) * u1[0], silu_f(g1[1]) * u1[1]); w.w = cvt_pk_bf16(silu_f(g1[2]) * u1[2], silu_f(g1[3]) * u1[3]);
                *(u32x4*)rowp = w; }
    }
};
struct EpiPlain {
    static constexpr bool PERM = true, AFTER_DRAIN = false;
    bf16_t* O; int ldc;
    __device__ __forceinline__ void operator()(const f32x4 (&acc)[2][2][4][2], const Unit& u, int wr, int wc, int fr, int fq) const {
        const int row0 = u.pm * BM + wr * 64 + fr, col0 = u.pn * BM + wc * 32 + 8 * fq;
#pragma unroll
        for (int ai = 0; ai < 2; ++ai)
#pragma unroll
            for (int m = 0; m < 4; ++m) { bf16_t* rowp = O + (size_t)(row0 + ai * HALF + m * 16) * ldc + col0;
#pragma unroll
                for (int bj = 0; bj < 2; ++bj) { const f32x4 v0 = acc[ai][bj][m][0], v1 = acc[ai][bj][m][1];
                    u32x4 w; w.x = cvt_pk_bf16(v0[0], v0[1]); w.y = cvt_pk_bf16(v0[2], v0[3]); w.z = cvt_pk_bf16(v1[0], v1[1]); w.w = cvt_pk_bf16(v1[2], v1[3]);
                    *(u32x4*)(rowp + bj * HALF) = w; } }
    }
};
struct EpiMix {
    static constexpr bool PERM = true, AFTER_DRAIN = false;
    bf16_t* O; int ldc; float* G; int npl;
    __device__ __forceinline__ void operator()(const f32x4 (&acc)[2][2][4][2], const Unit& u, int wr, int wc, int fr, int fq) const {
        const int row0 = u.pm * BM + wr * 64 + fr;
        if (u.pn < npl) {
            const int col0 = u.pn * BM + wc * 32 + 8 * fq;
#pragma unroll
            for (int ai = 0; ai < 2; ++ai)
#pragma unroll
                for (int m = 0; m < 4; ++m) { bf16_t* rowp = O + (size_t)(row0 + ai * HALF + m * 16) * ldc + col0;
#pragma unroll
                    for (int bj = 0; bj < 2; ++bj) { const f32x4 v0 = acc[ai][bj][m][0], v1 = acc[ai][bj][m][1];
                        u32x4 w; w.x = cvt_pk_bf16(v0[0], v0[1]); w.y = cvt_pk_bf16(v0[2], v0[3]); w.z = cvt_pk_bf16(v1[0], v1[1]); w.w = cvt_pk_bf16(v1[2], v1[3]);
                        *(u32x4*)(rowp + bj * HALF) = w; } }
        } else if (wc == 0 && fq < 2) {
#pragma unroll
            for (int ai = 0; ai < 2; ++ai)
#pragma unroll
                for (int m = 0; m < 4; ++m) { float* rowp = G + (size_t)(row0 + ai * HALF + m * 16) * 16 + 8 * fq;
                    *(f32x4*)rowp = acc[ai][0][m][0]; *(f32x4*)(rowp + 4) = acc[ai][0][m][1]; }
        }
    }
};
template <class Epi, class Sched, bool ALIGN_EPI = false, bool SP2 = false>
__device__ __forceinline__ void gemm_phase(PG8_LAS unsigned char* lds, const Gemm g, const Sched& S, const Epi& E) {
    int tid_ = threadIdx.x; asm volatile("" : "+v"(tid_));
    const int tid = tid_, wid = __builtin_amdgcn_readfirstlane(tid >> 6), lane = tid & 63, wr = wid >> 2, wc = wid & 3, fr = lane & 15, fq = lane >> 4;
    int K_ = g.K; asm volatile("" : "+s"(K_));
    const int K = K_, nt = K / BK;
    unsigned voffA[2], voffB[2];
#pragma unroll
    for (int i = 0; i < 2; ++i) { int R, C; stage_rc(tid * 16 + i * 8192, R, C); const int Rb = Epi::PERM ? ((R & ~31) + perm32(R & 31)) : R;
        voffA[i] = (unsigned)(R * K + C) * 2u; voffB[i] = (unsigned)(Rb * K + C) * 2u; }
    const size_t kstep = (size_t)(BK * 2);
    const size_t hstep = (size_t)HALF * K * 2;
    const size_t tstep = 2 * hstep;
    const unsigned ldsw = (unsigned)wid * 1024u;
    const int aoff = lds_byte(wr * 64 + fr, fq * 8), boff = lds_byte(wc * 32 + fr, fq * 8);
#define PG8_SA(b, h) (((b) * 2 + (h)) * HTB)
#define PG8_SB(b, h) ((4 + (b) * 2 + (h)) * HTB)
#define PG8_STAGE(bufoff, gbase, voff) do { _Pragma("unroll") for (int _i = 0; _i < 2; ++_i) \
        __builtin_amdgcn_global_load_lds((const unsigned*)((const char*)(gbase) + (voff)[_i]), (PG8_LAS unsigned*)(lds + (bufoff) + ldsw + _i * 8192), 16, 0, 0); } while (0)
#define PG8_LDA(dst, b, h) do { _Pragma("unroll") for (int m = 0; m < 4; ++m) _Pragma("unroll") for (int k = 0; k < 2; ++k) dst[m][k] = *(const PG8_LAS bf16x8*)(lds + PG8_SA(b, h) + aoff + m * 2048 + k * 1024); } while (0)
#define PG8_LDB(dst, b, h) do { _Pragma("unroll") for (int n = 0; n < 2; ++n) _Pragma("unroll") for (int k = 0; k < 2; ++k) dst[n][k] = *(const PG8_LAS bf16x8*)(lds + PG8_SB(b, h) + boff + n * 2048 + k * 1024); } while (0)
#define PG8_MMA(ai, bj, At, Bt) do { __builtin_amdgcn_s_setprio(1); _Pragma("unroll") for (int m = 0; m < 4; ++m) _Pragma("unroll") for (int n = 0; n < 2; ++n) _Pragma("unroll") for (int k = 0; k < 2; ++k) \
        acc[ai][bj][m][n] = __builtin_amdgcn_mfma_f32_16x16x32_bf16(Bt[n][k], At[m][k], acc[ai][bj][m][n], 0, 0, 0); __builtin_amdgcn_s_setprio(0); } while (0)
#define PG8_WAIT_V(n) asm volatile("s_waitcnt vmcnt(" #n ")" ::: "memory")
#define PG8_WAIT_L(n) asm volatile("s_waitcnt lgkmcnt(" #n ")" ::: "memory")
#define PG8_BAR __builtin_amdgcn_s_barrier()
#define PG8_SCHED __builtin_amdgcn_sched_barrier(0)
    Unit cur, nxt; int ui = 0;
    if (!S.next(0, cur)) return;
    f32x4 acc[2][2][4][2];
#pragma unroll
    for (int a = 0; a < 2; ++a)
#pragma unroll
        for (int b = 0; b < 2; ++b)
#pragma unroll
            for (int m = 0; m < 4; ++m)
#pragma unroll
                for (int n = 0; n < 2; ++n) acc[a][b][m][n] = (f32x4){0.f, 0.f, 0.f, 0.f};
    bf16x8 At[4][2], B0[2][2], B1[2][2];
    const char* cA = (const char*)g.A + (size_t)cur.pm * tstep; const char* cB = (const char*)g.Bt + (size_t)cur.pn * tstep;
    S.a_ready(cur);
    if constexpr (SP2) {
        PG8_STAGE(PG8_SB(0, 0), cB, voffB); PG8_STAGE(PG8_SB(0, 1), cB + hstep, voffB); PG8_STAGE(PG8_SA(0, 0), cA, voffA); PG8_STAGE(PG8_SA(0, 1), cA + hstep, voffA);
        if (wr == 1) PG8_BAR;
        PG8_WAIT_V(2); PG8_BAR;
        PG8_STAGE(PG8_SB(1, 0), cB + kstep, voffB); PG8_STAGE(PG8_SA(1, 0), cA + kstep, voffA); PG8_STAGE(PG8_SB(1, 1), cB + hstep + kstep, voffB);
        PG8_WAIT_V(6); PG8_BAR;
    } else {
        PG8_STAGE(PG8_SB(0, 0), cB, voffB); PG8_STAGE(PG8_SA(0, 0), cA, voffA); PG8_STAGE(PG8_SB(0, 1), cB + hstep, voffB); PG8_STAGE(PG8_SA(0, 1), cA + hstep, voffA);
        if (wr == 1) PG8_BAR;
        PG8_WAIT_V(4); PG8_BAR;
        PG8_STAGE(PG8_SB(1, 0), cB + kstep, voffB); PG8_STAGE(PG8_SA(1, 0), cA + kstep, voffA); PG8_STAGE(PG8_SB(1, 1), cB + hstep + kstep, voffB);
        PG8_WAIT_V(6); PG8_BAR;
    }
    for (;;) {
        const bool has_next = S.next(ui + 1, nxt);
        const char* nA = has_next ? (const char*)g.A + (size_t)nxt.pm * tstep : cA; const char* nB = has_next ? (const char*)g.Bt + (size_t)nxt.pn * tstep : cB;
        for (int t = 0; t < nt; t += 2) {
            const bool last = (t == nt - 2);
            const char* a1 = cA + (size_t)(t + 1) * kstep;
            const char* a2 = last ? nA : cA + (size_t)(t + 2) * kstep; const char* b2 = last ? nB : cB + (size_t)(t + 2) * kstep;
            const char* a3 = a2 + kstep; const char* b3 = b2 + kstep;
            if (last && has_next) S.a_ready(nxt);
            if constexpr (SP2) {
            PG8_LDB(B0, 0, 0); PG8_LDB(B1, 0, 1); PG8_SCHED; PG8_LDA(At, 0, 0); PG8_STAGE(PG8_SA(1, 1), a1 + hstep, voffA);
            PG8_WAIT_V(8); PG8_WAIT_L(0); PG8_BAR; PG8_MMA(0, 0, At, B0); PG8_MMA(0, 1, At, B1); PG8_BAR; PG8_SCHED;
            PG8_LDA(At, 0, 1); PG8_STAGE(PG8_SB(0, 0), b2, voffB); PG8_STAGE(PG8_SB(0, 1), b2 + hstep, voffB); PG8_STAGE(PG8_SA(0, 0), a2, voffA);
            PG8_WAIT_V(8); PG8_WAIT_L(0); PG8_BAR; PG8_MMA(1, 0, At, B0); PG8_MMA(1, 1, At, B1); PG8_BAR; PG8_SCHED;
            PG8_LDB(B0, 1, 0); PG8_LDB(B1, 1, 1); PG8_SCHED; PG8_LDA(At, 1, 0); PG8_STAGE(PG8_SA(0, 1), a2 + hstep, voffA);
            PG8_WAIT_V(8); PG8_WAIT_L(0); PG8_BAR; PG8_MMA(0, 0, At, B0); PG8_MMA(0, 1, At, B1); PG8_BAR; PG8_SCHED;
            PG8_LDA(At, 1, 1); PG8_STAGE(PG8_SB(1, 0), b3, voffB); PG8_STAGE(PG8_SB(1, 1), b3 + hstep, voffB); PG8_STAGE(PG8_SA(1, 0), a3, voffA);
            PG8_WAIT_V(8); PG8_WAIT_L(0); PG8_BAR; PG8_MMA(1, 0, At, B0); PG8_MMA(1, 1, At, B1); PG8_BAR; PG8_SCHED;
            } else {
            PG8_LDB(B0, 0, 0); PG8_SCHED; PG8_LDA(At, 0, 0); PG8_STAGE(PG8_SA(1, 1), a1 + hstep, voffA);
            PG8_WAIT_L(8); PG8_BAR; PG8_WAIT_L(0); PG8_MMA(0, 0, At, B0); PG8_BAR; PG8_SCHED;
            PG8_LDB(B1, 0, 1); PG8_STAGE(PG8_SB(0, 0), b2, voffB);
            PG8_BAR; PG8_WAIT_L(0); PG8_MMA(0, 1, At, B1); PG8_BAR;
            PG8_LDA(At, 0, 1); PG8_STAGE(PG8_SA(0, 0), a2, voffA);
            PG8_BAR; PG8_WAIT_L(0); PG8_MMA(1, 0, At, B0); PG8_BAR; PG8_SCHED;
            PG8_STAGE(PG8_SB(0, 1), b2 + hstep, voffB);
            PG8_WAIT_V(6); PG8_BAR; PG8_MMA(1, 1, At, B1); PG8_BAR;
            PG8_LDB(B0, 1, 0); PG8_SCHED; PG8_LDA(At, 1, 0); PG8_STAGE(PG8_SA(0, 1), a2 + hstep, voffA);
            PG8_WAIT_L(8); PG8_BAR; PG8_WAIT_L(0); PG8_MMA(0, 0, At, B0); PG8_BAR; PG8_SCHED;
            PG8_LDB(B1, 1, 1); PG8_STAGE(PG8_SB(1, 0), b3, voffB);
            PG8_BAR; PG8_WAIT_L(0); PG8_MMA(0, 1, At, B1); PG8_BAR;
            PG8_LDA(At, 1, 1); PG8_STAGE(PG8_SA(1, 0), a3, voffA);
            PG8_BAR; PG8_WAIT_L(0); PG8_MMA(1, 0, At, B0); PG8_BAR; PG8_SCHED;
            PG8_STAGE(PG8_SB(1, 1), b3 + hstep, voffB);
            PG8_WAIT_V(6); PG8_BAR; PG8_MMA(1, 1, At, B1); PG8_BAR;
            }
        }
        if constexpr (ALIGN_EPI) { if (wr == 0) PG8_BAR; }
        if constexpr (!Epi::AFTER_DRAIN) { E(acc, cur, wr, wc, fr, fq); S.done(cur); }
        if (!has_next) break;
#pragma unroll
        for (int a = 0; a < 2; ++a)
#pragma unroll
            for (int b = 0; b < 2; ++b)
#pragma unroll
                for (int m = 0; m < 4; ++m)
#pragma unroll
                    for (int n = 0; n < 2; ++n) acc[a][b][m][n] = (f32x4){0.f, 0.f, 0.f, 0.f};
        cur = nxt; cA = nA; cB = nB; ++ui;
        if constexpr (ALIGN_EPI) { if (wr == 1) PG8_BAR; }
    }
    PG8_WAIT_V(0);
    if constexpr (!ALIGN_EPI) { if (wr == 0) PG8_BAR; }
    PG8_BAR;
    if constexpr (Epi::AFTER_DRAIN) { E.fused(acc, cur, wr, wc, fr, fq, lds, wid, lane); S.done(cur); }
#undef PG8_SA
#undef PG8_SB
#undef PG8_STAGE
#undef PG8_LDA
#undef PG8_LDB
#undef PG8_MMA
#undef PG8_WAIT_V
#undef PG8_WAIT_L
#undef PG8_BAR
#undef PG8_SCHED
}
}

constexpr int NWAVES = 8;
constexpr int BATCH = 2, SEQ = 8192, M = BATCH * SEQ, D = 2048, DEPTH = 4;
constexpr int DFF = 5504, NFF = 2 * DFF;
constexpr int NMIX = 4624, NMIXP = 4864, MIXLD = 4608;
constexpr int C_QA = 0, C_KA = 1024, C_VA = 1280, C_QG = 1536, C_KG = 2048, C_VG = 2560, C_RG = 3584;
constexpr float NORM_EPS = 1e-6f;

constexpr size_t MiB = 1u << 20;
constexpr size_t WS_CTL = 0, CTL_ZERO_BYTES = 1 * MiB;
constexpr size_t SZ_WFI = (size_t)8 * NFF * D * 2, SZ_WFO = (size_t)8 * D * DFF * 2, SZ_WMI = (size_t)4 * NMIXP * D * 2, SZ_WMO = (size_t)4 * D * D * 2;
constexpr size_t WS_WFI = 2 * MiB;
constexpr size_t WS_WFO = WS_WFI + SZ_WFI;
constexpr size_t WS_WMI = WS_WFO + SZ_WFO;
constexpr size_t WS_WMO = WS_WMI + SZ_WMI;
constexpr size_t WS_XN  = WS_WMO + SZ_WMO;
constexpr size_t WS_ACT = WS_XN + (size_t)M * D * 2;
constexpr size_t WS_H   = WS_ACT + (size_t)M * DFF * 2;
constexpr size_t WS_MIX = WS_H + (size_t)M * D * 2;
constexpr size_t WS_GLR = WS_MIX + (size_t)M * MIXLD * 2;
constexpr size_t WS_ROPE = WS_GLR + (size_t)M * 16 * 4;
constexpr size_t WS_MO  = WS_ROPE + (size_t)M * 64 * 4;
constexpr size_t WS_XB  = WS_MO + (size_t)M * D * 2;
constexpr size_t RB_STRIDE = (size_t)M * D * 4;
constexpr size_t WS_DEC = WS_XB + 2 * RB_STRIDE;
constexpr size_t WS_DS  = WS_DEC + (size_t)1024 * 128 * 4;
constexpr size_t WS_ST  = WS_DS + (size_t)1024 * 32768 * 2;
constexpr size_t WS_END = WS_ST + (size_t)1024 * 32768 * 2;
static_assert(WS_WFI % 256 == 0 && WS_WFO % 256 == 0 && WS_WMI % 256 == 0 && WS_WMO % 256 == 0 && WS_XN % 256 == 0 && WS_ACT % 256 == 0 && WS_H % 256 == 0 && WS_MIX % 256 == 0 && WS_GLR % 256 == 0 && WS_ROPE % 256 == 0 && WS_MO % 256 == 0 && WS_XB % 256 == 0 && WS_DEC % 256 == 0 && WS_DS % 256 == 0 && WS_ST % 256 == 0, "alignment");
constexpr int CW_BAR = 4096;
constexpr int CW_WFLAG = 65536;

constexpr int RING_OFF = 0, RING_BYTES = 131072;
constexpr int LDSCTL_OFF = RING_BYTES, MISC_OFF = LDSCTL_OFF + 320;
constexpr int LDS_BYTES = 147456;
static_assert(MISC_OFF + 128 <= LDS_BYTES, "LDS map");
constexpr int G_KT = 0;
constexpr int G3_B = 0;
constexpr int G_VT = 32768;
constexpr int G_SEG = 69632;
constexpr int G3_QD = 71680;
constexpr int G3_KD = 89088;
constexpr int G3_IN = 106496;
constexpr int G3_SS = 115712;
constexpr int G_GLR = 117760;
static_assert(G_KT + 128 * 144 <= G_VT && G3_B + 32768 <= G_VT && G_VT + 256 * 144 <= G_SEG && G_SEG + 2048 <= G3_QD && G3_QD + 64 * 272 <= G3_KD && G3_KD + 64 * 272 <= G3_IN && G3_IN + 64 * 144 <= G3_SS && G3_SS + 2048 <= G_GLR && G_GLR + 4096 <= RING_BYTES, "GLA LDS map");
constexpr int A_KS = 0;
constexpr int A_VT = 36864;
static_assert(A_VT + 64 * 528 <= RING_BYTES, "attention LDS map");
#define GAS __attribute__((address_space(1)))
#define LAS __attribute__((address_space(3)))
typedef unsigned short bf16;
typedef unsigned v4u __attribute__((ext_vector_type(4)));
typedef float f32x4 __attribute__((ext_vector_type(4)));
typedef short bf16x8 __attribute__((ext_vector_type(8)));
typedef GAS unsigned gu32;
typedef GAS unsigned long long gu64;
#define RLX_AGENT __ATOMIC_RELAXED, __HIP_MEMORY_SCOPE_AGENT
#define LDS_WAIT() asm volatile("s_waitcnt lgkmcnt(0)" ::: "memory")
#define VM_WAIT() asm volatile("s_waitcnt vmcnt(0)" ::: "memory")
__device__ __forceinline__ unsigned long long rt() { return __builtin_amdgcn_s_memrealtime(); }
__device__ __forceinline__ unsigned f2bf(float f) { unsigned u = __builtin_bit_cast(unsigned, f); return (u + 0x7fffu + ((u >> 16) & 1u)) >> 16; }
__device__ __forceinline__ unsigned pk2(float lo, float hi) { return f2bf(lo) | (f2bf(hi) << 16); }
#define XB_TMO      128
#define XB_XCNT(j)  (256  + 64 * (j))
#define XB_XSUB(j)  (1280 + 64 * (j))
#define XB_XGEN(j)  (2304 + 64 * (j))
#define XB_TOP      3328
#define XB_TOPGEN   3392
#define XCD_BAR_WORDS 3456
#define XB_SPIN_CAP (1u << 18)

__device__ __forceinline__ unsigned xb_ld(unsigned* p)              { return __hip_atomic_load(p, __ATOMIC_RELAXED, __HIP_MEMORY_SCOPE_AGENT); }
__device__ __forceinline__ unsigned xb_add(unsigned* p, unsigned v) { return __hip_atomic_fetch_add(p, v, __ATOMIC_RELAXED, __HIP_MEMORY_SCOPE_AGENT); }
__device__ __forceinline__ unsigned xb_xcc_id() { return (unsigned)__builtin_amdgcn_s_getreg((3 << 11) | 20) & 0xFu; }
#define XB_SPIN(cond, bar) do { unsigned _sp = 0; while (cond) { __builtin_amdgcn_s_sleep(1); \
    if ((++_sp & 255u) == 0u) { if (xb_ld(&(bar)[XB_TMO])) break; if (_sp > XB_SPIN_CAP) { atomicAdd(&(bar)[XB_TMO], 1u); break; } } } } while (0)

struct XcdBarrier {
    unsigned* bar; unsigned x; unsigned ng;
    volatile LAS unsigned* st;
};

__device__ __forceinline__ XcdBarrier xcd_barrier_post(unsigned* bar, volatile LAS unsigned* st, unsigned ng) {
    XcdBarrier b; b.bar = bar; b.x = xb_xcc_id(); b.st = st; b.ng = ng;
    if (threadIdx.x == 0) (void)xb_add(&bar[XB_XCNT(b.x)], 1u);
    return b;
}
__device__ __forceinline__ void xcd_barrier_complete(unsigned* bar, unsigned x, unsigned G, unsigned& nloc, unsigned& nx) {
    unsigned sum, cnt, mine, sp = 0u;
    for (;;) {
        sum = 0u; cnt = 0u; mine = 0u;
#pragma unroll
        for (unsigned j = 0; j < 16; ++j) { const unsigned c = xb_ld(&bar[XB_XCNT(j)]); sum += c; cnt += (c > 0u) ? 1u : 0u; mine = (j == x) ? c : mine; }
        if (sum == G) break;
        __builtin_amdgcn_s_sleep(1);
        if ((++sp & 255u) == 0u) { if (xb_ld(&bar[XB_TMO])) break; if (sp > XB_SPIN_CAP) { atomicAdd(&bar[XB_TMO], 1u); break; } }
    }
    nloc = mine > 0u ? mine : 1u; nx = cnt > 0u ? cnt : 1u;
}

__device__ __forceinline__ void xcd_barrier(const XcdBarrier& b) {
    asm volatile("s_waitcnt vmcnt(0)" ::: "memory");
    __syncthreads();
    if (threadIdx.x == 0) {
        unsigned* bar = b.bar;
        __builtin_amdgcn_s_waitcnt(0);
        unsigned nloc = b.st[0], nx = b.st[1];
        if (nloc == 0u) { xcd_barrier_complete(bar, b.x, b.ng, nloc, nx); b.st[0] = nloc; b.st[1] = nx; }
        const unsigned old = xb_add(&bar[XB_XSUB(b.x)], 1u);
        const unsigned gen = old / nloc;
        if (old + 1u == (gen + 1u) * nloc) {
            __builtin_amdgcn_fence(__ATOMIC_RELEASE, "agent");
            asm volatile("s_waitcnt vmcnt(0)" ::: "memory");
            const unsigned og = xb_add(&bar[XB_TOP], 1u);
            const unsigned tg = og / nx;
            if (og + 1u == (tg + 1u) * nx) xb_add(&bar[XB_TOPGEN], 1u);
            else XB_SPIN(xb_ld(&bar[XB_TOPGEN]) == tg, bar);
            __builtin_amdgcn_fence(__ATOMIC_ACQUIRE, "agent");
            xb_add(&bar[XB_XGEN(b.x)], 1u);
            asm volatile("s_waitcnt vmcnt(0)" ::: "memory");
        } else {
            XB_SPIN(xb_ld(&bar[XB_XGEN(b.x)]) == gen, bar);
            __builtin_amdgcn_fence(__ATOMIC_ACQUIRE, "agent");
            asm volatile("s_waitcnt vmcnt(0)" ::: "memory");
        }
    }
    __syncthreads();
}

typedef unsigned v2u __attribute__((ext_vector_type(2)));
typedef float v2f __attribute__((ext_vector_type(2)));
struct Frame {
    LAS unsigned char* lds;
    volatile LAS unsigned* MISC;
    gu32* ctl;
    int tid, lane, wave;
    int vcu, G;
    int wcu, WG, row0, nrows, gc, nxl;
    const float* x; const int* pos; const float* gains; const float* w_fi; const float* w_fo; const float* w_mi; const float* sinks; const float* gate_w2; const float* gate_b; const float* gla_gain; const float* w_mo;
    float* out;
    bf16 *WFI, *WFO, *WMI, *WMO, *XN, *ACT, *H, *MIX, *MO;
    float *GLR, *ROPE, *DEC; bf16 *ST, *DS; unsigned char* RB;
};
#define RELAUNDER(F) do { int t_ = threadIdx.x; asm volatile("" : "+v"(t_)); (F).tid = t_; (F).lane = t_ & 63; (F).wave = __builtin_amdgcn_readfirstlane(t_ >> 6); \
    const __attribute__((address_space(4))) char* kb_ = (const __attribute__((address_space(4))) char*)__builtin_amdgcn_kernarg_segment_ptr(); asm volatile("" : "+s"(kb_)); \
    GAS void* const __attribute__((address_space(4)))* ka_ = (GAS void* const __attribute__((address_space(4)))*)kb_;     \
    (F).x = (const float*)ka_[0]; (F).pos = (const int*)ka_[1]; (F).gains = (const float*)ka_[2]; (F).w_fi = (const float*)ka_[3]; (F).w_fo = (const float*)ka_[4]; (F).w_mi = (const float*)ka_[5]; \
    (F).sinks = (const float*)ka_[6]; (F).gate_w2 = (const float*)ka_[7]; (F).gate_b = (const float*)ka_[8]; (F).gla_gain = (const float*)ka_[9]; (F).w_mo = (const float*)ka_[10]; (F).out = (float*)ka_[11]; \
    unsigned char* ws_ = (unsigned char*)ka_[12]; \
    (F).WFI = (bf16*)(ws_ + WS_WFI); (F).WFO = (bf16*)(ws_ + WS_WFO); (F).WMI = (bf16*)(ws_ + WS_WMI); (F).WMO = (bf16*)(ws_ + WS_WMO); \
    (F).XN = (bf16*)(ws_ + WS_XN); (F).ACT = (bf16*)(ws_ + WS_ACT); (F).H = (bf16*)(ws_ + WS_H); (F).MIX = (bf16*)(ws_ + WS_MIX); (F).MO = (bf16*)(ws_ + WS_MO); \
    (F).GLR = (float*)(ws_ + WS_GLR); (F).ROPE = (float*)(ws_ + WS_ROPE); (F).RB = ws_ + WS_XB; (F).DEC = (float*)(ws_ + WS_DEC); (F).DS = (bf16*)(ws_ + WS_DS); (F).ST = (bf16*)(ws_ + WS_ST); } while (0)
__device__ __forceinline__ float wave_sum(float v) {
#pragma unroll
    for (int o = 1; o < 64; o <<= 1) v += __shfl_xor(v, o);
    return v;
}
__device__ __forceinline__ float wave_max(float v) {
#pragma unroll
    for (int o = 1; o < 64; o <<= 1) v = fmaxf(v, __shfl_xor(v, o));
    return v;
}
__device__ __forceinline__ float bf_lo(unsigned w) { return __builtin_bit_cast(float, w << 16); }
__device__ __forceinline__ float bf_hi(unsigned w) { return __builtin_bit_cast(float, w & 0xffff0000u); }
__device__ __forceinline__ float bf1(bf16 h) { return __builtin_bit_cast(float, ((unsigned)h) << 16); }

constexpr bool kResBf16 = true;
constexpr int N_UPDATES = 3 * DEPTH;
struct RowRaw { f32x4 x[8]; v2u h[8]; };
template <bool FIRST>
__device__ __forceinline__ void norm_load(Frame& F, const void* xsrc, bool src_f32, int m, RowRaw& r) {
    if (src_f32) { const float* xr = (const float*)xsrc + (size_t)m * D + 4 * F.lane;
#pragma unroll
        for (int j = 0; j < 8; ++j) r.x[j] = *(const f32x4*)(xr + 256 * j); }
    else { const bf16* xr = (const bf16*)xsrc + (size_t)m * D + 4 * F.lane;
#pragma unroll
        for (int j = 0; j < 8; ++j) { const v2u w = *(const v2u*)(xr + 256 * j); r.x[j] = (f32x4){bf_lo(w.x), bf_hi(w.x), bf_lo(w.y), bf_hi(w.y)}; } }
    if (!FIRST) { const bf16* hr = F.H + (size_t)m * D + 4 * F.lane;
#pragma unroll
        for (int j = 0; j < 8; ++j) r.h[j] = *(const v2u*)(hr + 256 * j); }
}
template <bool FIRST>
__device__ __forceinline__ void norm_row(Frame& F, void* xdst, bool dst_f32, int m, RowRaw& r, const f32x4 (&GA)[8], const f32x4 (&GB)[8], float cres, bool write_xn) {
    if (!FIRST) {
        f32x4 hf[8]; float ss = 0.f;
#pragma unroll
        for (int j = 0; j < 8; ++j) { hf[j] = (f32x4){bf_lo(r.h[j].x), bf_hi(r.h[j].x), bf_lo(r.h[j].y), bf_hi(r.h[j].y)};
            ss += (hf[j].x * hf[j].x + hf[j].y * hf[j].y) + (hf[j].z * hf[j].z + hf[j].w * hf[j].w); }
        const float rs = 1.0f / sqrtf(wave_sum(ss) * (1.0f / D) + NORM_EPS);
#pragma unroll
        for (int j = 0; j < 8; ++j) r.x[j] = r.x[j] + cres * ((hf[j] * rs) * GA[j]);
        if (dst_f32) { float* xw = (float*)xdst + (size_t)m * D + 4 * F.lane;
#pragma unroll
            for (int j = 0; j < 8; ++j) *(f32x4*)(xw + 256 * j) = r.x[j]; }
        else { bf16* xw = (bf16*)xdst + (size_t)m * D + 4 * F.lane;
#pragma unroll
            for (int j = 0; j < 8; ++j) { v2u o; o.x = pg8::cvt_pk_bf16(r.x[j].x, r.x[j].y); o.y = pg8::cvt_pk_bf16(r.x[j].z, r.x[j].w); *(v2u*)(xw + 256 * j) = o;
                r.x[j] = (f32x4){bf_lo(o.x), bf_hi(o.x), bf_lo(o.y), bf_hi(o.y)}; } }
    }
    if (write_xn) {
        float s2 = 0.f;
#pragma unroll
        for (int j = 0; j < 8; ++j) s2 += (r.x[j].x * r.x[j].x + r.x[j].y * r.x[j].y) + (r.x[j].z * r.x[j].z + r.x[j].w * r.x[j].w);
        const float r2 = 1.0f / sqrtf(wave_sum(s2) * (1.0f / D) + NORM_EPS);
        bf16* xo = F.XN + (size_t)m * D + 4 * F.lane;
#pragma unroll
        for (int j = 0; j < 8; ++j) { const f32x4 a = (r.x[j] * r2) * GB[j];
            v2u o; o.x = pg8::cvt_pk_bf16(a.x, a.y); o.y = pg8::cvt_pk_bf16(a.z, a.w);
            *(v2u*)(xo + 256 * j) = o; }
    }
}
template <bool FIRST>
__device__ __forceinline__ void norm_phase(Frame& F, int k, int ia, int ib, float cres, bool write_xn) {
    RELAUNDER(F);
    const bool src_f32 = FIRST || k == 0 || !kResBf16, dst_f32 = (k == N_UPDATES - 1) || !kResBf16;
    const void* xsrc = (FIRST || k == 0) ? (const void*)F.x : (const void*)(F.RB + (size_t)((k - 1) & 1) * RB_STRIDE);
    void* xdst = (k == N_UPDATES - 1) ? (void*)F.out : (void*)(F.RB + (size_t)(k & 1) * RB_STRIDE);
    const float* ga = F.gains + (size_t)ia * D + 4 * F.lane; const float* gb = F.gains + (size_t)ib * D + 4 * F.lane;
    const int gw = F.wcu * NWAVES + F.wave, NGW = F.WG * NWAVES;
    f32x4 GA[8], GB[8];
#pragma unroll
    for (int j = 0; j < 8; ++j) {
        GA[j] = FIRST ? (f32x4){0.f, 0.f, 0.f, 0.f} : *(const f32x4*)(ga + 256 * j);
        GB[j] = write_xn ? *(const f32x4*)(gb + 256 * j) : (f32x4){0.f, 0.f, 0.f, 0.f}; }
    RowRaw ra, rb;
    int mm = gw;
    if (mm < F.nrows) norm_load<FIRST>(F, xsrc, src_f32, F.row0 + mm, ra);
    while (mm < F.nrows) {
        { const int nx = mm + NGW; if (nx < F.nrows) norm_load<FIRST>(F, xsrc, src_f32, F.row0 + nx, rb);
          norm_row<FIRST>(F, xdst, dst_f32, F.row0 + mm, ra, GA, GB, cres, write_xn); mm = nx; }
        if (mm >= F.nrows) break;
        { const int nx = mm + NGW; if (nx < F.nrows) norm_load<FIRST>(F, xsrc, src_f32, F.row0 + nx, ra);
          norm_row<FIRST>(F, xdst, dst_f32, F.row0 + mm, rb, GA, GB, cres, write_xn); mm = nx; }
    }
}
struct CvtItem { const float* W; bf16* WT; int K, N, nt, kt, mode; };
__device__ __forceinline__ CvtItem cvt_decode(Frame& F, int it, int l0, int nl) {
    constexpr int PER_FI = (NFF / 64) * (D / 64), PER_FO = (D / 64) * (DFF / 64), PER_MI = (NMIXP / 64) * (D / 64), PER_MO = (D / 64) * (D / 64);
    const int IT_FI = 2 * nl * PER_FI, IT_FO = 2 * nl * PER_FO, IT_MI = nl * PER_MI;
    CvtItem c; int r = it;
    if (r < IT_FI) { const int mat = 2 * l0 + r / PER_FI, q = r % PER_FI; c.W = F.w_fi + (size_t)mat * D * NFF; c.WT = F.WFI + (size_t)mat * NFF * D; c.K = D; c.N = NFF; c.kt = q / (NFF / 64); c.nt = q % (NFF / 64); c.mode = 1; return c; } r -= IT_FI;
    if (r < IT_FO) { const int mat = 2 * l0 + r / PER_FO, q = r % PER_FO; c.W = F.w_fo + (size_t)mat * DFF * D; c.WT = F.WFO + (size_t)mat * D * DFF; c.K = DFF; c.N = D; c.kt = q / (D / 64); c.nt = q % (D / 64); c.mode = 0; return c; } r -= IT_FO;
    if (r < IT_MI) { const int mat = l0 + r / PER_MI, q = r % PER_MI; c.W = F.w_mi + (size_t)mat * D * NMIX; c.WT = F.WMI + (size_t)mat * NMIXP * D; c.K = D; c.N = NMIX; c.kt = q / (NMIXP / 64); c.nt = q % (NMIXP / 64); c.mode = 2; return c; } r -= IT_MI;
    { const int mat = l0 + r / PER_MO, q = r % PER_MO; c.W = F.w_mo + (size_t)mat * D * D; c.WT = F.WMO + (size_t)mat * D * D; c.K = D; c.N = D; c.kt = q / (D / 64); c.nt = q % (D / 64); c.mode = 0; return c; }
}
__device__ __forceinline__ void cvt_load(const CvtItem& c, int lane, f32x4 (&v)[16]) {
    const int a = lane & 15, kr = lane >> 4, nd = c.nt * 64 + 4 * a;
    int src = nd; bool valid = true;
    if (c.mode == 1) { const int w = nd & 255; src = ((w >> 7) ? DFF : 0) + (nd >> 8) * 128 + (w & 127); }
    if (c.mode == 2) valid = nd < NMIX;
    const float* wp = c.W + (size_t)(c.kt * 64 + 2 * kr) * c.N + src;
#pragma unroll
    for (int i = 0; i < 16; ++i) v[i] = valid ? *(const f32x4*)(wp + (size_t)(8 * (i >> 1) + (i & 1)) * c.N) : (f32x4){0.f, 0.f, 0.f, 0.f};
}
__device__ __forceinline__ void cvt_store(const CvtItem& c, int lane, const f32x4 (&v)[16], LAS unsigned char* T) {
    const int a = lane & 15, kr = lane >> 4;
#pragma unroll
    for (int p = 0; p < 8; ++p)
#pragma unroll
        for (int j = 0; j < 4; ++j) *(LAS unsigned*)(T + (4 * a + j) * 132 + 4 * (4 * p + kr)) = pg8::cvt_pk_bf16(v[2 * p][j], v[2 * p + 1][j]);
    const int nn = lane >> 3, ch = lane & 7;
    bf16* op = c.WT + (size_t)(c.nt * 64 + nn) * c.K + c.kt * 64 + 8 * ch;
#pragma unroll
    for (int r = 0; r < 8; ++r) { const LAS unsigned* tp = (const LAS unsigned*)(T + (nn + 8 * r) * 132 + 16 * ch);
        const v4u o = {tp[0], tp[1], tp[2], tp[3]};
        *(v4u*)(op + (size_t)(8 * r) * c.K) = o; }
}
__device__ __forceinline__ void p0_convert(Frame& F, int l0, int l1) {
    RELAUNDER(F);
    const int gw = F.wcu * NWAVES + F.wave, NGW = F.WG * NWAVES, nl = l1 - l0;
    const int total = nl * (2 * (NFF / 64) * (D / 64) + 2 * (D / 64) * (DFF / 64) + (NMIXP / 64) * (D / 64) + (D / 64) * (D / 64));
    LAS unsigned char* T = F.lds + RING_OFF + F.wave * 8448;
    f32x4 va[16], vb[16];
    int it = gw;
    if (it < total) { const CvtItem c = cvt_decode(F, it, l0, nl); cvt_load(c, F.lane, va); }
    while (it < total) {
        { const int nx = it + NGW; if (nx < total) { const CvtItem cn = cvt_decode(F, nx, l0, nl); cvt_load(cn, F.lane, vb); }
          const CvtItem c = cvt_decode(F, it, l0, nl); cvt_store(c, F.lane, va, T); it = nx; }
        if (it >= total) break;
        { const int nx = it + NGW; if (nx < total) { const CvtItem cn = cvt_decode(F, nx, l0, nl); cvt_load(cn, F.lane, va); }
          const CvtItem c = cvt_decode(F, it, l0, nl); cvt_store(c, F.lane, vb, T); it = nx; }
    }
}
__device__ __forceinline__ void p0_rope(Frame& F) {
    RELAUNDER(F);
    for (int e = (F.wcu * NWAVES + F.wave) * 64 + F.lane; e < F.nrows * 32; e += F.WG * NWAVES * 64) {
        const int m = F.row0 + (e >> 5), i = e & 31;
        double pw = 1.0; for (int k = 0; k < i; ++k) pw *= 0.7498942093324559;
        const float a = (float)F.pos[m] * (float)pw;
        const double ad = (double)a, k = rint(ad * 0.15915494309189535), r = fma(-k, 6.283185307179586, ad);
        const float rf = (float)r;
        F.ROPE[(size_t)m * 64 + i] = cosf(rf); F.ROPE[(size_t)m * 64 + 32 + i] = sinf(rf);
    }
}

__device__ __forceinline__ pg8::f32x4 mma16(bf16x8 x, bf16x8 y, pg8::f32x4 c) { return __builtin_amdgcn_mfma_f32_16x16x32_bf16(x, y, c, 0, 0, 0); }

__device__ __forceinline__ void gla_cumsum(Frame& F, LAS unsigned char* L, int l, size_t m0, int h, float (&bb)[16], float& off, float& tot) {
    const int dk = F.tid & 127, tq = F.wave >> 1;
    const float* w2 = F.gate_w2 + (size_t)l * 16 * 512 + h * 128 + dk;
    float wv[16];
#pragma unroll
    for (int r = 0; r < 16; ++r) wv[r] = w2[r * 512];
    const float bias = F.gate_b[(size_t)l * 512 + h * 128 + dk];
    LAS float* gl = (LAS float*)(L + G_GLR);
    if (F.tid < 256) *(LAS f32x4*)(gl + 4 * F.tid) = *(const f32x4*)(F.GLR + m0 * 16 + 4 * F.tid);
    __syncthreads();
    const LAS float* gr = gl + tq * 256;
    float run = 0.f;
#pragma unroll
    for (int i = 0; i < 16; ++i) {
        const f32x4 g0 = *(const LAS f32x4*)(gr + i * 16), g1 = *(const LAS f32x4*)(gr + i * 16 + 4), g2 = *(const LAS f32x4*)(gr + i * 16 + 8), g3 = *(const LAS f32x4*)(gr + i * 16 + 12);
        const float gg[16] = {g0.x, g0.y, g0.z, g0.w, g1.x, g1.y, g1.z, g1.w, g2.x, g2.y, g2.z, g2.w, g3.x, g3.y, g3.z, g3.w};
        float z = bias;
#pragma unroll
        for (int r = 0; r < 16; ++r) z += gg[r] * wv[r];
        const float ls = fminf(z, 0.f) - __logf(1.0f + __expf(-fabsf(z)));
        run += ls * 0.0625f; bb[i] = run; }
    LAS float* seg = (LAS float*)(L + G_SEG);
    seg[tq * 128 + dk] = bb[15];
    __syncthreads();
    off = 0.f; tot = 0.f;
#pragma unroll
    for (int q = 0; q < 4; ++q) { const float sg = seg[q * 128 + dk]; tot += sg; if (q < tq) off += sg; }
}
__device__ __forceinline__ void gla_stage_vt(Frame& F, LAS unsigned char* L, size_t m0, int h) {
    const int dv = F.tid & 255, th = F.tid >> 8; const bf16* vp = F.MIX + (m0 + th * 32) * MIXLD + C_VG + h * 256 + dv;
    unsigned pk[16];
#pragma unroll
    for (int i = 0; i < 16; ++i) pk[i] = (unsigned)vp[(size_t)(2 * i) * MIXLD] | ((unsigned)vp[(size_t)(2 * i + 1) * MIXLD] << 16);
    LAS v4u* dst = (LAS v4u*)(L + G_VT + dv * 144 + th * 64);
#pragma unroll
    for (int j = 0; j < 4; ++j) dst[j] = (v4u){pk[4 * j], pk[4 * j + 1], pk[4 * j + 2], pk[4 * j + 3]};
}
__device__ __forceinline__ void gla_g1(Frame& F, int l) {
    RELAUNDER(F);
    LAS unsigned char* L = F.lds + RING_OFF;
    const int r16 = F.lane & 15, q4 = F.lane >> 4, w = F.wave;
    for (int uu = F.wcu; uu < (F.nrows >> 6) * 4; uu += F.WG) {
        const int u = (F.row0 >> 6) * 4 + uu;
        const int c = u >> 2, h = u & 3; const size_t m0 = (size_t)c * 64;
        const int dk = F.tid & 127, tq = F.wave >> 1;
        gla_stage_vt(F, L, m0, h);
        float bb[16], off, tot;
        gla_cumsum(F, L, l, m0, h, bb, off, tot);
        { const bf16* kp = F.MIX + (m0 + tq * 16) * MIXLD + C_KG + h * 128 + dk;
          unsigned pk[8];
#pragma unroll
          for (int i = 0; i < 8; ++i) { const float b0 = bb[2 * i] + off, b1 = bb[2 * i + 1] + off;
              pk[i] = pg8::cvt_pk_bf16(bf1(kp[(size_t)(2 * i) * MIXLD]) * __expf(tot - b0), bf1(kp[(size_t)(2 * i + 1) * MIXLD]) * __expf(tot - b1)); }
          LAS v4u* dst = (LAS v4u*)(L + G_KT + dk * 144 + tq * 32);
          dst[0] = (v4u){pk[0], pk[1], pk[2], pk[3]}; dst[1] = (v4u){pk[4], pk[5], pk[6], pk[7]}; }
        if (tq == 0) F.DEC[(size_t)u * 128 + dk] = __expf(tot);
        __syncthreads();
        bf16x8 av[2][2];
#pragma unroll
        for (int rb = 0; rb < 2; ++rb)
#pragma unroll
            for (int ks = 0; ks < 2; ++ks) av[rb][ks] = *(const LAS bf16x8*)(L + G_VT + (32 * w + 16 * rb + r16) * 144 + (32 * ks + 8 * q4) * 2);
        bf16* dsb = F.DS + (size_t)u * 32768;
#pragma unroll
        for (int cb = 0; cb < 8; ++cb) {
            bf16x8 kv[2];
#pragma unroll
            for (int ks = 0; ks < 2; ++ks) kv[ks] = *(const LAS bf16x8*)(L + G_KT + (16 * cb + r16) * 144 + (32 * ks + 8 * q4) * 2);
#pragma unroll
            for (int rb = 0; rb < 2; ++rb) { pg8::f32x4 acc = {0.f, 0.f, 0.f, 0.f};
#pragma unroll
                for (int ks = 0; ks < 2; ++ks) acc = mma16(kv[ks], av[rb][ks], acc);
                v2u pkd; pkd.x = pg8::cvt_pk_bf16_c(acc[0], acc[1]); pkd.y = pg8::cvt_pk_bf16_c(acc[2], acc[3]);
                *(v2u*)(dsb + (size_t)(32 * w + 16 * rb + r16) * 128 + 16 * cb + 4 * q4) = pkd; }
        }
        __syncthreads();
    }
}
__device__ __forceinline__ void gla_scan(Frame& F) {
    RELAUNDER(F);
    for (int g0 = (F.wcu * NWAVES + F.wave) * 64 + F.lane; g0 < (F.nrows / SEQ) * 65536; g0 += F.WG * NWAVES * 64) {
        const int g = (F.row0 / SEQ) * 65536 + g0;
        const int dk2 = g & 63, dv = (g >> 6) & 255, h = (g >> 14) & 3, b = g >> 16;
        const size_t base = (((size_t)b * 128 * 4 + h) * 256 + dv) * 128 + 2 * dk2, nstr = (size_t)4 * 32768;
        const size_t dbase = ((size_t)b * 128 * 4 + h) * 128 + 2 * dk2, dstr = 4 * 128;
        float s0 = 0.f, s1 = 0.f;
#pragma unroll 1
        for (int n = 0; n < 128; n += 8) {
            v2f d[8], dc[8];
#pragma unroll
            for (int i = 0; i < 8; ++i) { const unsigned dw = *(const unsigned*)(F.DS + base + (size_t)(n + i) * nstr); d[i] = (v2f){bf_lo(dw), bf_hi(dw)}; dc[i] = *(const v2f*)(F.DEC + dbase + (size_t)(n + i) * dstr); }
#pragma unroll
            for (int i = 0; i < 8; ++i) { *(unsigned*)(F.ST + base + (size_t)(n + i) * nstr) = pg8::cvt_pk_bf16(s0, s1);
                s0 = dc[i].x * s0 + d[i].x; s1 = dc[i].y * s1 + d[i].y; }
        }
    }
}
__device__ __forceinline__ void gla_g3(Frame& F, int l) {
    RELAUNDER(F);
    LAS unsigned char* L = F.lds + RING_OFF;
    const int r16 = F.lane & 15, q4 = F.lane >> 4, w = F.wave;
    for (int uu = F.wcu; uu < (F.nrows >> 6) * 4; uu += F.WG) {
        const int u = (F.row0 >> 6) * 4 + uu;
        const int c = u >> 2, h = u & 3; const size_t m0 = (size_t)c * 64;
        const bf16* stb = F.ST + (size_t)u * 32768;
        bf16x8 sf[2][4];
#pragma unroll
        for (int rb = 0; rb < 2; ++rb)
#pragma unroll
            for (int ks = 0; ks < 4; ++ks) sf[rb][ks] = *(const bf16x8*)(stb + (size_t)(32 * w + 16 * rb + r16) * 128 + 32 * ks + 8 * q4);
        gla_stage_vt(F, L, m0, h);
        { float bb[16], off, tot;
          gla_cumsum(F, L, l, m0, h, bb, off, tot);
          const int dk = F.tid & 127, tq = F.wave >> 1; (void)tot;
          LAS float* B = (LAS float*)(L + G3_B);
#pragma unroll
          for (int i = 0; i < 16; ++i) B[(tq * 16 + i) * 128 + dk] = bb[i] + off; }
        __syncthreads();
        { const int t = F.tid >> 3, d0 = (F.tid & 7) * 16; const size_t m = m0 + t;
          const LAS float* bp = (const LAS float*)(L + G3_B) + t * 128 + d0;
          const v4u q0 = *(const v4u*)(F.MIX + m * MIXLD + C_QG + h * 128 + d0), q1 = *(const v4u*)(F.MIX + m * MIXLD + C_QG + h * 128 + d0 + 8);
          const v4u k0 = *(const v4u*)(F.MIX + m * MIXLD + C_KG + h * 128 + d0), k1 = *(const v4u*)(F.MIX + m * MIXLD + C_KG + h * 128 + d0 + 8);
          const unsigned qw[8] = {q0.x, q0.y, q0.z, q0.w, q1.x, q1.y, q1.z, q1.w}, kw[8] = {k0.x, k0.y, k0.z, k0.w, k1.x, k1.y, k1.z, k1.w};
          unsigned qo[8], ko[8];
#pragma unroll
          for (int j = 0; j < 4; ++j) { const f32x4 bv = *(const LAS f32x4*)(bp + 4 * j);
              const float e0 = __expf(bv.x), e1 = __expf(bv.y), e2 = __expf(bv.z), e3 = __expf(bv.w), n0 = __expf(-bv.x), n1 = __expf(-bv.y), n2 = __expf(-bv.z), n3 = __expf(-bv.w);
              qo[2 * j] = pg8::cvt_pk_bf16(bf_lo(qw[2 * j]) * 0.08838834764831845f * e0, bf_hi(qw[2 * j]) * 0.08838834764831845f * e1);
              qo[2 * j + 1] = pg8::cvt_pk_bf16(bf_lo(qw[2 * j + 1]) * 0.08838834764831845f * e2, bf_hi(qw[2 * j + 1]) * 0.08838834764831845f * e3);
              ko[2 * j] = pg8::cvt_pk_bf16(bf_lo(kw[2 * j]) * n0, bf_hi(kw[2 * j]) * n1);
              ko[2 * j + 1] = pg8::cvt_pk_bf16(bf_lo(kw[2 * j + 1]) * n2, bf_hi(kw[2 * j + 1]) * n3); }
          LAS v4u* qd = (LAS v4u*)(L + G3_QD + t * 272 + d0 * 2); LAS v4u* kd = (LAS v4u*)(L + G3_KD + t * 272 + d0 * 2);
          qd[0] = (v4u){qo[0], qo[1], qo[2], qo[3]}; qd[1] = (v4u){qo[4], qo[5], qo[6], qo[7]};
          kd[0] = (v4u){ko[0], ko[1], ko[2], ko[3]}; kd[1] = (v4u){ko[4], ko[5], ko[6], ko[7]}; }
        __syncthreads();
#pragma unroll
        for (int j = 0; j < 2; ++j) {
            const int id = 2 * w + j, tr = id >> 2, sc = id & 3;
            pg8::f32x4 acc = {0.f, 0.f, 0.f, 0.f};
            if (sc <= tr) {
#pragma unroll
                for (int ks = 0; ks < 4; ++ks) acc = mma16(*(const LAS bf16x8*)(L + G3_KD + (16 * sc + r16) * 272 + (32 * ks + 8 * q4) * 2),
                                                           *(const LAS bf16x8*)(L + G3_QD + (16 * tr + r16) * 272 + (32 * ks + 8 * q4) * 2), acc);
                const int t = 16 * tr + r16, s0 = 16 * sc + 4 * q4;
#pragma unroll
                for (int i = 0; i < 4; ++i) if (s0 + i > t) acc[i] = 0.f;
            }
            v2u pk; pk.x = pg8::cvt_pk_bf16(acc[0], acc[1]); pk.y = pg8::cvt_pk_bf16(acc[2], acc[3]);
            *(LAS v2u*)(L + G3_IN + (16 * tr + r16) * 144 + (16 * sc + 4 * q4) * 2) = pk;
        }
        __syncthreads();
        bf16x8 vf[2][2];
#pragma unroll
        for (int rb = 0; rb < 2; ++rb)
#pragma unroll
            for (int ks = 0; ks < 2; ++ks) vf[rb][ks] = *(const LAS bf16x8*)(L + G_VT + (32 * w + 16 * rb + r16) * 144 + (32 * ks + 8 * q4) * 2);
        pg8::f32x4 o[2][4]; float ss[4];
#pragma unroll
        for (int cb = 0; cb < 4; ++cb) {
            bf16x8 qf[4], nf[2];
#pragma unroll
            for (int ks = 0; ks < 4; ++ks) qf[ks] = *(const LAS bf16x8*)(L + G3_QD + (16 * cb + r16) * 272 + (32 * ks + 8 * q4) * 2);
#pragma unroll
            for (int ks = 0; ks < 2; ++ks) nf[ks] = *(const LAS bf16x8*)(L + G3_IN + (16 * cb + r16) * 144 + (32 * ks + 8 * q4) * 2);
            float sq = 0.f;
#pragma unroll
            for (int rb = 0; rb < 2; ++rb) { pg8::f32x4 acc = {0.f, 0.f, 0.f, 0.f};
#pragma unroll
                for (int ks = 0; ks < 4; ++ks) acc = mma16(sf[rb][ks], qf[ks], acc);
#pragma unroll
                for (int ks = 0; ks < 2; ++ks) acc = mma16(vf[rb][ks], nf[ks], acc);
                o[rb][cb] = acc; sq += (acc[0] * acc[0] + acc[1] * acc[1]) + (acc[2] * acc[2] + acc[3] * acc[3]); }
            sq += __shfl_xor(sq, 16); sq += __shfl_xor(sq, 32);
            ss[cb] = sq;
        }
        LAS float* SS = (LAS float*)(L + G3_SS);
        if (q4 == 0) {
#pragma unroll
            for (int cb = 0; cb < 4; ++cb) SS[w * 64 + 16 * cb + r16] = ss[cb]; }
        __syncthreads();
#pragma unroll
        for (int cb = 0; cb < 4; ++cb) {
            float tot = 0.f;
#pragma unroll
            for (int ww = 0; ww < 8; ++ww) tot += SS[ww * 64 + 16 * cb + r16];
            const float rs = 1.0f / sqrtf(tot * (1.0f / 256.0f) + NORM_EPS);
            const size_t m = m0 + 16 * cb + r16;
#pragma unroll
            for (int rb = 0; rb < 2; ++rb) { const int dv = 32 * w + 16 * rb + 4 * q4;
                const f32x4 gv = *(const f32x4*)(F.gla_gain + (size_t)l * 256 + dv);
                const v2u rr = *(const v2u*)(F.MIX + m * MIXLD + C_RG + h * 256 + dv);
                const float r[4] = {bf_lo(rr.x), bf_hi(rr.x), bf_lo(rr.y), bf_hi(rr.y)};
                float y[4];
#pragma unroll
                for (int e = 0; e < 4; ++e) y[e] = ((o[rb][cb][e] * rs) * gv[e]) * (r[e] / (1.0f + expf(-r[e])));
                v2u wv; wv.x = pg8::cvt_pk_bf16(y[0], y[1]); wv.y = pg8::cvt_pk_bf16(y[2], y[3]);
                *(v2u*)(F.MO + m * D + 1024 + h * 256 + dv) = wv; }
        }
        __syncthreads();
    }
}


__device__ __forceinline__ void attn_mfma(Frame& F, int l) {
    RELAUNDER(F);
    LAS unsigned char* L = F.lds + RING_OFF;
    const int r16 = F.lane & 15, q4 = F.lane >> 4, w = F.wave, g = w >> 1, qh = w & 1;
    for (int uu = F.wcu; uu < (F.nrows >> 7) * 4; uu += F.WG) {
        const int u = (F.row0 >> 7) * 4 + uu;
        const int h = u & 3, nb = u >> 2, n = nb & 63;
        const size_t mq0 = (size_t)nb * 128;
        { const int key = F.tid >> 1, hf = F.tid & 1; const bool ok = (n > 0) || key >= 128;
          const size_t mk = ok ? mq0 + key - 128 : mq0;
          const bf16* kp = F.MIX + mk * MIXLD + C_KA + h * 64 + hf * 16; const float* cs = F.ROPE + mk * 64 + hf * 16;
          v4u lo[2], hi[2]; f32x4 cc[4], sn[4];
#pragma unroll
          for (int j = 0; j < 2; ++j) { lo[j] = *(const v4u*)(kp + 8 * j); hi[j] = *(const v4u*)(kp + 32 + 8 * j); }
#pragma unroll
          for (int j = 0; j < 4; ++j) { cc[j] = *(const f32x4*)(cs + 4 * j); sn[j] = *(const f32x4*)(cs + 32 + 4 * j); }
          v4u o1[2], o2[2];
#pragma unroll
          for (int j = 0; j < 2; ++j) {
              const unsigned lw[4] = {lo[j].x, lo[j].y, lo[j].z, lo[j].w}, hw[4] = {hi[j].x, hi[j].y, hi[j].z, hi[j].w}; unsigned a1[4], a2[4];
#pragma unroll
              for (int e = 0; e < 4; ++e) { const f32x4 c4 = cc[2 * j + (e >> 1)], s4 = sn[2 * j + (e >> 1)];
                  const float ca = (e & 1) ? c4.z : c4.x, cb2 = (e & 1) ? c4.w : c4.y, sa = (e & 1) ? s4.z : s4.x, sb = (e & 1) ? s4.w : s4.y;
                  const float x1a = bf_lo(lw[e]), x1b = bf_hi(lw[e]), x2a = bf_lo(hw[e]), x2b = bf_hi(hw[e]);
                  a1[e] = pg8::cvt_pk_bf16(x1a * ca - x2a * sa, x1b * cb2 - x2b * sb); a2[e] = pg8::cvt_pk_bf16(x2a * ca + x1a * sa, x2b * cb2 + x1b * sb); }
              o1[j] = ok ? (v4u){a1[0], a1[1], a1[2], a1[3]} : (v4u){0u, 0u, 0u, 0u}; o2[j] = ok ? (v4u){a2[0], a2[1], a2[2], a2[3]} : (v4u){0u, 0u, 0u, 0u}; }
          LAS v4u* d1 = (LAS v4u*)(L + A_KS + key * 144 + hf * 32); LAS v4u* d2 = (LAS v4u*)(L + A_KS + key * 144 + 64 + hf * 32);
          d1[0] = o1[0]; d1[1] = o1[1]; d2[0] = o2[0]; d2[1] = o2[1]; }
        { const int d = F.tid & 63, kg = F.tid >> 6; const bool ok = (n > 0) || kg >= 4;
          const bf16* vp = F.MIX + (ok ? mq0 + kg * 32 - 128 : mq0) * MIXLD + C_VA + h * 64 + d;
          unsigned pk[16];
#pragma unroll
          for (int i = 0; i < 16; ++i) pk[i] = ok ? ((unsigned)vp[(size_t)(2 * i) * MIXLD] | ((unsigned)vp[(size_t)(2 * i + 1) * MIXLD] << 16)) : 0u;
          LAS v4u* dst = (LAS v4u*)(L + A_VT + d * 528 + kg * 64);
#pragma unroll
          for (int j = 0; j < 4; ++j) dst[j] = (v4u){pk[4 * j], pk[4 * j + 1], pk[4 * j + 2], pk[4 * j + 3]}; }
        __syncthreads();
        const int hq = h * 4 + g;
        bf16x8 qf[4][2];
#pragma unroll
        for (int cb = 0; cb < 4; ++cb) {
            const size_t mq = mq0 + 64 * qh + 16 * cb + r16;
            const bf16* qp = F.MIX + mq * MIXLD + C_QA + hq * 64 + 8 * q4; const float* cs = F.ROPE + mq * 64 + 8 * q4;
            const v4u lo = *(const v4u*)qp, hi = *(const v4u*)(qp + 32);
            const f32x4 c0 = *(const f32x4*)cs, c1 = *(const f32x4*)(cs + 4), s0 = *(const f32x4*)(cs + 32), s1 = *(const f32x4*)(cs + 36);
            const unsigned lw[4] = {lo.x, lo.y, lo.z, lo.w}, hw[4] = {hi.x, hi.y, hi.z, hi.w};
            const float cc[8] = {c0.x, c0.y, c0.z, c0.w, c1.x, c1.y, c1.z, c1.w}, sn[8] = {s0.x, s0.y, s0.z, s0.w, s1.x, s1.y, s1.z, s1.w};
            unsigned a1[4], a2[4];
#pragma unroll
            for (int e = 0; e < 4; ++e) { const float x1a = bf_lo(lw[e]), x1b = bf_hi(lw[e]), x2a = bf_lo(hw[e]), x2b = bf_hi(hw[e]);
                a1[e] = pg8::cvt_pk_bf16((x1a * cc[2 * e] - x2a * sn[2 * e]) * 0.125f, (x1b * cc[2 * e + 1] - x2b * sn[2 * e + 1]) * 0.125f);
                a2[e] = pg8::cvt_pk_bf16((x2a * cc[2 * e] + x1a * sn[2 * e]) * 0.125f, (x2b * cc[2 * e + 1] + x1b * sn[2 * e + 1]) * 0.125f); }
            const v4u w1 = {a1[0], a1[1], a1[2], a1[3]}, w2 = {a2[0], a2[1], a2[2], a2[3]};
            qf[cb][0] = __builtin_bit_cast(bf16x8, w1); qf[cb][1] = __builtin_bit_cast(bf16x8, w2); }
        const float sink = F.sinks[l * 16 + hq];
#pragma unroll 1
        for (int cb = 0; cb < 4; ++cb) {
            pg8::f32x4 s[12];
#pragma unroll
            for (int kt = 0; kt < 12; ++kt) { pg8::f32x4 acc = {0.f, 0.f, 0.f, 0.f};
#pragma unroll
                for (int ks = 0; ks < 2; ++ks) acc = mma16(*(const LAS bf16x8*)(L + A_KS + (64 * qh + 16 * kt + r16) * 144 + (32 * ks + 8 * q4) * 2), cb == 0 ? qf[0][ks] : cb == 1 ? qf[1][ks] : cb == 2 ? qf[2][ks] : qf[3][ks], acc);
                s[kt] = acc; }
            const int qpos = 64 * qh + 16 * cb + r16;
            float mx = sink;
#pragma unroll
            for (int kt = 0; kt < 12; ++kt)
#pragma unroll
                for (int i = 0; i < 4; ++i) { const int kpos = 64 * qh - 128 + 16 * kt + 4 * q4 + i;
                    const bool valid = (kpos <= qpos) && (kpos > qpos - 128) && (n > 0 || kpos >= 0);
                    s[kt][i] = valid ? s[kt][i] : -INFINITY; mx = fmaxf(mx, s[kt][i]); }
            mx = fmaxf(mx, __shfl_xor(mx, 16)); mx = fmaxf(mx, __shfl_xor(mx, 32));
            float sum = 0.f;
#pragma unroll
            for (int kt = 0; kt < 12; ++kt)
#pragma unroll
                for (int i = 0; i < 4; ++i) { s[kt][i] = expf(s[kt][i] - mx); sum += s[kt][i]; }
            sum += __shfl_xor(sum, 16); sum += __shfl_xor(sum, 32);
            sum += expf(sink - mx);
            pg8::f32x4 o[4];
#pragma unroll
            for (int rb = 0; rb < 4; ++rb) o[rb] = (pg8::f32x4){0.f, 0.f, 0.f, 0.f};
#pragma unroll
            for (int kk = 0; kk < 6; ++kk) {
                v4u pw; pw.x = pg8::cvt_pk_bf16(s[2 * kk][0], s[2 * kk][1]); pw.y = pg8::cvt_pk_bf16(s[2 * kk][2], s[2 * kk][3]);
                pw.z = pg8::cvt_pk_bf16(s[2 * kk + 1][0], s[2 * kk + 1][1]); pw.w = pg8::cvt_pk_bf16(s[2 * kk + 1][2], s[2 * kk + 1][3]);
                const bf16x8 pf = __builtin_bit_cast(bf16x8, pw);
#pragma unroll
                for (int rb = 0; rb < 4; ++rb) {
                    const v2u lo = *(const LAS v2u*)(L + A_VT + (16 * rb + r16) * 528 + (64 * qh + 32 * kk + 4 * q4) * 2);
                    const v2u hi = *(const LAS v2u*)(L + A_VT + (16 * rb + r16) * 528 + (64 * qh + 32 * kk + 16 + 4 * q4) * 2);
                    const v4u vw = {lo.x, lo.y, hi.x, hi.y};
                    o[rb] = mma16(__builtin_bit_cast(bf16x8, vw), pf, o[rb]); }
            }
            const float inv = 1.0f / sum;
            bf16* op = F.MO + (mq0 + qpos) * D + hq * 64 + 4 * q4;
#pragma unroll
            for (int rb = 0; rb < 4; ++rb) { v2u wv; wv.x = pg8::cvt_pk_bf16(o[rb][0] * inv, o[rb][1] * inv); wv.y = pg8::cvt_pk_bf16(o[rb][2] * inv, o[rb][3] * inv);
                *(v2u*)(op + 16 * rb) = wv; }
        }
        __syncthreads();
    }
}

struct Args { const void* in[11]; float* out; unsigned char* ws; };
__global__ void __launch_bounds__(NWAVES * 64, 2) fwd(Args args) {
    extern __shared__ __attribute__((aligned(16))) unsigned char lds[];
    Frame F;
    F.lds = (LAS unsigned char*)lds;
    F.MISC = (volatile LAS unsigned*)(F.lds + MISC_OFF);
    F.tid = threadIdx.x; F.lane = F.tid & 63; F.wave = __builtin_amdgcn_readfirstlane(F.tid >> 6);
    F.G = gridDim.x; const int bx = blockIdx.x; F.vcu = (F.G % 8 == 0) ? (bx % 8) * (F.G / 8) + bx / 8 : bx;
    const int NLAB = (F.G % 8 == 0 && M % (8 * 256) == 0) ? 8 : 1, lab = bx % NLAB, wl = bx / NLAB, LW = F.G / NLAB;
    unsigned char* ws = args.ws;
    F.ctl = (gu32*)(ws + WS_CTL);
    RELAUNDER(F);
    for (int u = F.tid; u < (LDS_BYTES - LDSCTL_OFF) / 4; u += NWAVES * 64) ((LAS unsigned*)(F.lds + LDSCTL_OFF))[u] = 0u;
    __syncthreads();
    XcdBarrier bar_all = xcd_barrier_post((unsigned*)(F.ctl + CW_BAR), F.MISC + 8, (unsigned)F.G);
    XcdBarrier bar_lab = xcd_barrier_post((unsigned*)(F.ctl + CW_BAR + (1 + lab) * XCD_BAR_WORDS), F.MISC + 10, (unsigned)LW);
#define GRID_BAR_OF(B) do { XcdBarrier b_ = (B); GAS unsigned* gb_ = (GAS unsigned*)(B).bar; asm volatile("" : "+s"(gb_), "+s"(b_.x)); b_.bar = (unsigned*)gb_; xcd_barrier(b_); } while (0)
#define GRID_BAR() GRID_BAR_OF(bar_all)
#define LAB_BAR() GRID_BAR_OF(bar_lab)
#define GEO_ALL() do { F.wcu = F.vcu; F.WG = F.G; F.row0 = 0; F.nrows = M; } while (0)
#define GEO_LAB() do { F.wcu = wl; F.WG = LW; F.row0 = lab * (M / NLAB); F.nrows = M / NLAB; } while (0)
    F.gc = bx; F.nxl = 8;

    GEO_ALL();
    p0_convert(F, 0, DEPTH);
    p0_rope(F);
    norm_phase<true>(F, 0, 0, 0, 0.f, true);
    GRID_BAR();

#pragma unroll 1
    for (int l = 0; l < DEPTH; ++l) {
        RELAUNDER(F);
        { pg8::Gemm gm{F.XN, F.WFI + (size_t)(2 * l) * NFF * D, M, NFF, D}; pg8::StaticOrder S; S.init(M, NFF, F.G, F.gc, F.nxl);
          pg8::EpiSwiGLU E{F.ACT, DFF};
          pg8::gemm_phase<pg8::EpiSwiGLU, pg8::StaticOrder, true, true>(F.lds + RING_OFF, gm, S, E); }
        LAB_BAR();
        RELAUNDER(F);
        { pg8::Gemm gm{F.ACT, F.WFO + (size_t)(2 * l) * D * DFF, M, D, DFF}; pg8::StaticOrder S; S.init(M, D, F.G, F.gc, F.nxl);
          pg8::EpiPlain E{F.H, D};
          pg8::gemm_phase<pg8::EpiPlain, pg8::StaticOrder, true, true>(F.lds + RING_OFF, gm, S, E); }
        LAB_BAR();
        GEO_LAB();
        norm_phase<false>(F, 3 * l + 0, l * 6 + 1, l * 6 + 2, 0.5f, true);
        LAB_BAR();
        RELAUNDER(F);
        { pg8::Gemm gm{F.XN, F.WMI + (size_t)l * NMIXP * D, M, NMIXP, D}; pg8::StaticOrder S; S.init(M, NMIXP, F.G, F.gc, F.nxl);
          pg8::EpiMix E{F.MIX, MIXLD, F.GLR, MIXLD / 256};
          pg8::gemm_phase<pg8::EpiMix, pg8::StaticOrder, true, true>(F.lds + RING_OFF, gm, S, E); }
        GRID_BAR();
        GEO_LAB();
        gla_g1(F, l);
        attn_mfma(F, l);
        GRID_BAR();
        GEO_ALL();
        gla_scan(F);
        GRID_BAR();
        GEO_LAB();
        gla_g3(F, l);
        LAB_BAR();
        RELAUNDER(F);
        { pg8::Gemm gm{F.MO, F.WMO + (size_t)l * D * D, M, D, D}; pg8::StaticOrder S; S.init(M, D, F.G, F.gc, F.nxl);
          pg8::EpiPlain E{F.H, D};
          pg8::gemm_phase<pg8::EpiPlain, pg8::StaticOrder, true, true>(F.lds + RING_OFF, gm, S, E); }
        LAB_BAR();
        GEO_LAB();
        norm_phase<false>(F, 3 * l + 1, l * 6 + 3, l * 6 + 4, 1.0f, true);
        LAB_BAR();
        RELAUNDER(F);
        { pg8::Gemm gm{F.XN, F.WFI + (size_t)(2 * l + 1) * NFF * D, M, NFF, D}; pg8::StaticOrder S; S.init(M, NFF, F.G, F.gc, F.nxl);
          pg8::EpiSwiGLU E{F.ACT, DFF};
          pg8::gemm_phase<pg8::EpiSwiGLU, pg8::StaticOrder, true, true>(F.lds + RING_OFF, gm, S, E); }
        LAB_BAR();
        RELAUNDER(F);
        { pg8::Gemm gm{F.ACT, F.WFO + (size_t)(2 * l + 1) * D * DFF, M, D, DFF}; pg8::StaticOrder S; S.init(M, D, F.G, F.gc, F.nxl);
          pg8::EpiPlain E{F.H, D};
          pg8::gemm_phase<pg8::EpiPlain, pg8::StaticOrder, true, true>(F.lds + RING_OFF, gm, S, E); }
        LAB_BAR();
        GEO_LAB();
        norm_phase<false>(F, 3 * l + 2, l * 6 + 5, l * 6 + 6  , 0.5f, l + 1 < DEPTH);
        if (l + 1 < DEPTH) LAB_BAR();
    }
}

extern "C" void kernel_launch(void* const* d_in, const int* in_sizes, int n_in, void* d_out, int out_size, void* d_ws, size_t ws_size, hipStream_t stream) {
    static int grid = 0;
    if (grid == 0) {
        if (n_in != 11 || in_sizes[0] != M * D || out_size != M * D || ws_size < WS_END) { fprintf(stderr, "kernel_launch: unexpected shapes (n_in %d, in0 %d, out %d, ws %zu < %zu); nothing launched\n", n_in, n_in > 0 ? in_sizes[0] : -1, out_size, ws_size, (size_t)WS_END); grid = -1; return; }
        int dev = 0, cus = 0, per_cu = 0;
        if (hipGetDevice(&dev) != hipSuccess || hipDeviceGetAttribute(&cus, hipDeviceAttributeMultiprocessorCount, dev) != hipSuccess) { fprintf(stderr, "kernel_launch: device query failed\n"); grid = -1; return; }
        if (hipFuncSetAttribute((const void*)fwd, hipFuncAttributeMaxDynamicSharedMemorySize, LDS_BYTES) != hipSuccess) { fprintf(stderr, "kernel_launch: hipFuncSetAttribute failed\n"); grid = -1; return; }
        if (hipOccupancyMaxActiveBlocksPerMultiprocessor(&per_cu, (const void*)fwd, NWAVES * 64, LDS_BYTES) != hipSuccess || per_cu < 1) { fprintf(stderr, "kernel_launch: occupancy query reports %d workgroups per CU\n", per_cu); }
        (void)hipGetLastError();
        grid = cus;
    }
    if (grid < 0) return;
    if (hipMemsetAsync((char*)d_ws + WS_CTL, 0, CTL_ZERO_BYTES, stream) != hipSuccess) { fprintf(stderr, "kernel_launch: memset failed\n"); return; }
    Args a{};
    for (int i = 0; i < 11; ++i) a.in[i] = d_in[i];
    a.out = (float*)d_out; a.ws = (unsigned char*)d_ws;
    hipLaunchKernelGGL(fwd, dim3(grid), dim3(NWAVES * 64), LDS_BYTES, stream, a);
    const hipError_t le = hipPeekAtLastError();
    if (le != hipSuccess) fprintf(stderr, "kernel_launch: launch failed: %s\n", hipGetErrorName(le));
}
```

```cpp
#include <hip/hip_runtime.h>
#include <cstdio>
#include <cstdint>
#include <cmath>
namespace pg8 {
#define PG8_LAS __attribute__((address_space(3)))
typedef unsigned short bf16_t;
typedef short bf16x8 __attribute__((ext_vector_type(8)));
typedef float f32x4 __attribute__((ext_vector_type(4)));
typedef unsigned u32x4 __attribute__((ext_vector_type(4)));
constexpr int BM = 256, BK = 64, HALF = 128, HTB = HALF * BK * 2  , STAGE_BYTES = 8 * HTB, NXCD = 8, WGM = 8;

__host__ __device__ __forceinline__ int lds_byte(int r, int c) { const int st = (r >> 4) * 2 + (c >> 5), rr = r & 15, cc = c & 31, ob = rr * 64 + cc * 2; return st * 1024 + (ob ^ (((ob >> 9) & 1) << 5)); }
__host__ __device__ __forceinline__ void stage_rc(int b, int& R, int& C) { const int st = b / 1024, sb = b % 1024, swz = sb ^ (((sb >> 9) & 1) << 5); R = (st >> 1) * 16 + swz / 64; C = (st & 1) * 32 + (swz % 64) / 2; }
__host__ __device__ __forceinline__ int perm32(int rho) { const int n = rho >> 4, i = rho & 15; return 8 * (i >> 2) + 4 * n + (i & 3); }

struct Unit { int pm, pn; };
struct Gemm { const bf16_t* A; const bf16_t* Bt; int M, N, K; };

struct StaticOrder {
    int nM, nN, nwg, G, c, nx;
    __host__ __device__ void init(int M, int N, int G_, int c_, int nx_ = NXCD) { nM = M / BM; nN = N / BM; nwg = nM * nN; G = G_; c = c_; nx = nx_; }
    __host__ __device__ bool next(int i, Unit& u) const {
        const long L = (long)i * G + c; if (L >= nwg) return false;
        int wgid = (int)L; { const int q = nwg / nx, r = nwg % nx, xcd = wgid % nx, off = wgid / nx; wgid = (xcd < r ? xcd * (q + 1) : r * (q + 1) + (xcd - r) * q) + off; }
        const int nig = WGM * nN, gid = wgid / nig, fm = gid * WGM, gsz = (nM - fm) < WGM ? (nM - fm) : WGM;
        u.pm = fm + ((wgid % nig) % gsz); u.pn = (wgid % nig) / gsz; return true;
    }
    __device__ __forceinline__ void a_ready(const Unit&) const {}
    __device__ __forceinline__ void done(const Unit&) const {}
};

__device__ __forceinline__ unsigned cvt_pk_bf16(float lo, float hi) { unsigned r; asm volatile("v_cvt_pk_bf16_f32 %0, %1, %2" : "=v"(r) : "v"(lo), "v"(hi)); return r; }
typedef float cvt_f32x2 __attribute__((ext_vector_type(2)));
typedef __bf16 cvt_bf16x2 __attribute__((ext_vector_type(2)));
__device__ __forceinline__ unsigned cvt_pk_bf16_c(float lo, float hi) { const cvt_f32x2 v = {lo, hi}; return __builtin_bit_cast(unsigned, __builtin_convertvector(v, cvt_bf16x2)); }
typedef float f32x2 __attribute__((ext_vector_type(2)));

__device__ __forceinline__ float silu_f(float g) { return g * __builtin_amdgcn_rcpf(1.0f + __builtin_amdgcn_exp2f(-1.4426950408889634f * g)); }
struct EpiSwiGLU {
    static constexpr bool PERM = true, AFTER_DRAIN = false;
    bf16_t* O; int ldc;
    __device__ __forceinline__ void operator()(const f32x4 (&acc)[2][2][4][2], const Unit& u, int wr, int wc, int fr, int fq) const {
        const int row0 = u.pm * BM + wr * 64 + fr, col0 = u.pn * HALF + wc * 32 + 8 * fq;
#pragma unroll
        for (int ai = 0; ai < 2; ++ai)
#pragma unroll
            for (int m = 0; m < 4; ++m) { bf16_t* rowp = O + (size_t)(row0 + ai * HALF + m * 16) * ldc + col0;
                const f32x4 g0 = acc[ai][0][m][0], g1 = acc[ai][0][m][1], u0 = acc[ai][1][m][0], u1 = acc[ai][1][m][1];
                u32x4 w; w.x = cvt_pk_bf16(silu_f(g0[0]) * u0[0], silu_f(g0[1]) * u0[1]); w.y = cvt_pk_bf16(silu_f(g0[2]) * u0[2], silu_f(g0[3]) * u0[3]);
                w.z = cvt_pk_bf16(silu_f(g1[0]) * u1[0], silu_f(g1[1]) * u1[1]); w.w = cvt_pk_bf16(silu_f(g1[2]) * u1[2], silu_f(g1[3]) * u1[3]);
                *(u32x4*)rowp = w; }
    }
};
struct EpiPlain {
    static constexpr bool PERM = true, AFTER_DRAIN = false;
    bf16_t* O; int ldc;
    __device__ __forceinline__ void operator()(const f32x4 (&acc)[2][2][4][2], const Unit& u, int wr, int wc, int fr, int fq) const {
        const int row0 = u.pm * BM + wr * 64 + fr, col0 = u.pn * BM + wc * 32 + 8 * fq;
#pragma unroll
        for (int ai = 0; ai < 2; ++ai)
#pragma unroll
            for (int m = 0; m < 4; ++m) { bf16_t* rowp = O + (size_t)(row0 + ai * HALF + m * 16) * ldc + col0;
#pragma unroll
                for (int bj = 0; bj < 2; ++bj) { const f32x4 v0 = acc[ai][bj][m][0], v1 = acc[ai][bj][m][1];
                    u32x4 w; w.x = cvt_pk_bf16(v0[0], v0[1]); w.y = cvt_pk_bf16(v0[2], v0[3]); w.z = cvt_pk_bf16(v1[0], v1[1]); w.w = cvt_pk_bf16(v1[2], v1[3]);
                    *(u32x4*)(rowp + bj * HALF) = w; } }
    }
};
struct EpiMix {
    static constexpr bool PERM = true, AFTER_DRAIN = false;
    bf16_t* O; int ldc; float* G; int npl;
    __device__ __forceinline__ void operator()(const f32x4 (&acc)[2][2][4][2], const Unit& u, int wr, int wc, int fr, int fq) const {
        const int row0 = u.pm * BM + wr * 64 + fr;
        if (u.pn < npl) {
            const int col0 = u.pn * BM + wc * 32 + 8 * fq;
#pragma unroll
            for (int ai = 0; ai < 2; ++ai)
#pragma unroll
                for (int m = 0; m < 4; ++m) { bf16_t* rowp = O + (size_t)(row0 + ai * HALF + m * 16) * ldc + col0;
#pragma unroll
                    for (int bj = 0; bj < 2; ++bj) { const f32x4 v0 = acc[ai][bj][m][0], v1 = acc[ai][bj][m][1];
                        u32x4 w; w.x = cvt_pk_bf16(v0[0], v0[1]); w.y = cvt_pk_bf16(v0[2], v0[3]); w.z = cvt_pk_bf16(v1[0], v1[1]); w.w = cvt_pk_bf16(v1[2], v1[3]);
                        *(u32x4*)(rowp + bj * HALF) = w; } }
        } else if (wc == 0 && fq < 2) {
#pragma unroll
            for (int ai = 0; ai < 2; ++ai)
#pragma unroll
                for (int m = 0; m < 4; ++m) { float* rowp = G + (size_t)(row0 + ai * HALF + m * 16) * 16 + 8 * fq;
                    *(f32x4*)rowp = acc[ai][0][m][0]; *(f32x4*)(rowp + 4) = acc[ai][0][m][1]; }
        }
    }
};
template <class Epi, class Sched, bool ALIGN_EPI = false, bool SP2 = false>
__device__ __forceinline__ void gemm_phase(PG8_LAS unsigned char* lds, const Gemm g, const Sched& S, const Epi& E) {
    int tid_ = threadIdx.x; asm volatile("" : "+v"(tid_));
    const int tid = tid_, wid = __builtin_amdgcn_readfirstlane(tid >> 6), lane = tid & 63, wr = wid >> 2, wc = wid & 3, fr = lane & 15, fq = lane >> 4;
    int K_ = g.K; asm volatile("" : "+s"(K_));
    const int K = K_, nt = K / BK;
    unsigned voffA[2], voffB[2];
#pragma unroll
    for (int i = 0; i < 2; ++i) { int R, C; stage_rc(tid * 16 + i * 8192, R, C); const int Rb = Epi::PERM ? ((R & ~31) + perm32(R & 31)) : R;
        voffA[i] = (unsigned)(R * K + C) * 2u; voffB[i] = (unsigned)(Rb * K + C) * 2u; }
    const size_t kstep = (size_t)(BK * 2);
    const size_t hstep = (size_t)HALF * K * 2;
    const size_t tstep = 2 * hstep;
    const unsigned ldsw = (unsigned)wid * 1024u;
    const int aoff = lds_byte(wr * 64 + fr, fq * 8), boff = lds_byte(wc * 32 + fr, fq * 8);
#define PG8_SA(b, h) (((b) * 2 + (h)) * HTB)
#define PG8_SB(b, h) ((4 + (b) * 2 + (h)) * HTB)
#define PG8_STAGE(bufoff, gbase, voff) do { _Pragma("unroll") for (int _i = 0; _i < 2; ++_i) \
        __builtin_amdgcn_global_load_lds((const unsigned*)((const char*)(gbase) + (voff)[_i]), (PG8_LAS unsigned*)(lds + (bufoff) + ldsw + _i * 8192), 16, 0, 0); } while (0)
#define PG8_LDA(dst, b, h) do { _Pragma("unroll") for (int m = 0; m < 4; ++m) _Pragma("unroll") for (int k = 0; k < 2; ++k) dst[m][k] = *(const PG8_LAS bf16x8*)(lds + PG8_SA(b, h) + aoff + m * 2048 + k * 1024); } while (0)
#define PG8_LDB(dst, b, h) do { _Pragma("unroll") for (int n = 0; n < 2; ++n) _Pragma("unroll") for (int k = 0; k < 2; ++k) dst[n][k] = *(const PG8_LAS bf16x8*)(lds + PG8_SB(b, h) + boff + n * 2048 + k * 1024); } while (0)
#define PG8_MMA(ai, bj, At, Bt) do { __builtin_amdgcn_s_setprio(1); _Pragma("unroll") for (int m = 0; m < 4; ++m) _Pragma("unroll") for (int n = 0; n < 2; ++n) _Pragma("unroll") for (int k = 0; k < 2; ++k) \
        acc[ai][bj][m][n] = __builtin_amdgcn_mfma_f32_16x16x32_bf16(Bt[n][k], At[m][k], acc[ai][bj][m][n], 0, 0, 0); __builtin_amdgcn_s_setprio(0); } while (0)
#define PG8_WAIT_V(n) asm volatile("s_waitcnt vmcnt(" #n ")" ::: "memory")
#define PG8_WAIT_L(n) asm volatile("s_waitcnt lgkmcnt(" #n ")" ::: "memory")
#define PG8_BAR __builtin_amdgcn_s_barrier()
#define PG8_SCHED __builtin_amdgcn_sched_barrier(0)
    Unit cur, nxt; int ui = 0;
    if (!S.next(0, cur)) return;
    f32x4 acc[2][2][4][2];
#pragma unroll
    for (int a = 0; a < 2; ++a)
#pragma unroll
        for (int b = 0; b < 2; ++b)
#pragma unroll
            for (int m = 0; m < 4; ++m)
#pragma unroll
                for (int n = 0; n < 2; ++n) acc[a][b][m][n] = (f32x4){0.f, 0.f, 0.f, 0.f};
    bf16x8 At[4][2], B0[2][2], B1[2][2];
    const char* cA = (const char*)g.A + (size_t)cur.pm * tstep; const char* cB = (const char*)g.Bt + (size_t)cur.pn * tstep;
    S.a_ready(cur);
    if constexpr (SP2) {
        PG8_STAGE(PG8_SB(0, 0), cB, voffB); PG8_STAGE(PG8_SB(0, 1), cB + hstep, voffB); PG8_STAGE(PG8_SA(0, 0), cA, voffA); PG8_STAGE(PG8_SA(0, 1), cA + hstep, voffA);
        if (wr == 1) PG8_BAR;
        PG8_WAIT_V(2); PG8_BAR;
        PG8_STAGE(PG8_SB(1, 0), cB + kstep, voffB); PG8_STAGE(PG8_SA(1, 0), cA + kstep, voffA); PG8_STAGE(PG8_SB(1, 1), cB + hstep + kstep, voffB);
        PG8_WAIT_V(6); PG8_BAR;
    } else {
        PG8_STAGE(PG8_SB(0, 0), cB, voffB); PG8_STAGE(PG8_SA(0, 0), cA, voffA); PG8_STAGE(PG8_SB(0, 1), cB + hstep, voffB); PG8_STAGE(PG8_SA(0, 1), cA + hstep, voffA);
        if (wr == 1) PG8_BAR;
        PG8_WAIT_V(4); PG8_BAR;
        PG8_STAGE(PG8_SB(1, 0), cB + kstep, voffB); PG8_STAGE(PG8_SA(1, 0), cA + kstep, voffA); PG8_STAGE(PG8_SB(1, 1), cB + hstep + kstep, voffB);
        PG8_WAIT_V(6); PG8_BAR;
    }
    for (;;) {
        const bool has_next = S.next(ui + 1, nxt);
        const char* nA = has_next ? (const char*)g.A + (size_t)nxt.pm * tstep : cA; const char* nB = has_next ? (const char*)g.Bt + (size_t)nxt.pn * tstep : cB;
        for (int t = 0; t < nt; t += 2) {
            const bool last = (t == nt - 2);
            const char* a1 = cA + (size_t)(t + 1) * kstep;
            const char* a2 = last ? nA : cA + (size_t)(t + 2) * kstep; const char* b2 = last ? nB : cB + (size_t)(t + 2) * kstep;
            const char* a3 = a2 + kstep; const char* b3 = b2 + kstep;
            if (last && has_next) S.a_ready(nxt);
            if constexpr (SP2) {
            PG8_LDB(B0, 0, 0); PG8_LDB(B1, 0, 1); PG8_SCHED; PG8_LDA(At, 0, 0); PG8_STAGE(PG8_SA(1, 1), a1 + hstep, voffA);
            PG8_WAIT_V(8); PG8_WAIT_L(0); PG8_BAR; PG8_MMA(0, 0, At, B0); PG8_MMA(0, 1, At, B1); PG8_BAR; PG8_SCHED;
            PG8_LDA(At, 0, 1); PG8_STAGE(PG8_SB(0, 0), b2, voffB); PG8_STAGE(PG8_SB(0, 1), b2 + hstep, voffB); PG8_STAGE(PG8_SA(0, 0), a2, voffA);
            PG8_WAIT_V(8); PG8_WAIT_L(0); PG8_BAR; PG8_MMA(1, 0, At, B0); PG8_MMA(1, 1, At, B1); PG8_BAR; PG8_SCHED;
            PG8_LDB(B0, 1, 0); PG8_LDB(B1, 1, 1); PG8_SCHED; PG8_LDA(At, 1, 0); PG8_STAGE(PG8_SA(0, 1), a2 + hstep, voffA);
            PG8_WAIT_V(8); PG8_WAIT_L(0); PG8_BAR; PG8_MMA(0, 0, At, B0); PG8_MMA(0, 1, At, B1); PG8_BAR; PG8_SCHED;
            PG8_LDA(At, 1, 1); PG8_STAGE(PG8_SB(1, 0), b3, voffB); PG8_STAGE(PG8_SB(1, 1), b3 + hstep, voffB); PG8_STAGE(PG8_SA(1, 0), a3, voffA);
            PG8_WAIT_V(8); PG8_WAIT_L(0); PG8_BAR; PG8_MMA(1, 0, At, B0); PG8_MMA(1, 1, At, B1); PG8_BAR; PG8_SCHED;
            } else {
            PG8_LDB(B0, 0, 0); PG8_SCHED; PG8_LDA(At, 0, 0); PG8_STAGE(PG8_SA(1, 1), a1 + hstep, voffA);
            PG8_WAIT_L(8); PG8_BAR; PG8_WAIT_L(0); PG8_MMA(0, 0, At, B0); PG8_BAR; PG8_SCHED;
            PG8_LDB(B1, 0, 1); PG8_STAGE(PG8_SB(0, 0), b2, voffB);
            PG8_BAR; PG8_WAIT_L(0); PG8_MMA(0, 1, At, B1); PG8_BAR;
            PG8_LDA(At, 0, 1); PG8_STAGE(PG8_SA(0, 0), a2, voffA);
            PG8_BAR; PG8_WAIT_L(0); PG8_MMA(1, 0, At, B0); PG8_BAR; PG8_SCHED;
            PG8_STAGE(PG8_SB(0, 1), b2 + hstep, voffB);
            PG8_WAIT_V(6); PG8_BAR; PG8_MMA(1, 1, At, B1); PG8_BAR;
            PG8_LDB(B0, 1, 0); PG8_SCHED; PG8_LDA(At, 1, 0); PG8_STAGE(PG8_SA(0, 1), a2 + hstep, voffA);
            PG8_WAIT_L(8); PG8_BAR; PG8_WAIT_L(0); PG8_MMA(0, 0, At, B0); PG8_BAR; PG8_SCHED;
            PG8_LDB(B1, 1, 1); PG8_STAGE(PG8_SB(1, 0), b3, voffB);
            PG8_BAR; PG8_WAIT_L(0); PG8_MMA(0, 1, At, B1); PG8_BAR;
            PG8_LDA(At, 1, 1); PG8_STAGE(PG8_SA(1, 0), a3, voffA);
            PG8_BAR; PG8_WAIT_L(0); PG8_MMA(1, 0, At, B0); PG8_BAR; PG8_SCHED;
            PG8_STAGE(PG8_SB(1, 1), b3 + hstep, voffB);
            PG8_WAIT_V(6); PG8_BAR; PG8_MMA(1, 1, At, B1); PG8_BAR;
            }
        }
        if constexpr (ALIGN_EPI) { if (wr == 0) PG8_BAR; }
        if constexpr (!Epi::AFTER_DRAIN) { E(acc, cur, wr, wc, fr, fq); S.done(cur); }
        if (!has_next) break;
#pragma unroll
        for (int a = 0; a < 2; ++a)
#pragma unroll
            for (int b = 0; b < 2; ++b)
#pragma unroll
                for (int m = 0; m < 4; ++m)
#pragma unroll
                    for (int n = 0; n < 2; ++n) acc[a][b][m][n] = (f32x4){0.f, 0.f, 0.f, 0.f};
        cur = nxt; cA = nA; cB = nB; ++ui;
        if constexpr (ALIGN_EPI) { if (wr == 1) PG8_BAR; }
    }
    PG8_WAIT_V(0);
    if constexpr (!ALIGN_EPI) { if (wr == 0) PG8_BAR; }
    PG8_BAR;
    if constexpr (Epi::AFTER_DRAIN) { E.fused(acc, cur, wr, wc, fr, fq, lds, wid, lane); S.done(cur); }
#undef PG8_SA
#undef PG8_SB
#undef PG8_STAGE
#undef PG8_LDA
#undef PG8_LDB
#undef PG8_MMA
#undef PG8_WAIT_V
#undef PG8_WAIT_L
#undef PG8_BAR
#undef PG8_SCHED
}
}

constexpr int NWAVES = 8;
constexpr int BATCH = 2, SEQ = 8192, M = BATCH * SEQ, D = 2048, DEPTH = 4;
constexpr int DFF = 5504, NFF = 2 * DFF;
constexpr int NMIX = 4624, NMIXP = 4864, MIXLD = 4608;
constexpr int C_QA = 0, C_KA = 1024, C_VA = 1280, C_QG = 1536, C_KG = 2048, C_VG = 2560, C_RG = 3584;
constexpr float NORM_EPS = 1e-6f;

constexpr size_t MiB = 1u << 20;
constexpr size_t WS_CTL = 0, CTL_ZERO_BYTES = 1 * MiB;
constexpr size_t SZ_WFI = (size_t)8 * NFF * D * 2, SZ_WFO = (size_t)8 * D * DFF * 2, SZ_WMI = (size_t)4 * NMIXP * D * 2, SZ_WMO = (size_t)4 * D * D * 2;
constexpr size_t WS_WFI = 2 * MiB;
constexpr size_t WS_WFO = WS_WFI + SZ_WFI;
constexpr size_t WS_WMI = WS_WFO + SZ_WFO;
constexpr size_t WS_WMO = WS_WMI + SZ_WMI;
constexpr size_t WS_XN  = WS_WMO + SZ_WMO;
constexpr size_t WS_ACT = WS_XN + (size_t)M * D * 2;
constexpr size_t WS_H   = WS_ACT + (size_t)M * DFF * 2;
constexpr size_t WS_MIX = WS_H + (size_t)M * D * 2;
constexpr size_t WS_GLR = WS_MIX + (size_t)M * MIXLD * 2;
constexpr size_t WS_ROPE = WS_GLR + (size_t)M * 16 * 4;
constexpr size_t WS_MO  = WS_ROPE + (size_t)M * 64 * 4;
constexpr size_t WS_XB  = WS_MO + (size_t)M * D * 2;
constexpr size_t RB_STRIDE = (size_t)M * D * 4;
constexpr size_t WS_DEC = WS_XB + 2 * RB_STRIDE;
constexpr size_t WS_DS  = WS_DEC + (size_t)1024 * 128 * 4;
constexpr size_t WS_ST  = WS_DS + (size_t)1024 * 32768 * 2;
constexpr size_t WS_END = WS_ST + (size_t)1024 * 32768 * 2;
static_assert(WS_WFI % 256 == 0 && WS_WFO % 256 == 0 && WS_WMI % 256 == 0 && WS_WMO % 256 == 0 && WS_XN % 256 == 0 && WS_ACT % 256 == 0 && WS_H % 256 == 0 && WS_MIX % 256 == 0 && WS_GLR % 256 == 0 && WS_ROPE % 256 == 0 && WS_MO % 256 == 0 && WS_XB % 256 == 0 && WS_DEC % 256 == 0 && WS_DS % 256 == 0 && WS_ST % 256 == 0, "alignment");
constexpr int CW_BAR = 4096;
constexpr int CW_WFLAG = 65536;

constexpr int RING_OFF = 0, RING_BYTES = 131072;
constexpr int LDSCTL_OFF = RING_BYTES, MISC_OFF = LDSCTL_OFF + 320;
constexpr int LDS_BYTES = 147456;
static_assert(MISC_OFF + 128 <= LDS_BYTES, "LDS map");
constexpr int G_KT = 0;
constexpr int G3_B = 0;
constexpr int G_VT = 32768;
constexpr int G_SEG = 69632;
constexpr int G3_QD = 71680;
constexpr int G3_KD = 89088;
constexpr int G3_IN = 106496;
constexpr int G3_SS = 115712;
constexpr int G_GLR = 117760;
static_assert(G_KT + 128 * 144 <= G_VT && G3_B + 32768 <= G_VT && G_VT + 256 * 144 <= G_SEG && G_SEG + 2048 <= G3_QD && G3_QD + 64 * 272 <= G3_KD && G3_KD + 64 * 272 <= G3_IN && G3_IN + 64 * 144 <= G3_SS && G3_SS + 2048 <= G_GLR && G_GLR + 4096 <= RING_BYTES, "GLA LDS map");
constexpr int A_KS = 0;
constexpr int A_VT = 36864;
static_assert(A_VT + 64 * 528 <= RING_BYTES, "attention LDS map");
#define GAS __attribute__((address_space(1)))
#define LAS __attribute__((address_space(3)))
typedef unsigned short bf16;
typedef unsigned v4u __attribute__((ext_vector_type(4)));
typedef float f32x4 __attribute__((ext_vector_type(4)));
typedef short bf16x8 __attribute__((ext_vector_type(8)));
typedef GAS unsigned gu32;
typedef GAS unsigned long long gu64;
#define RLX_AGENT __ATOMIC_RELAXED, __HIP_MEMORY_SCOPE_AGENT
#define LDS_WAIT() asm volatile("s_waitcnt lgkmcnt(0)" ::: "memory")
#define VM_WAIT() asm volatile("s_waitcnt vmcnt(0)" ::: "memory")
__device__ __forceinline__ unsigned long long rt() { return __builtin_amdgcn_s_memrealtime(); }
__device__ __forceinline__ unsigned f2bf(float f) { unsigned u = __builtin_bit_cast(unsigned, f); return (u + 0x7fffu + ((u >> 16) & 1u)) >> 16; }
__device__ __forceinline__ unsigned pk2(float lo, float hi) { return f2bf(lo) | (f2bf(hi) << 16); }
#define XB_TMO      128
#define XB_XCNT(j)  (256  + 64 * (j))
#define XB_XSUB(j)  (1280 + 64 * (j))
#define XB_XGEN(j)  (2304 + 64 * (j))
#define XB_TOP      3328
#define XB_TOPGEN   3392
#define XCD_BAR_WORDS 3456
#define XB_SPIN_CAP (1u << 18)

__device__ __forceinline__ unsigned xb_ld(unsigned* p)              { return __hip_atomic_load(p, __ATOMIC_RELAXED, __HIP_MEMORY_SCOPE_AGENT); }
__device__ __forceinline__ unsigned xb_add(unsigned* p, unsigned v) { return __hip_atomic_fetch_add(p, v, __ATOMIC_RELAXED, __HIP_MEMORY_SCOPE_AGENT); }
__device__ __forceinline__ unsigned xb_xcc_id() { return (unsigned)__builtin_amdgcn_s_getreg((3 << 11) | 20) & 0xFu; }
#define XB_SPIN(cond, bar) do { unsigned _sp = 0; while (cond) { __builtin_amdgcn_s_sleep(1); \
    if ((++_sp & 255u) == 0u) { if (xb_ld(&(bar)[XB_TMO])) break; if (_sp > XB_SPIN_CAP) { atomicAdd(&(bar)[XB_TMO], 1u); break; } } } } while (0)

struct XcdBarrier {
    unsigned* bar; unsigned x; unsigned ng;
    volatile LAS unsigned* st;
};

__device__ __forceinline__ XcdBarrier xcd_barrier_post(unsigned* bar, volatile LAS unsigned* st, unsigned ng) {
    XcdBarrier b; b.bar = bar; b.x = xb_xcc_id(); b.st = st; b.ng = ng;
    if (threadIdx.x == 0) (void)xb_add(&bar[XB_XCNT(b.x)], 1u);
    return b;
}
__device__ __forceinline__ void xcd_barrier_complete(unsigned* bar, unsigned x, unsigned G, unsigned& nloc, unsigned& nx) {
    unsigned sum, cnt, mine, sp = 0u;
    for (;;) {
        sum = 0u; cnt = 0u; mine = 0u;
#pragma unroll
        for (unsigned j = 0; j < 16; ++j) { const unsigned c = xb_ld(&bar[XB_XCNT(j)]); sum += c; cnt += (c > 0u) ? 1u : 0u; mine = (j == x) ? c : mine; }
        if (sum == G) break;
        __builtin_amdgcn_s_sleep(1);
        if ((++sp & 255u) == 0u) { if (xb_ld(&bar[XB_TMO])) break; if (sp > XB_SPIN_CAP) { atomicAdd(&bar[XB_TMO], 1u); break; } }
    }
    nloc = mine > 0u ? mine : 1u; nx = cnt > 0u ? cnt : 1u;
}

__device__ __forceinline__ void xcd_barrier(const XcdBarrier& b) {
    asm volatile("s_waitcnt vmcnt(0)" ::: "memory");
    __syncthreads();
    if (threadIdx.x == 0) {
        unsigned* bar = b.bar;
        __builtin_amdgcn_s_waitcnt(0);
        unsigned nloc = b.st[0], nx = b.st[1];
        if (nloc == 0u) { xcd_barrier_complete(bar, b.x, b.ng, nloc, nx); b.st[0] = nloc; b.st[1] = nx; }
        const unsigned old = xb_add(&bar[XB_XSUB(b.x)], 1u);
        const unsigned gen = old / nloc;
        if (old + 1u == (gen + 1u) * nloc) {
            __builtin_amdgcn_fence(__ATOMIC_RELEASE, "agent");
            asm volatile("s_waitcnt vmcnt(0)" ::: "memory");
            const unsigned og = xb_add(&bar[XB_TOP], 1u);
            const unsigned tg = og / nx;
            if (og + 1u == (tg + 1u) * nx) xb_add(&bar[XB_TOPGEN], 1u);
            else XB_SPIN(xb_ld(&bar[XB_TOPGEN]) == tg, bar);
            __builtin_amdgcn_fence(__ATOMIC_ACQUIRE, "agent");
            xb_add(&bar[XB_XGEN(b.x)], 1u);
            asm volatile("s_waitcnt vmcnt(0)" ::: "memory");
        } else {
            XB_SPIN(xb_ld(&bar[XB_XGEN(b.x)]) == gen, bar);
            __builtin_amdgcn_fence(__ATOMIC_ACQUIRE, "agent");
            asm volatile("s_waitcnt vmcnt(0)" ::: "memory");
        }
    }
    __syncthreads();
}

typedef unsigned v2u __attribute__((ext_vector_type(2)));
typedef float v2f __attribute__((ext_vector_type(2)));
struct Frame {
    LAS unsigned char* lds;
    volatile LAS unsigned* MISC;
    gu32* ctl;
    int tid, lane, wave;
    int vcu, G;
    int wcu, WG, row0, nrows, gc, nxl;
    const float* x; const int* pos; const float* gains; const float* w_fi; const float* w_fo; const float* w_mi; const float* sinks; const float* gate_w2; const float* gate_b; const float* gla_gain; const float* w_mo;
    float* out;
    bf16 *WFI, *WFO, *WMI, *WMO, *XN, *ACT, *H, *MIX, *MO;
    float *GLR, *ROPE, *DEC; bf16 *ST, *DS; unsigned char* RB;
};
#define RELAUNDER(F) do { int t_ = threadIdx.x; asm volatile("" : "+v"(t_)); (F).tid = t_; (F).lane = t_ & 63; (F).wave = __builtin_amdgcn_readfirstlane(t_ >> 6); \
    const __attribute__((address_space(4))) char* kb_ = (const __attribute__((address_space(4))) char*)__builtin_amdgcn_kernarg_segment_ptr(); asm volatile("" : "+s"(kb_)); \
    GAS void* const __attribute__((address_space(4)))* ka_ = (GAS void* const __attribute__((address_space(4)))*)kb_;     \
    (F).x = (const float*)ka_[0]; (F).pos = (const int*)ka_[1]; (F).gains = (const float*)ka_[2]; (F).w_fi = (const float*)ka_[3]; (F).w_fo = (const float*)ka_[4]; (F).w_mi = (const float*)ka_[5]; \
    (F).sinks = (const float*)ka_[6]; (F).gate_w2 = (const float*)ka_[7]; (F).gate_b = (const float*)ka_[8]; (F).gla_gain = (const float*)ka_[9]; (F).w_mo = (const float*)ka_[10]; (F).out = (float*)ka_[11]; \
    unsigned char* ws_ = (unsigned char*)ka_[12]; \
    (F).WFI = (bf16*)(ws_ + WS_WFI); (F).WFO = (bf16*)(ws_ + WS_WFO); (F).WMI = (bf16*)(ws_ + WS_WMI); (F).WMO = (bf16*)(ws_ + WS_WMO); \
    (F).XN = (bf16*)(ws_ + WS_XN); (F).ACT = (bf16*)(ws_ + WS_ACT); (F).H = (bf16*)(ws_ + WS_H); (F).MIX = (bf16*)(ws_ + WS_MIX); (F).MO = (bf16*)(ws_ + WS_MO); \
    (F).GLR = (float*)(ws_ + WS_GLR); (F).ROPE = (float*)(ws_ + WS_ROPE); (F).RB = ws_ + WS_XB; (F).DEC = (float*)(ws_ + WS_DEC); (F).DS = (bf16*)(ws_ + WS_DS); (F).ST = (bf16*)(ws_ + WS_ST); } while (0)
__device__ __forceinline__ float wave_sum(float v) {
#pragma unroll
    for (int o = 1; o < 64; o <<= 1) v += __shfl_xor(v, o);
    return v;
}
__device__ __forceinline__ float wave_max(float v) {
#pragma unroll
    for (int o = 1; o < 64; o <<= 1) v = fmaxf(v, __shfl_xor(v, o));
    return v;
}
__device__ __forceinline__ float bf_lo(unsigned w) { return __builtin_bit_cast(float, w << 16); }
__device__ __forceinline__ float bf_hi(unsigned w) { return __builtin_bit_cast(float, w & 0xffff0000u); }
__device__ __forceinline__ float bf1(bf16 h) { return __builtin_bit_cast(float, ((unsigned)h) << 16); }

constexpr bool kResBf16 = true;
constexpr int N_UPDATES = 3 * DEPTH;
struct RowRaw { f32x4 x[8]; v2u h[8]; };
template <bool FIRST>
__device__ __forceinline__ void norm_load(Frame& F, const void* xsrc, bool src_f32, int m, RowRaw& r) {
    if (src_f32) { const float* xr = (const float*)xsrc + (size_t)m * D + 4 * F.lane;
#pragma unroll
        for (int j = 0; j < 8; ++j) r.x[j] = *(const f32x4*)(xr + 256 * j); }
    else { const bf16* xr = (const bf16*)xsrc + (size_t)m * D + 4 * F.lane;
#pragma unroll
        for (int j = 0; j < 8; ++j) { const v2u w = *(const v2u*)(xr + 256 * j); r.x[j] = (f32x4){bf_lo(w.x), bf_hi(w.x), bf_lo(w.y), bf_hi(w.y)}; } }
    if (!FIRST) { const bf16* hr = F.H + (size_t)m * D + 4 * F.lane;
#pragma unroll
        for (int j = 0; j < 8; ++j) r.h[j] = *(const v2u*)(hr + 256 * j); }
}
template <bool FIRST>
__device__ __forceinline__ void norm_row(Frame& F, void* xdst, bool dst_f32, int m, RowRaw& r, const f32x4 (&GA)[8], const f32x4 (&GB)[8], float cres, bool write_xn) {
    if (!FIRST) {
        f32x4 hf[8]; float ss = 0.f;
#pragma unroll
        for (int j = 0; j < 8; ++j) { hf[j] = (f32x4){bf_lo(r.h[j].x), bf_hi(r.h[j].x), bf_lo(r.h[j].y), bf_hi(r.h[j].y)};
            ss += (hf[j].x * hf[j].x + hf[j].y * hf[j].y) + (hf[j].z * hf[j].z + hf[j].w * hf[j].w); }
        const float rs = 1.0f / sqrtf(wave_sum(ss) * (1.0f / D) + NORM_EPS);
#pragma unroll
        for (int j = 0; j < 8; ++j) r.x[j] = r.x[j] + cres * ((hf[j] * rs) * GA[j]);
        if (dst_f32) { float* xw = (float*)xdst + (size_t)m * D + 4 * F.lane;
#pragma unroll
            for (int j = 0; j < 8; ++j) *(f32x4*)(xw + 256 * j) = r.x[j]; }
        else { bf16* xw = (bf16*)xdst + (size_t)m * D + 4 * F.lane;
#pragma unroll
            for (int j = 0; j < 8; ++j) { v2u o; o.x = pg8::cvt_pk_bf16(r.x[j].x, r.x[j].y); o.y = pg8::cvt_pk_bf16(r.x[j].z, r.x[j].w); *(v2u*)(xw + 256 * j) = o;
                r.x[j] = (f32x4){bf_lo(o.x), bf_hi(o.x), bf_lo(o.y), bf_hi(o.y)}; } }
    }
    if (write_xn) {
        float s2 = 0.f;
#pragma unroll
        for (int j = 0; j < 8; ++j) s2 += (r.x[j].x * r.x[j].x + r.x[j].y * r.x[j].y) + (r.x[j].z * r.x[j].z + r.x[j].w * r.x[j].w);
        const float r2 = 1.0f / sqrtf(wave_sum(s2) * (1.0f / D) + NORM_EPS);
        bf16* xo = F.XN + (size_t)m * D + 4 * F.lane;
#pragma unroll
        for (int j = 0; j < 8; ++j) { const f32x4 a = (r.x[j] * r2) * GB[j];
            v2u o; o.x = pg8::cvt_pk_bf16(a.x, a.y); o.y = pg8::cvt_pk_bf16(a.z, a.w);
            *(v2u*)(xo + 256 * j) = o; }
    }
}
template <bool FIRST>
__device__ __forceinline__ void norm_phase(Frame& F, int k, int ia, int ib, float cres, bool write_xn) {
    RELAUNDER(F);
    const bool src_f32 = FIRST || k == 0 || !kResBf16, dst_f32 = (k == N_UPDATES - 1) || !kResBf16;
    const void* xsrc = (FIRST || k == 0) ? (const void*)F.x : (const void*)(F.RB + (size_t)((k - 1) & 1) * RB_STRIDE);
    void* xdst = (k == N_UPDATES - 1) ? (void*)F.out : (void*)(F.RB + (size_t)(k & 1) * RB_STRIDE);
    const float* ga = F.gains + (size_t)ia * D + 4 * F.lane; const float* gb = F.gains + (size_t)ib * D + 4 * F.lane;
    const int gw = F.wcu * NWAVES + F.wave, NGW = F.WG * NWAVES;
    f32x4 GA[8], GB[8];
#pragma unroll
    for (int j = 0; j < 8; ++j) {
        GA[j] = FIRST ? (f32x4){0.f, 0.f, 0.f, 0.f} : *(const f32x4*)(ga + 256 * j);
        GB[j] = write_xn ? *(const f32x4*)(gb + 256 * j) : (f32x4){0.f, 0.f, 0.f, 0.f}; }
    RowRaw ra, rb;
    int mm = gw;
    if (mm < F.nrows) norm_load<FIRST>(F, xsrc, src_f32, F.row0 + mm, ra);
    while (mm < F.nrows) {
        { const int nx = mm + NGW; if (nx < F.nrows) norm_load<FIRST>(F, xsrc, src_f32, F.row0 + nx, rb);
          norm_row<FIRST>(F, xdst, dst_f32, F.row0 + mm, ra, GA, GB, cres, write_xn); mm = nx; }
        if (mm >= F.nrows) break;
        { const int nx = mm + NGW; if (nx < F.nrows) norm_load<FIRST>(F, xsrc, src_f32, F.row0 + nx, ra);
          norm_row<FIRST>(F, xdst, dst_f32, F.row0 + mm, rb, GA, GB, cres, write_xn); mm = nx; }
    }
}
struct CvtItem { const float* W; bf16* WT; int K, N, nt, kt, mode; };
__device__ __forceinline__ CvtItem cvt_decode(Frame& F, int it, int l0, int nl) {
    constexpr int PER_FI = (NFF / 64) * (D / 64), PER_FO = (D / 64) * (DFF / 64), PER_MI = (NMIXP / 64) * (D / 64), PER_MO = (D / 64) * (D / 64);
    const int IT_FI = 2 * nl * PER_FI, IT_FO = 2 * nl * PER_FO, IT_MI = nl * PER_MI;
    CvtItem c; int r = it;
    if (r < IT_FI) { const int mat = 2 * l0 + r / PER_FI, q = r % PER_FI; c.W = F.w_fi + (size_t)mat * D * NFF; c.WT = F.WFI + (size_t)mat * NFF * D; c.K = D; c.N = NFF; c.kt = q / (NFF / 64); c.nt = q % (NFF / 64); c.mode = 1; return c; } r -= IT_FI;
    if (r < IT_FO) { const int mat = 2 * l0 + r / PER_FO, q = r % PER_FO; c.W = F.w_fo + (size_t)mat * DFF * D; c.WT = F.WFO + (size_t)mat * D * DFF; c.K = DFF; c.N = D; c.kt = q / (D / 64); c.nt = q % (D / 64); c.mode = 0; return c; } r -= IT_FO;
    if (r < IT_MI) { const int mat = l0 + r / PER_MI, q = r % PER_MI; c.W = F.w_mi + (size_t)mat * D * NMIX; c.WT = F.WMI + (size_t)mat * NMIXP * D; c.K = D; c.N = NMIX; c.kt = q / (NMIXP / 64); c.nt = q % (NMIXP / 64); c.mode = 2; return c; } r -= IT_MI;
    { const int mat = l0 + r / PER_MO, q = r % PER_MO; c.W = F.w_mo + (size_t)mat * D * D; c.WT = F.WMO + (size_t)mat * D * D; c.K = D; c.N = D; c.kt = q / (D / 64); c.nt = q % (D / 64); c.mode = 0; return c; }
}
__device__ __forceinline__ void cvt_load(const CvtItem& c, int lane, f32x4 (&v)[16]) {
    const int a = lane & 15, kr = lane >> 4, nd = c.nt * 64 + 4 * a;
    int src = nd; bool valid = true;
    if (c.mode == 1) { const int w = nd & 255; src = ((w >> 7) ? DFF : 0) + (nd >> 8) * 128 + (w & 127); }
    if (c.mode == 2) { valid = nd < NMIX; if (!valid) src = 0; }
    const float* wp = c.W + (size_t)(c.kt * 64 + 2 * kr) * c.N + src;
#pragma unroll
    for (int i = 0; i < 16; ++i) v[i] = *(const f32x4*)(wp + (size_t)(8 * (i >> 1) + (i & 1)) * c.N);
    if (!valid) {
#pragma unroll
        for (int i = 0; i < 16; ++i) v[i] = (f32x4){0.f, 0.f, 0.f, 0.f}; }
}
__device__ __forceinline__ void cvt_store(const CvtItem& c, int lane, const f32x4 (&v)[16], LAS unsigned char* T) {
    const int a = lane & 15, kr = lane >> 4;
#pragma unroll
    for (int p = 0; p < 8; ++p)
#pragma unroll
        for (int j = 0; j < 4; ++j) *(LAS unsigned*)(T + (4 * a + j) * 132 + 4 * (4 * p + kr)) = pg8::cvt_pk_bf16(v[2 * p][j], v[2 * p + 1][j]);
    const int nn = lane >> 3, ch = lane & 7;
    bf16* op = c.WT + (size_t)(c.nt * 64 + nn) * c.K + c.kt * 64 + 8 * ch;
#pragma unroll
    for (int r = 0; r < 8; ++r) { const LAS unsigned* tp = (const LAS unsigned*)(T + (nn + 8 * r) * 132 + 16 * ch);
        const v4u o = {tp[0], tp[1], tp[2], tp[3]};
        *(v4u*)(op + (size_t)(8 * r) * c.K) = o; }
}
__device__ __forceinline__ void p0_convert(Frame& F, int l0, int l1) {
    RELAUNDER(F);
    const int gw = F.wcu * NWAVES + F.wave, NGW = F.WG * NWAVES, nl = l1 - l0;
    const int total = nl * (2 * (NFF / 64) * (D / 64) + 2 * (D / 64) * (DFF / 64) + (NMIXP / 64) * (D / 64) + (D / 64) * (D / 64));
    LAS unsigned char* T = F.lds + RING_OFF + F.wave * 8448;
    f32x4 va[16], vb[16];
    int it = gw;
    if (it < total) { const CvtItem c = cvt_decode(F, it, l0, nl); cvt_load(c, F.lane, va); }
    while (it < total) {
        { const int nx = it + NGW; if (nx < total) { const CvtItem cn = cvt_decode(F, nx, l0, nl); cvt_load(cn, F.lane, vb); }
          const CvtItem c = cvt_decode(F, it, l0, nl); cvt_store(c, F.lane, va, T); it = nx; }
        if (it >= total) break;
        { const int nx = it + NGW; if (nx < total) { const CvtItem cn = cvt_decode(F, nx, l0, nl); cvt_load(cn, F.lane, va); }
          const CvtItem c = cvt_decode(F, it, l0, nl); cvt_store(c, F.lane, vb, T); it = nx; }
    }
}
__device__ __forceinline__ void p0_rope(Frame& F) {
    RELAUNDER(F);
    for (int e = (F.wcu * NWAVES + F.wave) * 64 + F.lane; e < F.nrows * 32; e += F.WG * NWAVES * 64) {
        const int m = F.row0 + (e >> 5), i = e & 31;
        double pw = 1.0; for (int k = 0; k < i; ++k) pw *= 0.7498942093324559;
        const float a = (float)F.pos[m] * (float)pw;
        const double ad = (double)a, k = rint(ad * 0.15915494309189535), r = fma(-k, 6.283185307179586, ad);
        const float rf = (float)r;
        F.ROPE[(size_t)m * 64 + i] = cosf(rf); F.ROPE[(size_t)m * 64 + 32 + i] = sinf(rf);
    }
}

__device__ __forceinline__ pg8::f32x4 mma16(bf16x8 x, bf16x8 y, pg8::f32x4 c) { return __builtin_amdgcn_mfma_f32_16x16x32_bf16(x, y, c, 0, 0, 0); }

__device__ __forceinline__ void gla_cumsum(Frame& F, LAS unsigned char* L, int l, size_t m0, int h, float (&bb)[16], float& off, float& tot) {
    const int dk = F.tid & 127, tq = F.wave >> 1;
    const float* w2 = F.gate_w2 + (size_t)l * 16 * 512 + h * 128 + dk;
    float wv[16];
#pragma unroll
    for (int r = 0; r < 16; ++r) wv[r] = w2[r * 512];
    const float bias = F.gate_b[(size_t)l * 512 + h * 128 + dk];
    LAS float* gl = (LAS float*)(L + G_GLR);
    if (F.tid < 256) *(LAS f32x4*)(gl + 4 * F.tid) = *(const f32x4*)(F.GLR + m0 * 16 + 4 * F.tid);
    __syncthreads();
    const LAS float* gr = gl + tq * 256;
    float run = 0.f;
#pragma unroll
    for (int i = 0; i < 16; ++i) {
        const f32x4 g0 = *(const LAS f32x4*)(gr + i * 16), g1 = *(const LAS f32x4*)(gr + i * 16 + 4), g2 = *(const LAS f32x4*)(gr + i * 16 + 8), g3 = *(const LAS f32x4*)(gr + i * 16 + 12);
        const float gg[16] = {g0.x, g0.y, g0.z, g0.w, g1.x, g1.y, g1.z, g1.w, g2.x, g2.y, g2.z, g2.w, g3.x, g3.y, g3.z, g3.w};
        float z = bias;
#pragma unroll
        for (int r = 0; r < 16; ++r) z += gg[r] * wv[r];
        const float ls = fminf(z, 0.f) - __logf(1.0f + __expf(-fabsf(z)));
        run += ls * 0.0625f; bb[i] = run; }
    LAS float* seg = (LAS float*)(L + G_SEG);
    seg[tq * 128 + dk] = bb[15];
    __syncthreads();
    off = 0.f; tot = 0.f;
#pragma unroll
    for (int q = 0; q < 4; ++q) { const float sg = seg[q * 128 + dk]; tot += sg; if (q < tq) off += sg; }
}
__device__ __forceinline__ void gla_stage_vt(Frame& F, LAS unsigned char* L, size_t m0, int h) {
    const int dv = F.tid & 255, th = F.tid >> 8; const bf16* vp = F.MIX + (m0 + th * 32) * MIXLD + C_VG + h * 256 + dv;
    unsigned raw[32], pk[16];
#pragma unroll
    for (int i = 0; i < 32; ++i) raw[i] = vp[(size_t)i * MIXLD];
    __builtin_amdgcn_sched_barrier(0);
#pragma unroll
    for (int i = 0; i < 16; ++i) pk[i] = raw[2 * i] | (raw[2 * i + 1] << 16);
    LAS v4u* dst = (LAS v4u*)(L + G_VT + dv * 144 + th * 64);
#pragma unroll
    for (int j = 0; j < 4; ++j) dst[j] = (v4u){pk[4 * j], pk[4 * j + 1], pk[4 * j + 2], pk[4 * j + 3]};
}
__device__ __forceinline__ void gla_g1(Frame& F, int l) {
    RELAUNDER(F);
    LAS unsigned char* L = F.lds + RING_OFF;
    const int r16 = F.lane & 15, q4 = F.lane >> 4, w = F.wave;
    for (int uu = F.wcu; uu < (F.nrows >> 6) * 4; uu += F.WG) {
        const int u = (F.row0 >> 6) * 4 + uu;
        const int c = u >> 2, h = u & 3; const size_t m0 = (size_t)c * 64;
        const int dk = F.tid & 127, tq = F.wave >> 1;
        unsigned kraw[16];
        { const bf16* kp = F.MIX + (m0 + tq * 16) * MIXLD + C_KG + h * 128 + dk;
#pragma unroll
          for (int i = 0; i < 16; ++i) kraw[i] = kp[(size_t)i * MIXLD]; }
        gla_stage_vt(F, L, m0, h);
        float bb[16], off, tot;
        gla_cumsum(F, L, l, m0, h, bb, off, tot);
        { unsigned pk[8];
#pragma unroll
          for (int i = 0; i < 8; ++i) { const float b0 = bb[2 * i] + off, b1 = bb[2 * i + 1] + off;
              pk[i] = pg8::cvt_pk_bf16(bf1((bf16)kraw[2 * i]) * __expf(tot - b0), bf1((bf16)kraw[2 * i + 1]) * __expf(tot - b1)); }
          LAS v4u* dst = (LAS v4u*)(L + G_KT + dk * 144 + tq * 32);
          dst[0] = (v4u){pk[0], pk[1], pk[2], pk[3]}; dst[1] = (v4u){pk[4], pk[5], pk[6], pk[7]}; }
        if (tq == 0) F.DEC[(size_t)u * 128 + dk] = __expf(tot);
        __syncthreads();
        bf16x8 av[2][2];
#pragma unroll
        for (int rb = 0; rb < 2; ++rb)
#pragma unroll
            for (int ks = 0; ks < 2; ++ks) av[rb][ks] = *(const LAS bf16x8*)(L + G_VT + (32 * w + 16 * rb + r16) * 144 + (32 * ks + 8 * q4) * 2);
        bf16* dsb = F.DS + (size_t)u * 32768;
#pragma unroll
        for (int cb = 0; cb < 8; ++cb) {
            bf16x8 kv[2];
#pragma unroll
            for (int ks = 0; ks < 2; ++ks) kv[ks] = *(const LAS bf16x8*)(L + G_KT + (16 * cb + r16) * 144 + (32 * ks + 8 * q4) * 2);
#pragma unroll
            for (int rb = 0; rb < 2; ++rb) { pg8::f32x4 acc = {0.f, 0.f, 0.f, 0.f};
#pragma unroll
                for (int ks = 0; ks < 2; ++ks) acc = mma16(kv[ks], av[rb][ks], acc);
                v2u pkd; pkd.x = pg8::cvt_pk_bf16_c(acc[0], acc[1]); pkd.y = pg8::cvt_pk_bf16_c(acc[2], acc[3]);
                *(v2u*)(dsb + (size_t)(32 * w + 16 * rb + r16) * 128 + 16 * cb + 4 * q4) = pkd; }
        }
        __syncthreads();
    }
}
__device__ __forceinline__ void gla_scan(Frame& F) {
    RELAUNDER(F);
    for (int g0 = (F.wcu * NWAVES + F.wave) * 64 + F.lane; g0 < (F.nrows / SEQ) * 65536; g0 += F.WG * NWAVES * 64) {
        const int g = (F.row0 / SEQ) * 65536 + g0;
        const int dk2 = g & 63, dv = (g >> 6) & 255, h = (g >> 14) & 3, b = g >> 16;
        const size_t base = (((size_t)b * 128 * 4 + h) * 256 + dv) * 128 + 2 * dk2, nstr = (size_t)4 * 32768;
        const size_t dbase = ((size_t)b * 128 * 4 + h) * 128 + 2 * dk2, dstr = 4 * 128;
        float s0 = 0.f, s1 = 0.f;
#pragma unroll 1
        for (int n = 0; n < 128; n += 8) {
            v2f d[8], dc[8];
#pragma unroll
            for (int i = 0; i < 8; ++i) { const unsigned dw = *(const unsigned*)(F.DS + base + (size_t)(n + i) * nstr); d[i] = (v2f){bf_lo(dw), bf_hi(dw)}; dc[i] = *(const v2f*)(F.DEC + dbase + (size_t)(n + i) * dstr); }
#pragma unroll
            for (int i = 0; i < 8; ++i) { *(unsigned*)(F.ST + base + (size_t)(n + i) * nstr) = pg8::cvt_pk_bf16(s0, s1);
                s0 = dc[i].x * s0 + d[i].x; s1 = dc[i].y * s1 + d[i].y; }
        }
    }
}
__device__ __forceinline__ void gla_g3(Frame& F, int l) {
    RELAUNDER(F);
    LAS unsigned char* L = F.lds + RING_OFF;
    const int r16 = F.lane & 15, q4 = F.lane >> 4, w = F.wave;
    for (int uu = F.wcu; uu < (F.nrows >> 6) * 4; uu += F.WG) {
        const int u = (F.row0 >> 6) * 4 + uu;
        const int c = u >> 2, h = u & 3; const size_t m0 = (size_t)c * 64;
        const bf16* stb = F.ST + (size_t)u * 32768;
        bf16x8 sf[2][4];
#pragma unroll
        for (int rb = 0; rb < 2; ++rb)
#pragma unroll
            for (int ks = 0; ks < 4; ++ks) sf[rb][ks] = *(const bf16x8*)(stb + (size_t)(32 * w + 16 * rb + r16) * 128 + 32 * ks + 8 * q4);
        const int t_ = F.tid >> 3, d0_ = (F.tid & 7) * 16; const size_t mt_ = m0 + t_;
        const v4u q0 = *(const v4u*)(F.MIX + mt_ * MIXLD + C_QG + h * 128 + d0_), q1 = *(const v4u*)(F.MIX + mt_ * MIXLD + C_QG + h * 128 + d0_ + 8);
        const v4u k0 = *(const v4u*)(F.MIX + mt_ * MIXLD + C_KG + h * 128 + d0_), k1 = *(const v4u*)(F.MIX + mt_ * MIXLD + C_KG + h * 128 + d0_ + 8);
        v2u rrv[4][2]; f32x4 gvv[2];
#pragma unroll
        for (int rb = 0; rb < 2; ++rb) { gvv[rb] = *(const f32x4*)(F.gla_gain + (size_t)l * 256 + 32 * w + 16 * rb + 4 * q4);
#pragma unroll
            for (int cb = 0; cb < 4; ++cb) rrv[cb][rb] = *(const v2u*)(F.MIX + (m0 + 16 * cb + r16) * MIXLD + C_RG + h * 256 + 32 * w + 16 * rb + 4 * q4); }
        gla_stage_vt(F, L, m0, h);
        { float bb[16], off, tot;
          gla_cumsum(F, L, l, m0, h, bb, off, tot);
          const int dk = F.tid & 127, tq = F.wave >> 1; (void)tot;
          LAS float* B = (LAS float*)(L + G3_B);
#pragma unroll
          for (int i = 0; i < 16; ++i) B[(tq * 16 + i) * 128 + dk] = bb[i] + off; }
        __syncthreads();
        { const int t = t_, d0 = d0_;
          const LAS float* bp = (const LAS float*)(L + G3_B) + t * 128 + d0;
          const unsigned qw[8] = {q0.x, q0.y, q0.z, q0.w, q1.x, q1.y, q1.z, q1.w}, kw[8] = {k0.x, k0.y, k0.z, k0.w, k1.x, k1.y, k1.z, k1.w};
          unsigned qo[8], ko[8];
#pragma unroll
          for (int j = 0; j < 4; ++j) { const f32x4 bv = *(const LAS f32x4*)(bp + 4 * j);
              const float e0 = __expf(bv.x), e1 = __expf(bv.y), e2 = __expf(bv.z), e3 = __expf(bv.w), n0 = __expf(-bv.x), n1 = __expf(-bv.y), n2 = __expf(-bv.z), n3 = __expf(-bv.w);
              qo[2 * j] = pg8::cvt_pk_bf16(bf_lo(qw[2 * j]) * 0.08838834764831845f * e0, bf_hi(qw[2 * j]) * 0.08838834764831845f * e1);
              qo[2 * j + 1] = pg8::cvt_pk_bf16(bf_lo(qw[2 * j + 1]) * 0.08838834764831845f * e2, bf_hi(qw[2 * j + 1]) * 0.08838834764831845f * e3);
              ko[2 * j] = pg8::cvt_pk_bf16(bf_lo(kw[2 * j]) * n0, bf_hi(kw[2 * j]) * n1);
              ko[2 * j + 1] = pg8::cvt_pk_bf16(bf_lo(kw[2 * j + 1]) * n2, bf_hi(kw[2 * j + 1]) * n3); }
          LAS v4u* qd = (LAS v4u*)(L + G3_QD + t * 272 + d0 * 2); LAS v4u* kd = (LAS v4u*)(L + G3_KD + t * 272 + d0 * 2);
          qd[0] = (v4u){qo[0], qo[1], qo[2], qo[3]}; qd[1] = (v4u){qo[4], qo[5], qo[6], qo[7]};
          kd[0] = (v4u){ko[0], ko[1], ko[2], ko[3]}; kd[1] = (v4u){ko[4], ko[5], ko[6], ko[7]}; }
        __syncthreads();
#pragma unroll
        for (int j = 0; j < 2; ++j) {
            const int id = 2 * w + j, tr = id >> 2, sc = id & 3;
            pg8::f32x4 acc = {0.f, 0.f, 0.f, 0.f};
            if (sc <= tr) {
#pragma unroll
                for (int ks = 0; ks < 4; ++ks) acc = mma16(*(const LAS bf16x8*)(L + G3_KD + (16 * sc + r16) * 272 + (32 * ks + 8 * q4) * 2),
                                                           *(const LAS bf16x8*)(L + G3_QD + (16 * tr + r16) * 272 + (32 * ks + 8 * q4) * 2), acc);
                const int t = 16 * tr + r16, s0 = 16 * sc + 4 * q4;
#pragma unroll
                for (int i = 0; i < 4; ++i) if (s0 + i > t) acc[i] = 0.f;
            }
            v2u pk; pk.x = pg8::cvt_pk_bf16(acc[0], acc[1]); pk.y = pg8::cvt_pk_bf16(acc[2], acc[3]);
            *(LAS v2u*)(L + G3_IN + (16 * tr + r16) * 144 + (16 * sc + 4 * q4) * 2) = pk;
        }
        __syncthreads();
        bf16x8 vf[2][2];
#pragma unroll
        for (int rb = 0; rb < 2; ++rb)
#pragma unroll
            for (int ks = 0; ks < 2; ++ks) vf[rb][ks] = *(const LAS bf16x8*)(L + G_VT + (32 * w + 16 * rb + r16) * 144 + (32 * ks + 8 * q4) * 2);
        pg8::f32x4 o[2][4]; float ss[4];
#pragma unroll
        for (int cb = 0; cb < 4; ++cb) {
            bf16x8 qf[4], nf[2];
#pragma unroll
            for (int ks = 0; ks < 4; ++ks) qf[ks] = *(const LAS bf16x8*)(L + G3_QD + (16 * cb + r16) * 272 + (32 * ks + 8 * q4) * 2);
#pragma unroll
            for (int ks = 0; ks < 2; ++ks) nf[ks] = *(const LAS bf16x8*)(L + G3_IN + (16 * cb + r16) * 144 + (32 * ks + 8 * q4) * 2);
            float sq = 0.f;
#pragma unroll
            for (int rb = 0; rb < 2; ++rb) { pg8::f32x4 acc = {0.f, 0.f, 0.f, 0.f};
#pragma unroll
                for (int ks = 0; ks < 4; ++ks) acc = mma16(sf[rb][ks], qf[ks], acc);
#pragma unroll
                for (int ks = 0; ks < 2; ++ks) acc = mma16(vf[rb][ks], nf[ks], acc);
                o[rb][cb] = acc; sq += (acc[0] * acc[0] + acc[1] * acc[1]) + (acc[2] * acc[2] + acc[3] * acc[3]); }
            sq += __shfl_xor(sq, 16); sq += __shfl_xor(sq, 32);
            ss[cb] = sq;
        }
        LAS float* SS = (LAS float*)(L + G3_SS);
        if (q4 == 0) {
#pragma unroll
            for (int cb = 0; cb < 4; ++cb) SS[w * 64 + 16 * cb + r16] = ss[cb]; }
        __syncthreads();
#pragma unroll
        for (int cb = 0; cb < 4; ++cb) {
            float tot = 0.f;
#pragma unroll
            for (int ww = 0; ww < 8; ++ww) tot += SS[ww * 64 + 16 * cb + r16];
            const float rs = 1.0f / sqrtf(tot * (1.0f / 256.0f) + NORM_EPS);
            const size_t m = m0 + 16 * cb + r16;
#pragma unroll
            for (int rb = 0; rb < 2; ++rb) { const int dv = 32 * w + 16 * rb + 4 * q4;
                const f32x4 gv = gvv[rb];
                const v2u rr = rrv[cb][rb];
                const float r[4] = {bf_lo(rr.x), bf_hi(rr.x), bf_lo(rr.y), bf_hi(rr.y)};
                float y[4];
#pragma unroll
                for (int e = 0; e < 4; ++e) y[e] = ((o[rb][cb][e] * rs) * gv[e]) * (r[e] * __builtin_amdgcn_rcpf(1.0f + __expf(-r[e])));
                v2u wv; wv.x = pg8::cvt_pk_bf16(y[0], y[1]); wv.y = pg8::cvt_pk_bf16(y[2], y[3]);
                *(v2u*)(F.MO + m * D + 1024 + h * 256 + dv) = wv; }
        }
        __syncthreads();
    }
}


__device__ __forceinline__ void attn_mfma(Frame& F, int l) {
    RELAUNDER(F);
    LAS unsigned char* L = F.lds + RING_OFF;
    const int r16 = F.lane & 15, q4 = F.lane >> 4, w = F.wave, g = w >> 1, qh = w & 1;
    for (int uu = F.wcu; uu < (F.nrows >> 7) * 4; uu += F.WG) {
        const int u = (F.row0 >> 7) * 4 + uu;
        const int h = u & 3, nb = u >> 2, n = nb & 63;
        const size_t mq0 = (size_t)nb * 128;
        const int hq = h * 4 + g;
        v4u qlo[4], qhi[4]; f32x4 qc0[4], qc1[4], qs0[4], qs1[4];
#pragma unroll
        for (int cb = 0; cb < 4; ++cb) {
            const size_t mq = mq0 + 64 * qh + 16 * cb + r16;
            const bf16* qp = F.MIX + mq * MIXLD + C_QA + hq * 64 + 8 * q4; const float* cs = F.ROPE + mq * 64 + 8 * q4;
            qlo[cb] = *(const v4u*)qp; qhi[cb] = *(const v4u*)(qp + 32);
            qc0[cb] = *(const f32x4*)cs; qc1[cb] = *(const f32x4*)(cs + 4); qs0[cb] = *(const f32x4*)(cs + 32); qs1[cb] = *(const f32x4*)(cs + 36); }
        { const int key = F.tid >> 1, hf = F.tid & 1; const bool ok = (n > 0) || key >= 128;
          const size_t mk = ok ? mq0 + key - 128 : mq0;
          const bf16* kp = F.MIX + mk * MIXLD + C_KA + h * 64 + hf * 16; const float* cs = F.ROPE + mk * 64 + hf * 16;
          v4u lo[2], hi[2]; f32x4 cc[4], sn[4];
#pragma unroll
          for (int j = 0; j < 2; ++j) { lo[j] = *(const v4u*)(kp + 8 * j); hi[j] = *(const v4u*)(kp + 32 + 8 * j); }
#pragma unroll
          for (int j = 0; j < 4; ++j) { cc[j] = *(const f32x4*)(cs + 4 * j); sn[j] = *(const f32x4*)(cs + 32 + 4 * j); }
          v4u o1[2], o2[2];
#pragma unroll
          for (int j = 0; j < 2; ++j) {
              const unsigned lw[4] = {lo[j].x, lo[j].y, lo[j].z, lo[j].w}, hw[4] = {hi[j].x, hi[j].y, hi[j].z, hi[j].w}; unsigned a1[4], a2[4];
#pragma unroll
              for (int e = 0; e < 4; ++e) { const f32x4 c4 = cc[2 * j + (e >> 1)], s4 = sn[2 * j + (e >> 1)];
                  const float ca = (e & 1) ? c4.z : c4.x, cb2 = (e & 1) ? c4.w : c4.y, sa = (e & 1) ? s4.z : s4.x, sb = (e & 1) ? s4.w : s4.y;
                  const float x1a = bf_lo(lw[e]), x1b = bf_hi(lw[e]), x2a = bf_lo(hw[e]), x2b = bf_hi(hw[e]);
                  a1[e] = pg8::cvt_pk_bf16(x1a * ca - x2a * sa, x1b * cb2 - x2b * sb); a2[e] = pg8::cvt_pk_bf16(x2a * ca + x1a * sa, x2b * cb2 + x1b * sb); }
              o1[j] = ok ? (v4u){a1[0], a1[1], a1[2], a1[3]} : (v4u){0u, 0u, 0u, 0u}; o2[j] = ok ? (v4u){a2[0], a2[1], a2[2], a2[3]} : (v4u){0u, 0u, 0u, 0u}; }
          LAS v4u* d1 = (LAS v4u*)(L + A_KS + key * 144 + hf * 32); LAS v4u* d2 = (LAS v4u*)(L + A_KS + key * 144 + 64 + hf * 32);
          d1[0] = o1[0]; d1[1] = o1[1]; d2[0] = o2[0]; d2[1] = o2[1]; }
        { const int d = F.tid & 63, kg = F.tid >> 6; const bool ok = (n > 0) || kg >= 4;
          const bf16* vp = F.MIX + (ok ? mq0 + kg * 32 - 128 : mq0) * MIXLD + C_VA + h * 64 + d;
          unsigned pk[16];
          unsigned raw[32];
#pragma unroll
          for (int i = 0; i < 32; ++i) raw[i] = vp[(size_t)i * MIXLD];
          __builtin_amdgcn_sched_barrier(0);
#pragma unroll
          for (int i = 0; i < 16; ++i) pk[i] = ok ? (raw[2 * i] | (raw[2 * i + 1] << 16)) : 0u;
          LAS v4u* dst = (LAS v4u*)(L + A_VT + d * 528 + kg * 64);
#pragma unroll
          for (int j = 0; j < 4; ++j) dst[j] = (v4u){pk[4 * j], pk[4 * j + 1], pk[4 * j + 2], pk[4 * j + 3]}; }
        __syncthreads();
        bf16x8 qf[4][2];
#pragma unroll
        for (int cb = 0; cb < 4; ++cb) {
            const v4u lo = qlo[cb], hi = qhi[cb]; const f32x4 c0 = qc0[cb], c1 = qc1[cb], s0 = qs0[cb], s1 = qs1[cb];
            const unsigned lw[4] = {lo.x, lo.y, lo.z, lo.w}, hw[4] = {hi.x, hi.y, hi.z, hi.w};
            const float cc[8] = {c0.x, c0.y, c0.z, c0.w, c1.x, c1.y, c1.z, c1.w}, sn[8] = {s0.x, s0.y, s0.z, s0.w, s1.x, s1.y, s1.z, s1.w};
            unsigned a1[4], a2[4];
#pragma unroll
            for (int e = 0; e < 4; ++e) { const float x1a = bf_lo(lw[e]), x1b = bf_hi(lw[e]), x2a = bf_lo(hw[e]), x2b = bf_hi(hw[e]);
                a1[e] = pg8::cvt_pk_bf16((x1a * cc[2 * e] - x2a * sn[2 * e]) * 0.125f, (x1b * cc[2 * e + 1] - x2b * sn[2 * e + 1]) * 0.125f);
                a2[e] = pg8::cvt_pk_bf16((x2a * cc[2 * e] + x1a * sn[2 * e]) * 0.125f, (x2b * cc[2 * e + 1] + x1b * sn[2 * e + 1]) * 0.125f); }
            const v4u w1 = {a1[0], a1[1], a1[2], a1[3]}, w2 = {a2[0], a2[1], a2[2], a2[3]};
            qf[cb][0] = __builtin_bit_cast(bf16x8, w1); qf[cb][1] = __builtin_bit_cast(bf16x8, w2); }
        const float sink = F.sinks[l * 16 + hq];
#pragma unroll 1
        for (int cb = 0; cb < 4; ++cb) {
            pg8::f32x4 s[12];
#pragma unroll
            for (int kt = 0; kt < 12; ++kt) { pg8::f32x4 acc = {0.f, 0.f, 0.f, 0.f};
#pragma unroll
                for (int ks = 0; ks < 2; ++ks) acc = mma16(*(const LAS bf16x8*)(L + A_KS + (64 * qh + 16 * kt + r16) * 144 + (32 * ks + 8 * q4) * 2), cb == 0 ? qf[0][ks] : cb == 1 ? qf[1][ks] : cb == 2 ? qf[2][ks] : qf[3][ks], acc);
                s[kt] = acc; }
            const int qpos = 64 * qh + 16 * cb + r16;
            float mx = sink;
#pragma unroll
            for (int kt = 0; kt < 12; ++kt)
#pragma unroll
                for (int i = 0; i < 4; ++i) { const int kpos = 64 * qh - 128 + 16 * kt + 4 * q4 + i;
                    const bool valid = (kpos <= qpos) && (kpos > qpos - 128) && (n > 0 || kpos >= 0);
                    s[kt][i] = valid ? s[kt][i] : -INFINITY; mx = fmaxf(mx, s[kt][i]); }
            mx = fmaxf(mx, __shfl_xor(mx, 16)); mx = fmaxf(mx, __shfl_xor(mx, 32));
            float sum = 0.f;
#pragma unroll
            for (int kt = 0; kt < 12; ++kt)
#pragma unroll
                for (int i = 0; i < 4; ++i) { s[kt][i] = __expf(s[kt][i] - mx); sum += s[kt][i]; }
            sum += __shfl_xor(sum, 16); sum += __shfl_xor(sum, 32);
            sum += __expf(sink - mx);
            pg8::f32x4 o[4];
#pragma unroll
            for (int rb = 0; rb < 4; ++rb) o[rb] = (pg8::f32x4){0.f, 0.f, 0.f, 0.f};
#pragma unroll
            for (int kk = 0; kk < 6; ++kk) {
                v4u pw; pw.x = pg8::cvt_pk_bf16(s[2 * kk][0], s[2 * kk][1]); pw.y = pg8::cvt_pk_bf16(s[2 * kk][2], s[2 * kk][3]);
                pw.z = pg8::cvt_pk_bf16(s[2 * kk + 1][0], s[2 * kk + 1][1]); pw.w = pg8::cvt_pk_bf16(s[2 * kk + 1][2], s[2 * kk + 1][3]);
                const bf16x8 pf = __builtin_bit_cast(bf16x8, pw);
#pragma unroll
                for (int rb = 0; rb < 4; ++rb) {
                    const v2u lo = *(const LAS v2u*)(L + A_VT + (16 * rb + r16) * 528 + (64 * qh + 32 * kk + 4 * q4) * 2);
                    const v2u hi = *(const LAS v2u*)(L + A_VT + (16 * rb + r16) * 528 + (64 * qh + 32 * kk + 16 + 4 * q4) * 2);
                    const v4u vw = {lo.x, lo.y, hi.x, hi.y};
                    o[rb] = mma16(__builtin_bit_cast(bf16x8, vw), pf, o[rb]); }
            }
            const float inv = 1.0f / sum;
            bf16* op = F.MO + (mq0 + qpos) * D + hq * 64 + 4 * q4;
#pragma unroll
            for (int rb = 0; rb < 4; ++rb) { v2u wv; wv.x = pg8::cvt_pk_bf16(o[rb][0] * inv, o[rb][1] * inv); wv.y = pg8::cvt_pk_bf16(o[rb][2] * inv, o[rb][3] * inv);
                *(v2u*)(op + 16 * rb) = wv; }
        }
        __syncthreads();
    }
}

struct Args { const void* in[11]; float* out; unsigned char* ws; };
__global__ void __launch_bounds__(NWAVES * 64, 2) fwd(Args args) {
    extern __shared__ __attribute__((aligned(16))) unsigned char lds[];
    Frame F;
    F.lds = (LAS unsigned char*)lds;
    F.MISC = (volatile LAS unsigned*)(F.lds + MISC_OFF);
    F.tid = threadIdx.x; F.lane = F.tid & 63; F.wave = __builtin_amdgcn_readfirstlane(F.tid >> 6);
    F.G = gridDim.x; const int bx = blockIdx.x; F.vcu = (bx % 8) * (F.G / 8) + bx / 8;
    constexpr int NLAB = 8; static_assert(M % (NLAB * 256) == 0, "label groups own whole row panels");
    const int lab = bx % NLAB, wl = bx / NLAB, LW = F.G / NLAB;
    unsigned char* ws = args.ws;
    F.ctl = (gu32*)(ws + WS_CTL);
    RELAUNDER(F);
    for (int u = F.tid; u < (LDS_BYTES - LDSCTL_OFF) / 4; u += NWAVES * 64) ((LAS unsigned*)(F.lds + LDSCTL_OFF))[u] = 0u;
    __syncthreads();
    XcdBarrier bar_all = xcd_barrier_post((unsigned*)(F.ctl + CW_BAR), F.MISC + 8, (unsigned)F.G);
    XcdBarrier bar_lab = xcd_barrier_post((unsigned*)(F.ctl + CW_BAR + (1 + lab) * XCD_BAR_WORDS), F.MISC + 10, (unsigned)LW);
#define GRID_BAR_OF(B) do { XcdBarrier b_ = (B); GAS unsigned* gb_ = (GAS unsigned*)(B).bar; asm volatile("" : "+s"(gb_), "+s"(b_.x)); b_.bar = (unsigned*)gb_; xcd_barrier(b_); } while (0)
#define GRID_BAR() GRID_BAR_OF(bar_all)
#define LAB_BAR() GRID_BAR_OF(bar_lab)
#define GEO_ALL() do { F.wcu = F.vcu; F.WG = F.G; F.row0 = 0; F.nrows = M; } while (0)
#define GEO_LAB() do { F.wcu = wl; F.WG = LW; F.row0 = lab * (M / NLAB); F.nrows = M / NLAB; } while (0)
    F.gc = bx; F.nxl = 8;

    GEO_ALL();
    p0_convert(F, 0, DEPTH);
    p0_rope(F);
    norm_phase<true>(F, 0, 0, 0, 0.f, true);
    GRID_BAR();

#pragma unroll 1
    for (int l = 0; l < DEPTH; ++l) {
        RELAUNDER(F);
        { pg8::Gemm gm{F.XN, F.WFI + (size_t)(2 * l) * NFF * D, M, NFF, D}; pg8::StaticOrder S; S.init(M, NFF, F.G, F.gc, F.nxl);
          pg8::EpiSwiGLU E{F.ACT, DFF};
          pg8::gemm_phase<pg8::EpiSwiGLU, pg8::StaticOrder, true, true>(F.lds + RING_OFF, gm, S, E); }
        LAB_BAR();
        RELAUNDER(F);
        { pg8::Gemm gm{F.ACT, F.WFO + (size_t)(2 * l) * D * DFF, M, D, DFF}; pg8::StaticOrder S; S.init(M, D, F.G, F.gc, F.nxl);
          pg8::EpiPlain E{F.H, D};
          pg8::gemm_phase<pg8::EpiPlain, pg8::StaticOrder, true, true>(F.lds + RING_OFF, gm, S, E); }
        LAB_BAR();
        GEO_LAB();
        norm_phase<false>(F, 3 * l + 0, l * 6 + 1, l * 6 + 2, 0.5f, true);
        LAB_BAR();
        RELAUNDER(F);
        { pg8::Gemm gm{F.XN, F.WMI + (size_t)l * NMIXP * D, M, NMIXP, D}; pg8::StaticOrder S; S.init(M, NMIXP, F.G, F.gc, F.nxl);
          pg8::EpiMix E{F.MIX, MIXLD, F.GLR, MIXLD / 256};
          pg8::gemm_phase<pg8::EpiMix, pg8::StaticOrder, true, true>(F.lds + RING_OFF, gm, S, E); }
        GRID_BAR();
        GEO_LAB();
        gla_g1(F, l);
        attn_mfma(F, l);
        GRID_BAR();
        GEO_ALL();
        gla_scan(F);
        GRID_BAR();
        GEO_LAB();
        gla_g3(F, l);
        LAB_BAR();
        RELAUNDER(F);
        { pg8::Gemm gm{F.MO, F.WMO + (size_t)l * D * D, M, D, D}; pg8::StaticOrder S; S.init(M, D, F.G, F.gc, F.nxl);
          pg8::EpiPlain E{F.H, D};
          pg8::gemm_phase<pg8::EpiPlain, pg8::StaticOrder, true, true>(F.lds + RING_OFF, gm, S, E); }
        LAB_BAR();
        GEO_LAB();
        norm_phase<false>(F, 3 * l + 1, l * 6 + 3, l * 6 + 4, 1.0f, true);
        LAB_BAR();
        RELAUNDER(F);
        { pg8::Gemm gm{F.XN, F.WFI + (size_t)(2 * l + 1) * NFF * D, M, NFF, D}; pg8::StaticOrder S; S.init(M, NFF, F.G, F.gc, F.nxl);
          pg8::EpiSwiGLU E{F.ACT, DFF};
          pg8::gemm_phase<pg8::EpiSwiGLU, pg8::StaticOrder, true, true>(F.lds + RING_OFF, gm, S, E); }
        LAB_BAR();
        RELAUNDER(F);
        { pg8::Gemm gm{F.ACT, F.WFO + (size_t)(2 * l + 1) * D * DFF, M, D, DFF}; pg8::StaticOrder S; S.init(M, D, F.G, F.gc, F.nxl);
          pg8::EpiPlain E{F.H, D};
          pg8::gemm_phase<pg8::EpiPlain, pg8::StaticOrder, true, true>(F.lds + RING_OFF, gm, S, E); }
        LAB_BAR();
        GEO_LAB();
        norm_phase<false>(F, 3 * l + 2, l * 6 + 5, l * 6 + 6  , 0.5f, l + 1 < DEPTH);
        if (l + 1 < DEPTH) LAB_BAR();
    }
}

extern "C" void kernel_launch(void* const* d_in, const int* in_sizes, int n_in, void* d_out, int out_size, void* d_ws, size_t ws_size, hipStream_t stream) {
    static int grid = 0;
    if (grid == 0) {
        if (n_in != 11 || in_sizes[0] != M * D || out_size != M * D || ws_size < WS_END) { fprintf(stderr, "kernel_launch: unexpected shapes (n_in %d, in0 %d, out %d, ws %zu < %zu); nothing launched\n", n_in, n_in > 0 ? in_sizes[0] : -1, out_size, ws_size, (size_t)WS_END); grid = -1; return; }
        int dev = 0, cus = 0, per_cu = 0;
        if (hipGetDevice(&dev) != hipSuccess || hipDeviceGetAttribute(&cus, hipDeviceAttributeMultiprocessorCount, dev) != hipSuccess) { fprintf(stderr, "kernel_launch: device query failed\n"); grid = -1; return; }
        if (hipFuncSetAttribute((const void*)fwd, hipFuncAttributeMaxDynamicSharedMemorySize, LDS_BYTES) != hipSuccess) { fprintf(stderr, "kernel_launch: hipFuncSetAttribute failed\n"); grid = -1; return; }
        if (hipOccupancyMaxActiveBlocksPerMultiprocessor(&per_cu, (const void*)fwd, NWAVES * 64, LDS_BYTES) != hipSuccess || per_cu < 1) { fprintf(stderr, "kernel_launch: occupancy query reports %d workgroups per CU\n", per_cu); }
        (void)hipGetLastError();
        if (cus % 8 != 0) { fprintf(stderr, "kernel_launch: %d CUs: this kernel deals its work over 8 label groups and needs a multiple of 8; nothing launched\n", cus); grid = -1; return; }
        grid = cus;
    }
    if (grid < 0) return;
    if (hipMemsetAsync((char*)d_ws + WS_CTL, 0, CTL_ZERO_BYTES, stream) != hipSuccess) { fprintf(stderr, "kernel_launch: memset failed\n"); return; }
    Args a{};
    for (int i = 0; i < 11; ++i) a.in[i] = d_in[i];
    a.out = (float*)d_out; a.ws = (unsigned char*)d_ws;
    hipLaunchKernelGGL(fwd, dim3(grid), dim3(NWAVES * 64), LDS_BYTES, stream, a);
    const hipError_t le = hipPeekAtLastError();
    if (le != hipSuccess) fprintf(stderr, "kernel_launch: launch failed: %s\n", hipGetErrorName(le));
}
```
